# Optimizing an MI355X kernel written in HIP

```python
import math
import jax, jax.numpy as jnp
from jax import lax
import numpy as np

D_MODEL = 1024
BATCH = 4
SEQ = 8192
DEPTH = 2

GRID_W = 64
ROPE_THETA = 10000.0
NORM_EPS = 1e-6
Q_BLOCK = 128

GDN_HEADS = 4
GDN_DK = 128
GDN_DV = 128
GDN_CONV = 5
GDN_CHUNK = 64
DIFF_HEADS = 4
DIFF_DQK = 64
DIFF_DV = 2 * DIFF_DQK
GQA_HEADS = 8
GQA_KV = 2
GQA_DH = 64

N_BRANCH = 3
GDN_W = GDN_HEADS * GDN_DV
DIFF_W = DIFF_HEADS * DIFF_DV
GQA_W = GQA_HEADS * GQA_DH
GDN_QKV = GDN_HEADS * (2 * GDN_DK + GDN_DV)

IN_SIZES = (
    GDN_QKV,
    GDN_W,
    2 * GDN_HEADS,
    2 * GDN_HEADS,
    DIFF_HEADS * 2 * DIFF_DQK,
    DIFF_HEADS * 2 * DIFF_DQK,
    DIFF_W,
    GQA_HEADS * GQA_DH,
    GQA_KV * GQA_DH,
    GQA_KV * GQA_DH,
    N_BRANCH * D_MODEL,
)
IN_COLS = sum(IN_SIZES)

N_GROUPS = 4
EXPERTS_PER_GROUP = 8
N_EXPERTS = N_GROUPS * EXPERTS_PER_GROUP
TOPK = 2
EXPERT_FF = 512
MOE_BLOCK = 256

kernel_name = 'hybrid_gdn_diff_axialgqa_hiermoe_encoder'


def _rmsnorm(x, w):
    xf = x.astype(jnp.float32)
    y = xf * lax.rsqrt(jnp.mean(xf * xf, axis=-1, keepdims=True) + NORM_EPS)
    return (y * w.astype(jnp.float32)).astype(x.dtype)


def _l2norm(x):
    return x * lax.rsqrt(jnp.sum(x * x, axis=-1, keepdims=True) + NORM_EPS)


def _split_cols(p):
    idx = []
    acc = 0
    for s in IN_SIZES[:-1]:
        acc += s
        idx.append(acc)
    return jnp.split(p, idx, axis=-1)


def _rope_tables(pos, dim):
    inv = 1.0 / (ROPE_THETA ** (jnp.arange(0, dim, 2, dtype=jnp.float32) / dim))
    ang = pos.astype(jnp.float32)[:, None] * inv[None, :]
    ang = jnp.concatenate([ang, ang], axis=-1)
    return (jnp.cos(ang), jnp.sin(ang))


def _apply_rope(x, cos, sin):
    c = cos[:, None, :].astype(x.dtype)
    s = sin[:, None, :].astype(x.dtype)
    half = x.shape[-1] // 2
    rot = jnp.concatenate([-x[..., half:], x[..., :half]], axis=-1)
    return x * c + rot * s


def _axial_rope(x, cos_r, sin_r, cos_c, sin_c):
    half = x.shape[-1] // 2
    return jnp.concatenate([_apply_rope(x[..., :half], cos_r, sin_r),
                            _apply_rope(x[..., half:], cos_c, sin_c)], axis=-1)


def _to_qblocks(x):
    b, s = x.shape[:2]
    x = x.reshape((b, s // Q_BLOCK, Q_BLOCK) + x.shape[2:])
    return jnp.moveaxis(x, 1, 0)


def _from_qblocks(y):
    nb, b, qb = y.shape[:3]
    return jnp.moveaxis(y, 0, 1).reshape((b, nb * qb) + y.shape[3:])


def _short_conv(x, w):
    c = x.shape[-1]
    pad = GDN_CONV // 2
    return lax.conv_general_dilated(x, w[:, None, :].astype(x.dtype), window_strides=(1,),
                                    padding=[(pad, pad)], dimension_numbers=('NWC', 'WIO', 'NWC'),
                                    feature_group_count=c)


def _gated_delta_chunked(q, k, v, beta, g):
    bsz, nh, s, dk = q.shape
    dv = v.shape[-1]
    c = GDN_CHUNK
    n = s // c
    q = q.reshape(bsz, nh, n, c, dk) * (dk ** -0.5)
    k = k.reshape(bsz, nh, n, c, dk)
    v = v.reshape(bsz, nh, n, c, dv)
    beta = beta.reshape(bsz, nh, n, c)
    gc = jnp.cumsum(g.reshape(bsz, nh, n, c), axis=-1)
    idx = jnp.arange(c)
    incl = idx[:, None] >= idx[None, :]
    strict = idx[:, None] > idx[None, :]
    decay = jnp.exp(jnp.where(incl, gc[..., :, None] - gc[..., None, :], -jnp.inf))
    kb = k * beta[..., None]
    lmat = jnp.where(strict, jnp.einsum('bhnid,bhnjd->bhnij', kb, k) * decay, 0.0)
    tmat = lmat + jnp.eye(c, dtype=jnp.float32)
    rhs = jnp.concatenate([v * beta[..., None], kb * jnp.exp(gc)[..., None]], axis=-1)
    sol = lax.linalg.triangular_solve(tmat, rhs, left_side=True, lower=True, unit_diagonal=True)
    u, w = sol[..., :dv], sol[..., dv:]
    intra = jnp.einsum('bhnid,bhnjd->bhnij', q, k) * decay
    q_dec = q * jnp.exp(gc)[..., None]
    k_dec = k * jnp.exp(gc[..., -1:] - gc)[..., None]
    g_last = jnp.exp(gc[..., -1])
    xs = (jnp.moveaxis(u, 2, 0), jnp.moveaxis(w, 2, 0), jnp.moveaxis(intra, 2, 0),
          jnp.moveaxis(q_dec, 2, 0), jnp.moveaxis(k_dec, 2, 0), jnp.moveaxis(g_last, 2, 0))

    def step(state, inp):
        u_n, w_n, intra_n, qd_n, kd_n, gl_n = inp
        v_new = u_n - jnp.einsum('bhck,bhkv->bhcv', w_n, state)
        o_n = jnp.einsum('bhck,bhkv->bhcv', qd_n, state) + jnp.einsum('bhij,bhjv->bhiv', intra_n, v_new)
        state = state * gl_n[..., None, None] + jnp.einsum('bhck,bhcv->bhkv', kd_n, v_new)
        return state, o_n

    s0 = jnp.zeros((bsz, nh, dk, dv), jnp.float32)
    _, o = lax.scan(step, s0, xs)
    return jnp.moveaxis(o, 0, 2).reshape(bsz, nh, s, dv)


def _gdn_mixer(qkv, z, b_raw, a_raw, conv_w, a_log, dt_bias, norm_w):
    bsz, s, _ = qkv.shape
    qkv = jax.nn.silu(_short_conv(qkv, conv_w))
    q, k, v = jnp.split(qkv, [GDN_HEADS * GDN_DK, 2 * GDN_HEADS * GDN_DK], axis=-1)

    def heads(t, d):
        return jnp.transpose(t.reshape(bsz, s, GDN_HEADS, d).astype(jnp.float32), (0, 2, 1, 3))

    q = _l2norm(heads(q, GDN_DK))
    k = _l2norm(heads(k, GDN_DK))
    v = heads(v, GDN_DV)
    beta = jax.nn.sigmoid(b_raw.astype(jnp.float32)).reshape(bsz, s, 2, GDN_HEADS)
    g = -jnp.exp(a_log.astype(jnp.float32)) * jax.nn.softplus(
        a_raw.astype(jnp.float32).reshape(bsz, s, 2, GDN_HEADS) + dt_bias.astype(jnp.float32))
    beta = jnp.transpose(beta, (2, 0, 3, 1))
    g = jnp.transpose(g, (2, 0, 3, 1))
    o_fwd = _gated_delta_chunked(q, k, v, beta[0], g[0])
    fl = lambda t: jnp.flip(t, axis=2)
    o_bwd = fl(_gated_delta_chunked(fl(q), fl(k), fl(v), fl(beta[1]), fl(g[1])))
    o = jnp.transpose(o_fwd + o_bwd, (0, 2, 1, 3))
    o = _rmsnorm(o, norm_w) * jax.nn.silu(z.astype(jnp.float32).reshape(bsz, s, GDN_HEADS, GDN_DV))
    return o.reshape(bsz, s, GDN_W).astype(qkv.dtype)


def _diff_mixer(q, k, v, lam_vecs, norm_w, lambda_init, cos, sin):
    bsz, s, _ = q.shape
    q = _apply_rope(q.reshape(bsz, s, 2 * DIFF_HEADS, DIFF_DQK), cos, sin)
    q = q.reshape(bsz, s, DIFF_HEADS, 2, DIFF_DQK) * (DIFF_DQK ** -0.5)
    k = _apply_rope(k.reshape(bsz, s, 2 * DIFF_HEADS, DIFF_DQK), cos, sin)
    k = k.reshape(bsz, s, DIFF_HEADS, 2, DIFF_DQK)
    v = v.reshape(bsz, s, DIFF_HEADS, DIFF_DV)
    lv = lam_vecs.astype(jnp.float32)
    lam = jnp.exp(jnp.sum(lv[0] * lv[1])) - jnp.exp(jnp.sum(lv[2] * lv[3])) + lambda_init

    def block(qb):
        sc = jnp.einsum('bqhmd,bshmd->bhmqs', qb, k).astype(jnp.float32)
        p = jax.nn.softmax(sc, axis=-1)
        pd = (p[:, :, 0] - lam * p[:, :, 1]).astype(v.dtype)
        return jnp.einsum('bhqs,bshe->bqhe', pd, v)

    o = _from_qblocks(lax.map(block, _to_qblocks(q)))
    o = _rmsnorm(o, norm_w) * (1.0 - lambda_init)
    return o.reshape(bsz, s, DIFF_W)


def _gqa_mixer(q, k, v, qn_w, kn_w, cos_r, sin_r, cos_c, sin_c):
    bsz, s, _ = q.shape
    q = _rmsnorm(q.reshape(bsz, s, GQA_HEADS, GQA_DH), qn_w)
    k = _rmsnorm(k.reshape(bsz, s, GQA_KV, GQA_DH), kn_w)
    v = v.reshape(bsz, s, GQA_KV, GQA_DH)
    q = _axial_rope(q, cos_r, sin_r, cos_c, sin_c) * (GQA_DH ** -0.5)
    k = _axial_rope(k, cos_r, sin_r, cos_c, sin_c)
    q = q.reshape(bsz, s, GQA_KV, GQA_HEADS // GQA_KV, GQA_DH)

    def block(qb):
        sc = jnp.einsum('bqkgd,bskd->bkgqs', qb, k).astype(jnp.float32)
        p = jax.nn.softmax(sc, axis=-1).astype(v.dtype)
        return jnp.einsum('bkgqs,bskd->bqkgd', p, v)

    o = _from_qblocks(lax.map(block, _to_qblocks(q)))
    return o.reshape(bsz, s, GQA_W)


def _hier_moe(h, wg, bg, we, be, w1, w3, w2):
    bsz, s, d = h.shape
    t = bsz * s
    ht = h.reshape(t, d)
    gprob = jax.nn.softmax((ht @ wg).astype(jnp.float32) + bg.astype(jnp.float32), axis=-1)
    gp, gidx = lax.top_k(gprob, 1)
    elog = ((ht @ we).astype(jnp.float32) + be.astype(jnp.float32)).reshape(t, N_GROUPS, EXPERTS_PER_GROUP)
    elog = jnp.take_along_axis(elog, gidx[:, :, None], axis=1)[:, 0]
    ep, eidx = lax.top_k(jax.nn.softmax(elog, axis=-1), TOPK)
    ep = ep / jnp.sum(ep, axis=-1, keepdims=True)
    weights = (gp * ep).astype(h.dtype)
    expert_id = (gidx * EXPERTS_PER_GROUP + eidx).astype(jnp.int32)
    a = t * TOPK
    p_len = ((a + N_EXPERTS * (MOE_BLOCK - 1) + MOE_BLOCK - 1) // MOE_BLOCK) * MOE_BLOCK
    n_blocks = p_len // MOE_BLOCK
    flat_e = expert_id.reshape(-1)
    flat_w = weights.reshape(-1)
    flat_t = jnp.repeat(jnp.arange(t, dtype=jnp.int32), TOPK)
    order = jnp.argsort(flat_e)
    se = flat_e[order]
    counts = jnp.bincount(flat_e, length=N_EXPERTS).astype(jnp.int32)
    start = jnp.cumsum(counts) - counts
    pcounts = ((counts + MOE_BLOCK - 1) // MOE_BLOCK) * MOE_BLOCK
    pend = jnp.cumsum(pcounts)
    pstart = pend - pcounts
    dest = pstart[se] + (jnp.arange(a, dtype=jnp.int32) - start[se])
    tok_buf = jnp.full((p_len,), t, jnp.int32).at[dest].set(flat_t[order])
    w_buf = jnp.zeros((p_len,), h.dtype).at[dest].set(flat_w[order])
    blk_e = jnp.minimum(jnp.searchsorted(pend, jnp.arange(n_blocks, dtype=jnp.int32) * MOE_BLOCK, side='right'),
                        N_EXPERTS - 1)
    x_pad = jnp.concatenate([ht, jnp.zeros((1, d), h.dtype)], axis=0)
    xb = x_pad[tok_buf].reshape(n_blocks, MOE_BLOCK, d)

    def expert_block(args):
        xblk, e = args
        return (jax.nn.silu(xblk @ w1[e]) * (xblk @ w3[e])) @ w2[e]

    yb = lax.map(expert_block, (xb, blk_e)).reshape(p_len, d) * w_buf[:, None]
    out = jnp.zeros((t + 1, d), h.dtype).at[tok_buf].add(yb)[:t]
    return out.reshape(bsz, s, d)


def setup_inputs(seed: int = 0) -> dict:
    key = jax.random.key(seed)
    ks = jax.random.split(key, 32)
    f32 = jnp.float32
    nrm = lambda k, shape, scale: jax.random.normal(k, shape, f32) * scale
    gain = lambda k, shape: 1.0 + 0.02 * jax.random.normal(k, shape, f32)
    lo, hi = math.log(0.001), math.log(0.1)
    dt = jnp.exp(jax.random.uniform(ks[5], (DEPTH, 2, GDN_HEADS), f32) * (hi - lo) + lo)
    return {
        'x': jax.random.normal(ks[0], (BATCH, SEQ, D_MODEL), f32),
        'attn_norm_w': gain(ks[1], (DEPTH, D_MODEL)),
        'w_in': nrm(ks[2], (DEPTH, D_MODEL, IN_COLS), D_MODEL ** -0.5),
        'gdn_conv_w': nrm(ks[3], (DEPTH, GDN_CONV, GDN_QKV), GDN_CONV ** -0.5),
        'gdn_a_log': jnp.log(jax.random.uniform(ks[4], (DEPTH, 2, GDN_HEADS), f32, 1.0, 16.0)),
        'gdn_dt_bias': dt + jnp.log(-jnp.expm1(-dt)),
        'gdn_norm_w': gain(ks[6], (DEPTH, GDN_DV)),
        'diff_lambda': nrm(ks[7], (DEPTH, 4, DIFF_DQK), 0.1),
        'diff_norm_w': gain(ks[8], (DEPTH, DIFF_DV)),
        'gqa_q_norm_w': gain(ks[9], (DEPTH, GQA_DH)),
        'gqa_k_norm_w': gain(ks[10], (DEPTH, GQA_DH)),
        'w_branch_a': nrm(ks[11], (DEPTH, GDN_W, D_MODEL), GDN_W ** -0.5),
        'w_branch_b': nrm(ks[12], (DEPTH, DIFF_W, D_MODEL), DIFF_W ** -0.5),
        'w_branch_c': nrm(ks[13], (DEPTH, GQA_W, D_MODEL), GQA_W ** -0.5),
        'w_out': nrm(ks[14], (DEPTH, D_MODEL, D_MODEL), D_MODEL ** -0.5),
        'ffn_norm_w': gain(ks[15], (DEPTH, D_MODEL)),
        'router_group_w': nrm(ks[16], (DEPTH, D_MODEL, N_GROUPS), D_MODEL ** -0.5),
        'router_group_b': nrm(ks[17], (DEPTH, N_GROUPS), 0.01),
        'router_expert_w': nrm(ks[18], (DEPTH, D_MODEL, N_EXPERTS), D_MODEL ** -0.5),
        'router_expert_b': nrm(ks[19], (DEPTH, N_EXPERTS), 0.01),
        'expert_w_gate': nrm(ks[20], (DEPTH, N_EXPERTS, D_MODEL, EXPERT_FF), D_MODEL ** -0.5),
        'expert_w_up': nrm(ks[21], (DEPTH, N_EXPERTS, D_MODEL, EXPERT_FF), D_MODEL ** -0.5),
        'expert_w_down': nrm(ks[22], (DEPTH, N_EXPERTS, EXPERT_FF, D_MODEL), EXPERT_FF ** -0.5),
        'final_norm_w': gain(ks[23], (D_MODEL,)),
    }


def reference(x, attn_norm_w, w_in, gdn_conv_w, gdn_a_log, gdn_dt_bias, gdn_norm_w, diff_lambda,
              diff_norm_w, gqa_q_norm_w, gqa_k_norm_w, w_branch_a, w_branch_b, w_branch_c, w_out,
              ffn_norm_w, router_group_w, router_group_b, router_expert_w, router_expert_b,
              expert_w_gate, expert_w_up, expert_w_down, final_norm_w):
    bsz, s, _ = x.shape
    rows = s // GRID_W
    row = jnp.broadcast_to(jnp.arange(rows)[:, None], (rows, GRID_W)).reshape(s)
    col = jnp.broadcast_to(jnp.arange(GRID_W)[None, :], (rows, GRID_W)).reshape(s)
    cos1, sin1 = _rope_tables(jnp.arange(s), DIFF_DQK)
    cos_r, sin_r = _rope_tables(row, GQA_DH // 2)
    cos_c, sin_c = _rope_tables(col, GQA_DH // 2)
    for l in range(DEPTH):
        lambda_init = 0.8 - 0.6 * math.exp(-0.3 * l)
        h = _rmsnorm(x, attn_norm_w[l])
        (g_qkv, g_z, g_b, g_a, d_q, d_k, d_v, c_q, c_k, c_v, gate_raw) = _split_cols(h @ w_in[l])
        y_a = _gdn_mixer(g_qkv, g_z, g_b, g_a, gdn_conv_w[l], gdn_a_log[l], gdn_dt_bias[l], gdn_norm_w[l])
        y_b = _diff_mixer(d_q, d_k, d_v, diff_lambda[l], diff_norm_w[l], lambda_init, cos1, sin1)
        y_c = _gqa_mixer(c_q, c_k, c_v, gqa_q_norm_w[l], gqa_k_norm_w[l], cos_r, sin_r, cos_c, sin_c)
        gates = jax.nn.sigmoid(gate_raw.astype(jnp.float32)).astype(x.dtype).reshape(bsz, s, N_BRANCH, D_MODEL)
        merged = (gates[:, :, 0] * (y_a @ w_branch_a[l]) + gates[:, :, 1] * (y_b @ w_branch_b[l])
                  + gates[:, :, 2] * (y_c @ w_branch_c[l]))
        x = x + merged @ w_out[l]
        x = x + _hier_moe(_rmsnorm(x, ffn_norm_w[l]), router_group_w[l], router_group_b[l],
                          router_expert_w[l], router_expert_b[l], expert_w_gate[l], expert_w_up[l],
                          expert_w_down[l])
    return _rmsnorm(x, final_norm_w)
```

```cpp
#include <hip/hip_runtime.h>
#include <cstdio>
#include <cstdint>
#include <utility>
#ifndef DBG_N
#define DBG_N (32768 * 1024)
#endif
namespace pg8 {
#define PG8_LAS __attribute__((address_space(3)))
typedef unsigned short bf16_t;
typedef short bf16x8 __attribute__((ext_vector_type(8)));
typedef float f32x4 __attribute__((ext_vector_type(4)));
typedef unsigned u32x4 __attribute__((ext_vector_type(4)));
constexpr int BM = 256, BK = 64, HALF = 128, HTB = HALF * BK * 2  , STAGE_BYTES = 8 * HTB, NXCD = 8, WGM = 8;

__host__ __device__ __forceinline__ int lds_byte(int r, int c) { const int st = (r >> 4) * 2 + (c >> 5), rr = r & 15, cc = c & 31, ob = rr * 64 + cc * 2; return st * 1024 + (ob ^ (((ob >> 9) & 1) << 5)); }
__host__ __device__ __forceinline__ void stage_rc(int b, int& R, int& C) { const int st = b / 1024, sb = b % 1024, swz = sb ^ (((sb >> 9) & 1) << 5); R = (st >> 1) * 16 + swz / 64; C = (st & 1) * 32 + (swz % 64) / 2; }
__host__ __device__ __forceinline__ int perm32(int rho) { const int n = rho >> 4, i = rho & 15; return 8 * (i >> 2) + 4 * n + (i & 3); }

struct Unit { int pm, pn; long aoff, boff; int ord; };
struct Gemm { const bf16_t* A; const bf16_t* Bt; int M, N, K, lda, ldb; };

struct StaticOrder {
    int nM, nN, nwg, G, c;
    __host__ __device__ void init(int M, int N, int G_, int c_) { nM = M / BM; nN = N / BM; nwg = nM * nN; G = G_; c = c_; }
    __host__ __device__ bool next(int i, Unit& u) const {
        const long L = (long)i * G + c; if (L >= nwg) return false;
        int wgid = (int)L; { const int q = nwg / NXCD, r = nwg % NXCD, xcd = wgid % NXCD, off = wgid / NXCD; wgid = (xcd < r ? xcd * (q + 1) : r * (q + 1) + (xcd - r) * q) + off; }
        const int nig = WGM * nN, gid = wgid / nig, fm = gid * WGM, gsz = (nM - fm) < WGM ? (nM - fm) : WGM;
        u.pm = fm + ((wgid % nig) % gsz); u.pn = (wgid % nig) / gsz; u.aoff = 0; u.boff = 0; u.ord = i; return true;
    }
    __device__ __forceinline__ void a_ready(const Unit&) const {}
    __device__ __forceinline__ void done(const Unit&) const {}
    __device__ __forceinline__ int row(const Unit& u, int r) const { return u.pm * BM + r; }
};


#define PG8_GAS __attribute__((address_space(1)))
typedef float f32x2c_t __attribute__((ext_vector_type(2))); typedef __bf16 bf16x2c_t __attribute__((ext_vector_type(2)));
__device__ __forceinline__ unsigned cvt_pk_bf16(float lo, float hi) { const f32x2c_t v = {lo, hi}; const bf16x2c_t b = __builtin_convertvector(v, bf16x2c_t); return __builtin_bit_cast(unsigned, b); }
__device__ __forceinline__ float bflo(unsigned w) { return __uint_as_float(w << 16); }
__device__ __forceinline__ float bfhi(unsigned w) { return __uint_as_float(w & 0xffff0000u); }
__device__ __forceinline__ float sigmoidf_(float x) { return __builtin_amdgcn_rcpf(1.0f + __expf(-x)); }

#define PG8_ST16H(p, v) asm volatile("global_store_dwordx4 %0, %1, off\n\ts_nop 1" :: "v"((PG8_GAS void*)(p)), "v"(v) : "memory")
struct EpiInproj {
    static constexpr bool PERM = true, AFTER_DRAIN = false;
    bf16_t* raw; bf16_t* pp; const float* rstd; const float* cos1; const float* sin1; const float* ax; const float* qnw; const float* knw; float qscale;
    unsigned* nrm;
    __device__ __forceinline__ void operator()(const f32x4 (&acc)[2][2][4][2], const Unit& u, int wr, int wc, int fr, int fq) const {
        const int row0 = u.pm * BM + wr * 64 + fr;
        const int pt = u.pn - 6;
        float rsv[2][4];
#pragma unroll
        for (int ai = 0; ai < 2; ++ai)
#pragma unroll
            for (int m = 0; m < 4; ++m) rsv[ai][m] = ((const PG8_GAS float*)rstd)[row0 + ai * HALF + m * 16];
        const bool perm = (pt >= 2 && pt <= 5) || (pt >= 8);
        if (!perm) {
            bf16_t* base; int ldc, colt;
            if (u.pn < 6) { base = raw; ldc = 1536; colt = u.pn * 256; } else { base = pp; ldc = 2816; colt = pt * 256; }
            const int col0 = colt + wc * 32 + 8 * fq;
#pragma unroll
            for (int ai = 0; ai < 2; ++ai)
#pragma unroll
                for (int m = 0; m < 4; ++m) { const int row = row0 + ai * HALF + m * 16; const float s = rsv[ai][m]; bf16_t* rowp = base + (size_t)row * ldc + col0;
#pragma unroll
                    for (int bj = 0; bj < 2; ++bj) { const f32x4 v0 = acc[ai][bj][m][0] * s, v1 = acc[ai][bj][m][1] * s;
                        u32x4 w; w.x = cvt_pk_bf16(v0[0], v0[1]); w.y = cvt_pk_bf16(v0[2], v0[3]); w.z = cvt_pk_bf16(v1[0], v1[1]); w.w = cvt_pk_bf16(v1[2], v1[3]);
                        *(PG8_GAS u32x4*)(rowp + bj * HALF) = w; } }
            return;
        }
        const int kind = (pt <= 3) ? 0 : (pt <= 5) ? 1 : (pt <= 9) ? 2 : (wc < 2 ? 3 : 4);
        const int col0 = pt * 256 + wc * 64 + 8 * fq;
        const int lane = fq * 16 + fr;
        float nw0[8], nw1[8]; float nmax = 0.f;
        if (kind == 2 || kind == 3) { const PG8_GAS float* nwp = (const PG8_GAS float*)(kind == 2 ? qnw : knw) + 8 * fq;
#pragma unroll
            for (int j = 0; j < 8; ++j) { nw0[j] = nwp[j]; nw1[j] = nwp[32 + j]; } }
#pragma unroll
        for (int ai = 0; ai < 2; ++ai)
#pragma unroll
            for (int m = 0; m < 4; ++m) { const int row = row0 + ai * HALF + m * 16; const float s = rsv[ai][m]; const int sp = row & 8191;
                float x0[8], x1[8];
#pragma unroll
                for (int n = 0; n < 2; ++n)
#pragma unroll
                    for (int e2 = 0; e2 < 4; ++e2) { x0[4 * n + e2] = acc[ai][0][m][n][e2] * s; x1[4 * n + e2] = acc[ai][1][m][n][e2] * s; }
                if (kind <= 1) {
                    int fqo = fq; asm volatile("" : "+v"(fqo));
                    const PG8_GAS f32x4* cp = (const PG8_GAS f32x4*)(cos1 + sp * 32 + 8 * fqo); const PG8_GAS f32x4* snp = (const PG8_GAS f32x4*)(sin1 + sp * 32 + 8 * fqo);
                    const f32x4 c0 = cp[0], c1 = cp[1], s0 = snp[0], s1 = snp[1];
#pragma unroll
                    for (int j = 0; j < 8; ++j) { const float c = j < 4 ? c0[j & 3] : c1[j & 3], sn = j < 4 ? s0[j & 3] : s1[j & 3]; const float a = x0[j], b = x1[j];
                        x0[j] = a * c - b * sn; x1[j] = b * c + a * sn; if (kind == 0) { x0[j] *= qscale; x1[j] *= qscale; } }
                    float ssn = 0.f;
#pragma unroll
                    for (int j = 0; j < 8; ++j) { ssn = __builtin_fmaf(x0[j], x0[j], ssn); ssn = __builtin_fmaf(x1[j], x1[j], ssn); }
                    ssn += __int_as_float(__builtin_amdgcn_ds_bpermute((lane ^ 16) << 2, __float_as_int(ssn)));
                    ssn += __int_as_float(__builtin_amdgcn_ds_bpermute((lane ^ 32) << 2, __float_as_int(ssn)));
                    nmax = fmaxf(nmax, ssn);
                } else if (kind <= 3) {
                    float ss = 0.f;
#pragma unroll
                    for (int j = 0; j < 8; ++j) ss += x0[j] * x0[j] + x1[j] * x1[j];
                    ss += __int_as_float(__builtin_amdgcn_ds_bpermute((lane ^ 16) << 2, __float_as_int(ss)));
                    ss += __int_as_float(__builtin_amdgcn_ds_bpermute((lane ^ 32) << 2, __float_as_int(ss)));
                    const float rn = __builtin_amdgcn_rsqf(ss * (1.0f / 64.0f) + 1e-6f);
                    const PG8_GAS float* tr = (const PG8_GAS float*)ax + (sp >> 6) * 16 + 8 * (fq & 1); const PG8_GAS float* tc = (const PG8_GAS float*)ax + 4096 + (sp & 63) * 16 + 8 * (fq & 1);
                    const f32x4 cr0 = *(const PG8_GAS f32x4*)tr, cr1 = *(const PG8_GAS f32x4*)(tr + 4), sr0 = *(const PG8_GAS f32x4*)(tr + 2048), sr1 = *(const PG8_GAS f32x4*)(tr + 2052);
                    const f32x4 cc0 = *(const PG8_GAS f32x4*)tc, cc1 = *(const PG8_GAS f32x4*)(tc + 4), sc0 = *(const PG8_GAS f32x4*)(tc + 1024), sc1 = *(const PG8_GAS f32x4*)(tc + 1028);
#pragma unroll
                    for (int j = 0; j < 8; ++j) { const float y0 = x0[j] * rn * nw0[j], y1 = x1[j] * rn * nw1[j];
                        const float p0 = __int_as_float(__builtin_amdgcn_ds_bpermute((lane ^ 32) << 2, __float_as_int(y0))), p1 = __int_as_float(__builtin_amdgcn_ds_bpermute((lane ^ 32) << 2, __float_as_int(y1)));
                        const float cr = j < 4 ? cr0[j & 3] : cr1[j & 3], sr = j < 4 ? sr0[j & 3] : sr1[j & 3], cc = j < 4 ? cc0[j & 3] : cc1[j & 3], sc = j < 4 ? sc0[j & 3] : sc1[j & 3];
                        float o0 = (fq < 2) ? y0 * cr - p0 * sr : y0 * cr + p0 * sr, o1 = (fq < 2) ? y1 * cc - p1 * sc : y1 * cc + p1 * sc;
                        if (kind == 2) { o0 *= qscale; o1 *= qscale; }
                        x0[j] = o0; x1[j] = o1; }
                }
                bf16_t* rowp = pp + (size_t)row * 2816 + col0;
                u32x4 w; w.x = cvt_pk_bf16(x0[0], x0[1]); w.y = cvt_pk_bf16(x0[2], x0[3]); w.z = cvt_pk_bf16(x0[4], x0[5]); w.w = cvt_pk_bf16(x0[6], x0[7]);
                *(PG8_GAS u32x4*)rowp = w;
                w.x = cvt_pk_bf16(x1[0], x1[1]); w.y = cvt_pk_bf16(x1[2], x1[3]); w.z = cvt_pk_bf16(x1[4], x1[5]); w.w = cvt_pk_bf16(x1[6], x1[7]);
                *(PG8_GAS u32x4*)(rowp + 32) = w; }
        if (kind <= 1) {
#pragma unroll
            for (int o = 1; o < 16; o <<= 1) nmax = fmaxf(nmax, __int_as_float(__builtin_amdgcn_ds_bpermute((lane ^ o) << 2, __float_as_int(nmax))));
            if (lane == 0) __hip_atomic_fetch_max((PG8_GAS unsigned*)nrm + kind * 32 + ((u.pm * BM) >> 13) * 8 + (pt - (kind == 0 ? 2 : 4)) * 4 + wc, __float_as_uint(nmax), __ATOMIC_RELAXED, __HIP_MEMORY_SCOPE_AGENT);
        }
    }
};
struct EpiBf16Row {
    static constexpr bool PERM = true, AFTER_DRAIN = false;
    bf16_t* O; int ldc; const float* rs;
    __device__ __forceinline__ void operator()(const f32x4 (&acc)[2][2][4][2], const Unit& u, int wr, int wc, int fr, int fq) const {
        const int row0 = u.pm * BM + wr * 64 + fr; const int col0 = u.pn * BM + wc * 32 + 8 * fq;
        float rsv[2][4];
#pragma unroll
        for (int ai = 0; ai < 2; ++ai)
#pragma unroll
            for (int m = 0; m < 4; ++m) rsv[ai][m] = rs ? ((const PG8_GAS float*)rs)[row0 + ai * HALF + m * 16] : 1.0f;
#pragma unroll
        for (int ai = 0; ai < 2; ++ai)
#pragma unroll
            for (int m = 0; m < 4; ++m) { const int row = row0 + ai * HALF + m * 16; const float s = rsv[ai][m]; bf16_t* rowp = O + (size_t)row * ldc + col0;
#pragma unroll
                for (int bj = 0; bj < 2; ++bj) { const f32x4 v0 = acc[ai][bj][m][0] * s, v1 = acc[ai][bj][m][1] * s;
                    u32x4 w; w.x = cvt_pk_bf16(v0[0], v0[1]); w.y = cvt_pk_bf16(v0[2], v0[3]); w.z = cvt_pk_bf16(v1[0], v1[1]); w.w = cvt_pk_bf16(v1[2], v1[3]);
                    *(PG8_GAS u32x4*)(rowp + bj * HALF) = w; } }
    }
};
struct EpiBrTM {
    static constexpr bool PERM = true, AFTER_DRAIN = false;
    bf16_t* O;
    __device__ __forceinline__ void operator()(const f32x4 (&acc)[2][2][4][2], const Unit& u, int wr, int wc, int fr, int fq) const {
        bf16_t* tp = O + (size_t)(u.pm * 12 + u.pn) * 65536 + (size_t)(((wr * 4 + wc) * 64 + fq * 16 + fr) * 8);
#pragma unroll
        for (int ai = 0; ai < 2; ++ai)
#pragma unroll
            for (int m = 0; m < 4; ++m)
#pragma unroll
                for (int bj = 0; bj < 2; ++bj) { const f32x4 v0 = acc[ai][bj][m][0], v1 = acc[ai][bj][m][1];
                    u32x4 w; w.x = cvt_pk_bf16(v0[0], v0[1]); w.y = cvt_pk_bf16(v0[2], v0[3]); w.z = cvt_pk_bf16(v1[0], v1[1]); w.w = cvt_pk_bf16(v1[2], v1[3]);
                    *(PG8_GAS u32x4*)(tp + ((ai * 4 + m) * 2 + bj) * 4096) = w; }
    }
};
struct EpiGate {
    static constexpr bool PERM = true, AFTER_DRAIN = false;
    const bf16_t* Y; bf16_t* MG; const float* rstd; bf16_t* MT;
    __device__ __forceinline__ void operator()(const f32x4 (&acc)[2][2][4][2], const Unit& u, int wr, int wc, int fr, int fq) const {
        const int br = u.pn >> 2, cb = u.pn & 3;
        const size_t tmo = (size_t)(((wr * 4 + wc) * 64 + fq * 16 + fr) * 8); const bf16_t* yt = Y + (size_t)(u.pm * 12 + u.pn) * 65536 + tmo; bf16_t* mt = MT + (size_t)(u.pm * 4 + cb) * 65536 + tmo;
        const int row0 = u.pm * BM + wr * 64 + fr; const int ycol0 = u.pn * BM + wc * 32 + 8 * fq, mcol0 = cb * BM + wc * 32 + 8 * fq;
#pragma unroll
        for (int ai = 0; ai < 2; ++ai) {
            u32x4 yv[4][2], ov[4][2]; float sv[4];
#pragma unroll
            for (int m = 0; m < 4; ++m) { const int row = row0 + ai * HALF + m * 16; sv[m] = ((const PG8_GAS float*)rstd)[row];
#pragma unroll
                for (int bj = 0; bj < 2; ++bj) { yv[m][bj] = *(const PG8_GAS u32x4*)(yt + ((ai * 4 + m) * 2 + bj) * 4096);
                    if (br != 0) ov[m][bj] = *(const PG8_GAS u32x4*)(mt + ((ai * 4 + m) * 2 + bj) * 4096); else ov[m][bj] = (u32x4){0u, 0u, 0u, 0u}; } }
#pragma unroll
            for (int m = 0; m < 4; ++m) { const int row = row0 + ai * HALF + m * 16; const float s = sv[m];
#pragma unroll
                for (int bj = 0; bj < 2; ++bj) { const f32x4 v0 = acc[ai][bj][m][0] * s, v1 = acc[ai][bj][m][1] * s; const u32x4 y = yv[m][bj], o = ov[m][bj];
                    u32x4 w;
                    w.x = cvt_pk_bf16(sigmoidf_(v0[0]) * bflo(y.x) + bflo(o.x), sigmoidf_(v0[1]) * bfhi(y.x) + bfhi(o.x));
                    w.y = cvt_pk_bf16(sigmoidf_(v0[2]) * bflo(y.y) + bflo(o.y), sigmoidf_(v0[3]) * bfhi(y.y) + bfhi(o.y));
                    w.z = cvt_pk_bf16(sigmoidf_(v1[0]) * bflo(y.z) + bflo(o.z), sigmoidf_(v1[1]) * bfhi(y.z) + bfhi(o.z));
                    w.w = cvt_pk_bf16(sigmoidf_(v1[2]) * bflo(y.w) + bflo(o.w), sigmoidf_(v1[3]) * bfhi(y.w) + bfhi(o.w));
                    if (br == 2) PG8_ST16H(MG + (size_t)row * 1024 + mcol0 + bj * HALF, w); else PG8_ST16H(mt + ((ai * 4 + m) * 2 + bj) * 4096, w); } }
        }
    }
};
struct EpiResid {
    static constexpr bool PERM = false, AFTER_DRAIN = false;
    const float* src; float* out; int ldc;
    __device__ __forceinline__ void operator()(const f32x4 (&acc)[2][2][4][2], const Unit& u, int wr, int wc, int fr, int fq) const {
        const int col0 = u.pn * BM + wc * 32 + 4 * fq;
#pragma unroll
        for (int ai = 0; ai < 2; ++ai) { f32x4 bs[4][2][2];
#pragma unroll
            for (int m = 0; m < 4; ++m) { const size_t off = (size_t)(u.pm * BM + ai * HALF + wr * 64 + m * 16 + fr) * ldc + col0;
#pragma unroll
                for (int bj = 0; bj < 2; ++bj)
#pragma unroll
                    for (int n = 0; n < 2; ++n) bs[m][bj][n] = *(const PG8_GAS f32x4*)(src + off + bj * HALF + n * 16); }
#pragma unroll
            for (int m = 0; m < 4; ++m) { const size_t off = (size_t)(u.pm * BM + ai * HALF + wr * 64 + m * 16 + fr) * ldc + col0;
#pragma unroll
                for (int bj = 0; bj < 2; ++bj)
#pragma unroll
                    for (int n = 0; n < 2; ++n) *(PG8_GAS f32x4*)(out + off + bj * HALF + n * 16) = bs[m][bj][n] + acc[ai][bj][m][n]; } }
    }
};
struct EpiResidB {
    static constexpr bool PERM = true, AFTER_DRAIN = false;
    bf16_t* X; int ldc;
    __device__ __forceinline__ void operator()(const f32x4 (&acc)[2][2][4][2], const Unit& u, int wr, int wc, int fr, int fq) const {
        const int row0 = u.pm * BM + wr * 64 + fr; const int col0 = u.pn * BM + wc * 32 + 8 * fq;
#pragma unroll
        for (int ai = 0; ai < 2; ++ai) { u32x4 xs[4][2];
#pragma unroll
            for (int m = 0; m < 4; ++m)
#pragma unroll
                for (int bj = 0; bj < 2; ++bj) xs[m][bj] = *(const PG8_GAS u32x4*)(X + (size_t)(row0 + ai * HALF + m * 16) * ldc + col0 + bj * HALF);
#pragma unroll
            for (int m = 0; m < 4; ++m)
#pragma unroll
                for (int bj = 0; bj < 2; ++bj) { const f32x4 v0 = acc[ai][bj][m][0], v1 = acc[ai][bj][m][1]; const u32x4 a = xs[m][bj];
                    u32x4 w; w.x = cvt_pk_bf16(__uint_as_float(a.x << 16) + v0[0], __uint_as_float(a.x & 0xffff0000u) + v0[1]); w.y = cvt_pk_bf16(__uint_as_float(a.y << 16) + v0[2], __uint_as_float(a.y & 0xffff0000u) + v0[3]);
                    w.z = cvt_pk_bf16(__uint_as_float(a.z << 16) + v1[0], __uint_as_float(a.z & 0xffff0000u) + v1[1]); w.w = cvt_pk_bf16(__uint_as_float(a.w << 16) + v1[2], __uint_as_float(a.w & 0xffff0000u) + v1[3]);
                    PG8_ST16H(X + (size_t)(row0 + ai * HALF + m * 16) * ldc + col0 + bj * HALF, w); } }
    }
};
struct EpiMoe1 {
    static constexpr bool PERM = true, AFTER_DRAIN = false;
    bf16_t* H; const PG8_LAS float* rs;
    __device__ __forceinline__ void operator()(const f32x4 (&acc)[2][2][4][2], const Unit& u, int wr, int wc, int fr, int fq) const {
        const int lrow0 = wr * 64 + fr; const int col0 = u.pn * HALF + wc * 32 + 8 * fq;
#pragma unroll
        for (int ai = 0; ai < 2; ++ai)
#pragma unroll
            for (int m = 0; m < 4; ++m) { const int lrow = lrow0 + ai * HALF + m * 16; const float s = rs[u.ord * BM + lrow];
                float h[8];
#pragma unroll
                for (int n = 0; n < 2; ++n)
#pragma unroll
                    for (int e = 0; e < 4; ++e) { const float g = acc[ai][0][m][n][e] * s, uu = acc[ai][1][m][n][e] * s; h[n * 4 + e] = g * sigmoidf_(g) * uu; }
                u32x4 w; w.x = cvt_pk_bf16(h[0], h[1]); w.y = cvt_pk_bf16(h[2], h[3]); w.z = cvt_pk_bf16(h[4], h[5]); w.w = cvt_pk_bf16(h[6], h[7]);
                *(PG8_GAS u32x4*)(H + (size_t)(u.pm * BM + lrow) * 512 + col0) = w; }
    }
};
struct EpiMoe2 {
    static constexpr bool PERM = true, AFTER_DRAIN = false;
    bf16_t* O; const PG8_LAS float* ws;
    __device__ __forceinline__ void operator()(const f32x4 (&acc)[2][2][4][2], const Unit& u, int wr, int wc, int fr, int fq) const {
        const int lrow0 = wr * 64 + fr; const int col0 = u.pn * BM + wc * 32 + 8 * fq;
#pragma unroll
        for (int ai = 0; ai < 2; ++ai)
#pragma unroll
            for (int m = 0; m < 4; ++m) { const int lrow = lrow0 + ai * HALF + m * 16; const float s = ws[u.ord * BM + lrow]; bf16_t* rowp = O + (size_t)(u.pm * BM + lrow) * 1024 + col0;
#pragma unroll
                for (int bj = 0; bj < 2; ++bj) { const f32x4 v0 = acc[ai][bj][m][0] * s, v1 = acc[ai][bj][m][1] * s;
                    u32x4 w; w.x = cvt_pk_bf16(v0[0], v0[1]); w.y = cvt_pk_bf16(v0[2], v0[3]); w.z = cvt_pk_bf16(v1[0], v1[1]); w.w = cvt_pk_bf16(v1[2], v1[3]);
                    *(PG8_GAS u32x4*)(rowp + bj * HALF) = w; } }
    }
};
template <class Epi, class Sched, bool ALIGN_EPI = false, bool SP2 = false, bool GATHER = false>
__device__ __forceinline__ void gemm_phase(PG8_LAS unsigned char* lds, const Gemm g, const Sched& S, const Epi& E, const int tid_in) {
    int tid_o = tid_in; asm volatile("" : "+v"(tid_o));
    const int tid = tid_o, wid = __builtin_amdgcn_readfirstlane(tid >> 6), lane = tid & 63, wr = wid >> 2, wc = wid & 3, fr = lane & 15, fq = lane >> 4;
    const int K = g.K, nt = K / BK;
    static_assert(!GATHER || SP2, "GATHER is wired into the SP2 loop only");
    unsigned voffA[2], voffB[2]; int gR[2], gC[2];
#pragma unroll
    for (int i = 0; i < 2; ++i) { int R, C; stage_rc(tid * 16 + i * 8192, R, C); gR[i] = R; gC[i] = C; const int Rb = Epi::PERM ? ((R & ~31) + perm32(R & 31)) : R;
        voffA[i] = (unsigned)(R * g.lda + C) * 2u; voffB[i] = (unsigned)(Rb * g.ldb + C) * 2u; }
    const size_t kstep = (size_t)(BK * 2);
    const size_t hstepA = GATHER ? 0 : (size_t)HALF * g.lda * 2, hstepB = (size_t)HALF * g.ldb * 2;
    const size_t tstepA = GATHER ? 0 : 2 * hstepA, tstepB = 2 * hstepB;
    const unsigned ldsw = (unsigned)wid * 1024u;
    const int aoff = lds_byte(wr * 64 + fr, fq * 8), boff = lds_byte(wc * 32 + fr, fq * 8);
#define PG8_SA(b, h) (((b) * 2 + (h)) * HTB)
#define PG8_SB(b, h) ((4 + (b) * 2 + (h)) * HTB)
#define PG8_STAGE(bufoff, gbase, voff) do { _Pragma("unroll") for (int _i = 0; _i < 2; ++_i) \
        __builtin_amdgcn_global_load_lds((const unsigned*)((const char*)(gbase) + (voff)[_i]), (PG8_LAS unsigned*)(lds + (bufoff) + ldsw + _i * 8192), 16, 0, 0); } while (0)
#define PG8_LDA(dst, b, h) do { _Pragma("unroll") for (int m = 0; m < 4; ++m) _Pragma("unroll") for (int k = 0; k < 2; ++k) dst[m][k] = *(const PG8_LAS bf16x8*)(lds + PG8_SA(b, h) + aoff + m * 2048 + k * 1024); } while (0)
#define PG8_LDB(dst, b, h) do { _Pragma("unroll") for (int n = 0; n < 2; ++n) _Pragma("unroll") for (int k = 0; k < 2; ++k) dst[n][k] = *(const PG8_LAS bf16x8*)(lds + PG8_SB(b, h) + boff + n * 2048 + k * 1024); } while (0)
#define PG8_MMA(ai, bj, At, Bt) do { __builtin_amdgcn_s_setprio(1); _Pragma("unroll") for (int m = 0; m < 4; ++m) _Pragma("unroll") for (int n = 0; n < 2; ++n) _Pragma("unroll") for (int k = 0; k < 2; ++k) \
        acc[ai][bj][m][n] = __builtin_amdgcn_mfma_f32_16x16x32_bf16(Bt[n][k], At[m][k], acc[ai][bj][m][n], 0, 0, 0); __builtin_amdgcn_s_setprio(0); } while (0)
#define PG8_WAIT_V(n) asm volatile("s_waitcnt vmcnt(" #n ")" ::: "memory")
#define PG8_WAIT_L(n) asm volatile("s_waitcnt lgkmcnt(" #n ")" ::: "memory")
#define PG8_BAR __builtin_amdgcn_s_barrier()
#define PG8_SCHED __builtin_amdgcn_sched_barrier(0)
    Unit cur, nxt; int ui = 0;
    if (!S.next(0, cur)) return;
    f32x4 acc[2][2][4][2];
#pragma unroll
    for (int a = 0; a < 2; ++a)
#pragma unroll
        for (int b = 0; b < 2; ++b)
#pragma unroll
            for (int m = 0; m < 4; ++m)
#pragma unroll
                for (int n = 0; n < 2; ++n) acc[a][b][m][n] = (f32x4){0.f, 0.f, 0.f, 0.f};
    bf16x8 At[4][2], B0[2][2], B1[2][2];
    const char* cA = (const char*)g.A + (size_t)cur.pm * tstepA + cur.aoff; const char* cB = (const char*)g.Bt + (size_t)cur.pn * tstepB + cur.boff;
    unsigned cv0[2], cv1[2], nv0[2], nv1[2];
#define PG8_SETOFF(d0, d1, u) do { _Pragma("unroll") for (int i_ = 0; i_ < 2; ++i_) { if constexpr (GATHER) { d0[i_] = (unsigned)S.row(u, gR[i_]) * (unsigned)(g.lda * 2) + (unsigned)gC[i_] * 2u; d1[i_] = (unsigned)S.row(u, HALF + gR[i_]) * (unsigned)(g.lda * 2) + (unsigned)gC[i_] * 2u; } else { d0[i_] = voffA[i_]; d1[i_] = voffA[i_]; } } } while (0)
    PG8_SETOFF(cv0, cv1, cur); PG8_SETOFF(nv0, nv1, cur);
    S.a_ready(cur);
    if constexpr (SP2) {
        PG8_STAGE(PG8_SB(0, 0), cB, voffB); PG8_STAGE(PG8_SB(0, 1), cB + hstepB, voffB); PG8_STAGE(PG8_SA(0, 0), cA, cv0); PG8_STAGE(PG8_SA(0, 1), cA + hstepA, cv1);
        if (wr == 1) PG8_BAR;
        PG8_WAIT_V(2); PG8_BAR;
        PG8_STAGE(PG8_SB(1, 0), cB + kstep, voffB); PG8_STAGE(PG8_SA(1, 0), cA + kstep, cv0); PG8_STAGE(PG8_SB(1, 1), cB + hstepB + kstep, voffB);
        PG8_WAIT_V(6); PG8_BAR;
    } else {
        PG8_STAGE(PG8_SB(0, 0), cB, voffB); PG8_STAGE(PG8_SA(0, 0), cA, voffA); PG8_STAGE(PG8_SB(0, 1), cB + hstepB, voffB); PG8_STAGE(PG8_SA(0, 1), cA + hstepA, voffA);
        if (wr == 1) PG8_BAR;
        PG8_WAIT_V(4); PG8_BAR;
        PG8_STAGE(PG8_SB(1, 0), cB + kstep, voffB); PG8_STAGE(PG8_SA(1, 0), cA + kstep, voffA); PG8_STAGE(PG8_SB(1, 1), cB + hstepB + kstep, voffB);
        PG8_WAIT_V(6); PG8_BAR;
    }
    for (;;) {
        const bool has_next = S.next(ui + 1, nxt);
        if constexpr (GATHER) { if (has_next) PG8_SETOFF(nv0, nv1, nxt); else { _Pragma("unroll") for (int i = 0; i < 2; ++i) { nv0[i] = cv0[i]; nv1[i] = cv1[i]; } } }
        const char* nA = has_next ? (const char*)g.A + (size_t)nxt.pm * tstepA + nxt.aoff : cA; const char* nB = has_next ? (const char*)g.Bt + (size_t)nxt.pn * tstepB + nxt.boff : cB;
        for (int t = 0; t < nt; t += 2) {
            const bool last = (t == nt - 2);
            unsigned s0[2], s1[2];
#pragma unroll
            for (int i = 0; i < 2; ++i) { s0[i] = last ? nv0[i] : cv0[i]; s1[i] = last ? nv1[i] : cv1[i]; }
            const char* a1 = cA + (size_t)(t + 1) * kstep;
            const char* a2 = last ? nA : cA + (size_t)(t + 2) * kstep; const char* b2 = last ? nB : cB + (size_t)(t + 2) * kstep;
            const char* a3 = a2 + kstep; const char* b3 = b2 + kstep;
            if (last && has_next) S.a_ready(nxt);
            if constexpr (SP2) {
            PG8_LDB(B0, 0, 0); PG8_LDB(B1, 0, 1); PG8_SCHED; PG8_LDA(At, 0, 0); PG8_STAGE(PG8_SA(1, 1), a1 + hstepA, cv1);
            PG8_WAIT_V(8); PG8_WAIT_L(0); PG8_BAR; PG8_MMA(0, 0, At, B0); PG8_MMA(0, 1, At, B1); PG8_BAR; PG8_SCHED;
            PG8_LDA(At, 0, 1); PG8_STAGE(PG8_SB(0, 0), b2, voffB); PG8_STAGE(PG8_SB(0, 1), b2 + hstepB, voffB); PG8_STAGE(PG8_SA(0, 0), a2, s0);
            PG8_WAIT_V(8); PG8_WAIT_L(0); PG8_BAR; PG8_MMA(1, 0, At, B0); PG8_MMA(1, 1, At, B1); PG8_BAR; PG8_SCHED;
            PG8_LDB(B0, 1, 0); PG8_LDB(B1, 1, 1); PG8_SCHED; PG8_LDA(At, 1, 0); PG8_STAGE(PG8_SA(0, 1), a2 + hstepA, s1);
            PG8_WAIT_V(8); PG8_WAIT_L(0); PG8_BAR; PG8_MMA(0, 0, At, B0); PG8_MMA(0, 1, At, B1); PG8_BAR; PG8_SCHED;
            PG8_LDA(At, 1, 1); PG8_STAGE(PG8_SB(1, 0), b3, voffB); PG8_STAGE(PG8_SB(1, 1), b3 + hstepB, voffB); PG8_STAGE(PG8_SA(1, 0), a3, s0);
            PG8_WAIT_V(8); PG8_WAIT_L(0); PG8_BAR; PG8_MMA(1, 0, At, B0); PG8_MMA(1, 1, At, B1); PG8_BAR; PG8_SCHED;
            } else {
            PG8_LDB(B0, 0, 0); PG8_SCHED; PG8_LDA(At, 0, 0); PG8_STAGE(PG8_SA(1, 1), a1 + hstepA, voffA);
            PG8_WAIT_L(8); PG8_BAR; PG8_WAIT_L(0); PG8_MMA(0, 0, At, B0); PG8_BAR; PG8_SCHED;
            PG8_LDB(B1, 0, 1); PG8_STAGE(PG8_SB(0, 0), b2, voffB);
            PG8_BAR; PG8_WAIT_L(0); PG8_MMA(0, 1, At, B1); PG8_BAR;
            PG8_LDA(At, 0, 1); PG8_STAGE(PG8_SA(0, 0), a2, voffA);
            PG8_BAR; PG8_WAIT_L(0); PG8_MMA(1, 0, At, B0); PG8_BAR; PG8_SCHED;
            PG8_STAGE(PG8_SB(0, 1), b2 + hstepB, voffB);
            PG8_WAIT_V(6); PG8_BAR; PG8_MMA(1, 1, At, B1); PG8_BAR;
            PG8_LDB(B0, 1, 0); PG8_SCHED; PG8_LDA(At, 1, 0); PG8_STAGE(PG8_SA(0, 1), a2 + hstepA, voffA);
            PG8_WAIT_L(8); PG8_BAR; PG8_WAIT_L(0); PG8_MMA(0, 0, At, B0); PG8_BAR; PG8_SCHED;
            PG8_LDB(B1, 1, 1); PG8_STAGE(PG8_SB(1, 0), b3, voffB);
            PG8_BAR; PG8_WAIT_L(0); PG8_MMA(0, 1, At, B1); PG8_BAR;
            PG8_LDA(At, 1, 1); PG8_STAGE(PG8_SA(1, 0), a3, voffA);
            PG8_BAR; PG8_WAIT_L(0); PG8_MMA(1, 0, At, B0); PG8_BAR; PG8_SCHED;
            PG8_STAGE(PG8_SB(1, 1), b3 + hstepB, voffB);
            PG8_WAIT_V(6); PG8_BAR; PG8_MMA(1, 1, At, B1); PG8_BAR;
            }
        }
        if constexpr (ALIGN_EPI) { if (wr == 0) PG8_BAR; }
        if constexpr (!Epi::AFTER_DRAIN) { E(acc, cur, wr, wc, fr, fq); S.done(cur); }
        if (!has_next) break;
#pragma unroll
        for (int a = 0; a < 2; ++a)
#pragma unroll
            for (int b = 0; b < 2; ++b)
#pragma unroll
                for (int m = 0; m < 4; ++m)
#pragma unroll
                    for (int n = 0; n < 2; ++n) acc[a][b][m][n] = (f32x4){0.f, 0.f, 0.f, 0.f};
        cur = nxt; cA = nA; cB = nB; ++ui;
#pragma unroll
        for (int i = 0; i < 2; ++i) { cv0[i] = nv0[i]; cv1[i] = nv1[i]; }
        if constexpr (ALIGN_EPI) { if (wr == 1) PG8_BAR; }
    }
    PG8_WAIT_V(0);
    if constexpr (!ALIGN_EPI) { if (wr == 0) PG8_BAR; }
    PG8_BAR;
    if constexpr (Epi::AFTER_DRAIN) { E.fused(acc, cur, wr, wc, fr, fq, lds, wid, lane); S.done(cur); }
#undef PG8_SA
#undef PG8_SB
#undef PG8_STAGE
#undef PG8_SETOFF
#undef PG8_LDA
#undef PG8_LDB
#undef PG8_MMA
#undef PG8_WAIT_V
#undef PG8_WAIT_L
#undef PG8_BAR
#undef PG8_SCHED
}
}
#include <hip/hip_bf16.h>
#include <cmath>
namespace attn_body {
using bf16=__hip_bfloat16;
using bf16x8=__attribute__((ext_vector_type(8)))short;
using s16x4=__attribute__((ext_vector_type(4)))short;
using f32x16=__attribute__((ext_vector_type(16)))float;
using u32x4=__attribute__((ext_vector_type(4)))unsigned;
constexpr int SEQ=8192,D=64,DM=2816;
constexpr int NW=8,QBLK=32,QB=QBLK*NW,KVBLK=64,NQB=SEQ/QB;
constexpr int ATTN_PITCH=DM, ATTN_UNIT_ROWS=QB;
__device__ __forceinline__ int crow(int r,int hi){return (r&3)+8*(r>>2)+4*hi;}
#define SBAR() __builtin_amdgcn_sched_barrier(0)
__device__ __forceinline__ void cmask(f32x16&p0,f32x16&p1,int jb,int qrel,int hi){
  const float NEG=-INFINITY; int kb=64*jb+4*hi;
  #pragma unroll
  for(int r=0;r<16;++r){int kv=kb+(r&3)+8*(r>>2); if(kv>qrel)p0[r]=NEG; if(kv+32>qrel)p1[r]=NEG;}
}

constexpr int NSLOT=3, SLOTB=8192;
constexpr int LDS_K=0, LDS_V=NSLOT*SLOTB;
constexpr int LDS_BYTES=LDS_V+NSLOT*16384+NW*64*4+NW*4096;
constexpr float C2=0.125f*1.4426950408889634f;
__device__ __forceinline__ void glds16(const void*gsrc,unsigned lds_dst){unsigned keep;
  asm volatile("s_mov_b32 %0, m0\n\ts_mov_b32 m0, %2\n\ts_nop 0\n\tglobal_load_lds_dwordx4 %1, off\n\ts_mov_b32 m0, %0":"=&s"(keep):"v"(gsrc),"s"(lds_dst):"memory");}
__device__ __forceinline__ void glds16s(unsigned voff,const void*sbase,unsigned lds_dst){unsigned keep;
  asm volatile("s_mov_b32 %0, m0\n\ts_mov_b32 m0, %3\n\ts_nop 0\n\tglobal_load_lds_dwordx4 %1, %2\n\ts_mov_b32 m0, %0":"=&s"(keep):"v"(voff),"s"(sbase),"s"(lds_dst):"memory");}
__device__ __forceinline__ float max3f(float a,float b,float c){float r;asm("v_max3_f32 %0, %1, %2, %3":"=v"(r):"v"(a),"v"(b),"v"(c));return r;}
__device__ __forceinline__ float max2f(float a,float b){float r;asm("v_max_f32_e32 %0, %1, %2":"=v"(r):"v"(a),"v"(b));return r;}
__device__ __forceinline__ float fadd_s(float a,float b){float r;asm("v_add_f32_e32 %0, %1, %2":"=v"(r):"v"(a),"v"(b));return r;}
__device__ __forceinline__ float fsub_s(float a,float b){float r;asm("v_sub_f32_e32 %0, %1, %2":"=v"(r):"v"(a),"v"(b));return r;}
typedef float f32x2_t __attribute__((ext_vector_type(2))); typedef __bf16 bf16x2_t __attribute__((ext_vector_type(2)));
__device__ __forceinline__ unsigned cvtpk_s(float lo,float hi){f32x2_t v={lo,hi};bf16x2_t b=__builtin_convertvector(v,bf16x2_t);return __builtin_bit_cast(unsigned,b);}
#define WAIT_BAR(N) asm volatile("s_waitcnt vmcnt(" #N ") lgkmcnt(0)\n\ts_barrier":::"memory")

typedef __attribute__((address_space(3))) const char* lds_cptr;
__device__ __forceinline__ void qkt(f32x16&p0,f32x16&p1,lds_cptr Kslot,const bf16x8*qr,const f32x16&negm,int r32,int hi){
  const lds_cptr kb=Kslot+hi*1024+r32*16;
  #pragma unroll
  for(int d0=0;d0<4;++d0){
    const bf16x8 b0=*(const __attribute__((address_space(3))) bf16x8*)(kb+d0*2048);
    const bf16x8 b1=*(const __attribute__((address_space(3))) bf16x8*)(kb+d0*2048+512);
    if(d0==0){p0=__builtin_amdgcn_mfma_f32_32x32x16_bf16(b0,qr[0],negm,0,0,0);p1=__builtin_amdgcn_mfma_f32_32x32x16_bf16(b1,qr[0],negm,0,0,0);}
    else{p0=__builtin_amdgcn_mfma_f32_32x32x16_bf16(b0,qr[d0],p0,0,0,0);p1=__builtin_amdgcn_mfma_f32_32x32x16_bf16(b1,qr[d0],p1,0,0,0);}}
}
typedef short v4i16_t __attribute__((ext_vector_type(4)));
__device__ __forceinline__ void kload8(bf16x8*kf,lds_cptr kp){
  kf[0]=*(const __attribute__((address_space(3))) bf16x8*)(kp);      kf[1]=*(const __attribute__((address_space(3))) bf16x8*)(kp+512);
  kf[2]=*(const __attribute__((address_space(3))) bf16x8*)(kp+2048); kf[3]=*(const __attribute__((address_space(3))) bf16x8*)(kp+2560);
  kf[4]=*(const __attribute__((address_space(3))) bf16x8*)(kp+4096); kf[5]=*(const __attribute__((address_space(3))) bf16x8*)(kp+4608);
  kf[6]=*(const __attribute__((address_space(3))) bf16x8*)(kp+6144); kf[7]=*(const __attribute__((address_space(3))) bf16x8*)(kp+6656);
}
__device__ __forceinline__ void kload2(bf16x8*kf,lds_cptr kp,int j){ kf[2*j]=*(const __attribute__((address_space(3))) bf16x8*)(kp+j*2048); kf[2*j+1]=*(const __attribute__((address_space(3))) bf16x8*)(kp+j*2048+512); }
__device__ __forceinline__ s16x4 vtr(lds_cptr p){ return __builtin_bit_cast(s16x4,__builtin_amdgcn_ds_read_tr16_b64_v4i16((__attribute__((address_space(3))) v4i16_t*)p)); }
__device__ __forceinline__ float rowmax(const f32x16&p0,const f32x16&p1){
  float a=max3f(p0[0],p0[1],p1[0]),b=max3f(p0[2],p0[3],p1[1]);a=max3f(a,p1[2],p1[3]);
  #pragma unroll
  for(int r=4;r<16;r+=4){a=max3f(a,p0[r],p0[r+1]);b=max3f(b,p0[r+2],p0[r+3]);a=max3f(a,p1[r],p1[r+1]);b=max3f(b,p1[r+2],p1[r+3]);}
  const float m=max2f(a,b);
  auto rr=__builtin_amdgcn_permlane32_swap(__float_as_uint(m),__float_as_uint(m),false,false);
  return max2f(__uint_as_float(rr[0]),__uint_as_float(rr[1]));
}
template<int NDB> __device__ __forceinline__ void pv(f32x16*o,int vb,bf16x8 pa0,bf16x8 pa1,bf16x8 pa2,bf16x8 pa3){
  #pragma unroll
  for(int d0=0;d0<NDB;++d0){s16x4 lo[4],hi[4];
    #pragma unroll
    for(int ks=0;ks<4;++ks){
      asm volatile("ds_read_b64_tr_b16 %0,%1 offset:%c2":"=&v"(lo[ks]):"v"(vb),"i"(d0*4096+ks*1024):"memory");
      asm volatile("ds_read_b64_tr_b16 %0,%1 offset:%c2":"=&v"(hi[ks]):"v"(vb),"i"(d0*4096+ks*1024+512):"memory");}
    asm volatile("s_waitcnt lgkmcnt(0)":::"memory");SBAR();
    #define PK(k) (bf16x8){lo[k][0],lo[k][1],lo[k][2],lo[k][3],hi[k][0],hi[k][1],hi[k][2],hi[k][3]}
    o[d0]=__builtin_amdgcn_mfma_f32_32x32x16_bf16(pa0,PK(0),o[d0],0,0,0);
    o[d0]=__builtin_amdgcn_mfma_f32_32x32x16_bf16(pa1,PK(1),o[d0],0,0,0);
    o[d0]=__builtin_amdgcn_mfma_f32_32x32x16_bf16(pa2,PK(2),o[d0],0,0,0);
    o[d0]=__builtin_amdgcn_mfma_f32_32x32x16_bf16(pa3,PK(3),o[d0],0,0,0);
    #undef PK
  }
}

#ifndef ATTN_STORE16
#define ATTN_STORE16(p,v) (*(__attribute__((address_space(1))) u32x4*)(p)=(v))
#endif
template<int THRL,int NDB,bool FIXREF=false> __device__ __forceinline__ void attn_unit(int qb,const bf16*Qb,const bf16*__restrict__ Kb,const bf16*__restrict__ Vb,bf16*Ob,int opitch,char*shm,const int tid_in,const float negref=0.f){
  int tid_o=tid_in; asm volatile("":"+v"(tid_o));
  const int tid=tid_o,lane=tid&63,r32=lane&31,hi=lane>>5; const int wid=__builtin_amdgcn_readfirstlane(tid>>6);
  constexpr int VSLOTB=NDB*4096, LDS_WS=LDS_V+NSLOT*VSLOTB, LDS_OST=LDS_WS+NW*64*4;
  const int q0=qb*QB;
  const bf16*Qw=Qb+(long)(q0+wid*QBLK)*DM;
  const bf16*Kh=Kb,*Vh=Vb;
  const unsigned lds0=(unsigned)(uintptr_t)shm;
  __attribute__((address_space(3))) float*wsf=(__attribute__((address_space(3))) float*)((lds_cptr)shm+LDS_WS)+wid*64;
  const unsigned ksrc=(unsigned)((lane*DM+wid*8)*2);
  const unsigned vsrc=(unsigned)(((16*(wid&3)+(lane>>2))*DM+(wid>>2)*32+(lane&3)*8)*2);
  const unsigned kdst=lds0+LDS_K+wid*1024, vdst=lds0+LDS_V+wid*1024;
  #define DMA_K(t,slot) glds16s(ksrc,(const char*)Kh+(long)(t)*(KVBLK*DM*2),(unsigned)__builtin_amdgcn_readfirstlane(kdst+(slot)))
  #define DMA_V(t,slot) do{ glds16s(vsrc,(const char*)Vh+(long)(t)*(KVBLK*DM*2),(unsigned)__builtin_amdgcn_readfirstlane(vdst+(slot)*(VSLOTB/SLOTB))); if(NDB==4) glds16s(vsrc,(const char*)Vh+(long)(t)*(KVBLK*DM*2)+128,(unsigned)__builtin_amdgcn_readfirstlane(vdst+(slot)*(VSLOTB/SLOTB)+8192)); }while(0)
  const int vb0=(int)(lds0+LDS_V)+((lane>>4)&1)*32+(lane&3)*8+(4*hi+((lane&15)>>2))*64;
  const lds_cptr Kbase=(lds_cptr)shm+LDS_K; bf16x8 kf[8];
  const lds_cptr shm3=(lds_cptr)shm; const lds_cptr kp0=shm3+LDS_K+hi*1024+r32*16; const lds_cptr vp0=shm3+LDS_V+((lane>>4)&1)*32+(lane&3)*8+(4*hi+((lane&15)>>2))*64;
  constexpr int NT=SEQ/KVBLK;
  DMA_K(0,0);DMA_V(0,0);DMA_K(1,SLOTB);
  bf16x8 qr[4];
  #pragma unroll
  for(int d0=0;d0<4;++d0)qr[d0]=*(const __attribute__((address_space(1))) bf16x8*)(&Qw[(long)r32*DM+d0*16+hi*8]);
  float mhat=0.f,l_reg=0.f;f32x16 o[NDB];_Pragma("unroll") for(int d_=0;d_<NDB;++d_)o[d_]=f32x16{};f32x16 negm=f32x16{}; if(FIXREF){_Pragma("unroll") for(int r=0;r<16;++r)negm[r]=negref;} asm volatile("":"+v"(negm));
  #define CMASK(P0,P1,t) do{}while(0)
  bool resc=false;
  #define START(P0,P1) do{ resc=false; if(!FIXREF){ const float rm=rowmax(P0,P1); \
    { const float dl=rm; mhat=fadd_s(mhat,dl); \
      _Pragma("unroll") for(int r=0;r<16;++r){P0[r]=fsub_s(P0[r],dl);P1[r]=fsub_s(P1[r],dl);} \
      _Pragma("unroll") for(int r=0;r<16;++r)negm[r]=-mhat; asm volatile("":"+v"(negm)); } } \
    _Pragma("unroll") for(int r=0;r<16;++r)P0[r]=__builtin_amdgcn_exp2f(P0[r]); }while(0)
  #define RESC() do{ if(!FIXREF&&resc){ asm volatile("s_waitcnt lgkmcnt(0)":::"memory"); \
      _Pragma("unroll") for(int d_=0;d_<NDB;++d_) _Pragma("unroll") for(int r=0;r<16;++r)o[d_][r]*=wsf[crow(r,hi)]; } }while(0)
  f32x16 pA0,pA1,pB0,pB1;
  #define WAIT_KV() do{ if(NDB==4){WAIT_BAR(3);}else{WAIT_BAR(2);} }while(0)
  #define WAIT_V() do{ if(NDB==4){WAIT_BAR(2);}else{WAIT_BAR(1);} }while(0)
  int sl_prev=0,sl_cur=0,sl_next=SLOTB;
  #define ROT() do{sl_prev=sl_cur;sl_cur=sl_next;sl_next=(sl_next==(NSLOT-1)*SLOTB)?0:sl_next+SLOTB;}while(0)
  DMA_K(2,2*SLOTB);
  WAIT_BAR(3);
  qkt(pA0,pA1,Kbase,qr,negm,r32,hi);asm volatile("s_nop 15\n\ts_nop 7":"+v"(pA0),"+v"(pA1));CMASK(pA0,pA1,0);
  START(pA0,pA1);
  _Pragma("unroll") for(int r=0;r<16;++r)pA1[r]=__builtin_amdgcn_exp2f(pA1[r]);
  WAIT_BAR(0);
  DMA_K(3,0);DMA_V(1,SLOTB);
  ROT();
  kload8(kf,kp0+sl_cur);
  WAIT_KV();
  s16x4 vlo[8],vhi[8]; u32x4 pw0,pw1,pw2,pw3;
  #define PKW(P,B) cvtpk_s(P[B],P[B+1])
  #define PAF(k) __builtin_bit_cast(bf16x8,pw##k)
  #define VFR(i) (bf16x8){vlo[i][0],vlo[i][1],vlo[i][2],vlo[i][3],vhi[i][0],vhi[i][1],vhi[i][2],vhi[i][3]}
  #define PIN(x) asm volatile("":"+v"(x))
  #define MX3(a,b,c) __builtin_fmaxf(__builtin_fmaxf((a),(b)),(c))
  #define GAPA(MF,A0,A1,A2,A3,W0,W1,PW) do{ MF; sacc+=A0; sacc+=A1; sacc+=A2; sacc+=A3; PIN(sacc); W0; W1; PIN(PW); SBAR(); }while(0)
  #define EX(v) __builtin_amdgcn_exp2f(v)
  #define GAPB(MF,X,B) do{ MF; X[B]=EX(X[B]); X[B+1]=EX(X[B+1]); X[B+2]=EX(X[B+2]); X[B+3]=EX(X[B+3]); PIN(X); SBAR(); }while(0)
  #define GAPB2(MF,X,B) do{ MF; X[B]=EX(X[B]); X[B+1]=EX(X[B+1]); PIN(X); SBAR(); }while(0)
  #define VRDX(s,ks,db) do{ vlo[s]=vtr(vp_+((db)*4096+(ks)*1024)); vhi[s]=vtr(vp_+((db)*4096+(ks)*1024+512)); }while(0)
  #define VRDA(i) do{ if(NDB==2){VRD(i);} else if(((i)&3)<2){ VRDX(2*((i)&3)+((i)>>2),(i)&3,(i)>>2); } }while(0)
  #define VRD(i) do{ vlo[i]=vtr(vp_+(((i)>>2)*4096+((i)&3)*1024)); vhi[i]=vtr(vp_+(((i)>>2)*4096+((i)&3)*1024+512)); }while(0)
  #define KRD(G,j) do{ if(G){ kload2(kf,kp0+sl_next,j); SBAR(); } }while(0)
  #define STEP(C0,C1,P0,P1,t,GK,GV,GL) do{ SBAR(); \
    const lds_cptr vp_=vp0+sl_prev*(VSLOTB/SLOTB); \
    VRDA(0); SBAR(); float sacc=(P0[0]+P0[1]); \
    GAPA(C0=__builtin_amdgcn_mfma_f32_32x32x16_bf16(kf[0],qr[0],negm,0,0,0), P0[2],P0[3],P0[4],P0[5],     pw0[0]=PKW(P0,0), pw0[1]=PKW(P0,2), pw0); \
    VRDA(4); SBAR(); GAPA(C1=__builtin_amdgcn_mfma_f32_32x32x16_bf16(kf[1],qr[0],negm,0,0,0), P0[6],P0[7],P0[8],P0[9],     pw0[2]=PKW(P0,4), pw0[3]=PKW(P0,6), pw0); \
    VRDA(1); SBAR(); GAPA(C0=__builtin_amdgcn_mfma_f32_32x32x16_bf16(kf[2],qr[1],C0,0,0,0),   P0[10],P0[11],P0[12],P0[13], pw1[0]=PKW(P0,8), pw1[1]=PKW(P0,10), pw1); \
    VRDA(5); SBAR(); GAPA(C1=__builtin_amdgcn_mfma_f32_32x32x16_bf16(kf[3],qr[1],C1,0,0,0),   P0[14],P0[15],P1[0],P1[1],   pw1[2]=PKW(P0,12),pw1[3]=PKW(P0,14), pw1); \
    VRDA(2); SBAR(); GAPA(C0=__builtin_amdgcn_mfma_f32_32x32x16_bf16(kf[4],qr[2],C0,0,0,0),   P1[2],P1[3],P1[4],P1[5],     pw2[0]=PKW(P1,0), pw2[1]=PKW(P1,2), pw2); \
    VRDA(6); SBAR(); GAPA(C1=__builtin_amdgcn_mfma_f32_32x32x16_bf16(kf[5],qr[2],C1,0,0,0),   P1[6],P1[7],P1[8],P1[9],     pw2[2]=PKW(P1,4), pw2[3]=PKW(P1,6), pw2); \
    VRDA(3); SBAR(); GAPA(C0=__builtin_amdgcn_mfma_f32_32x32x16_bf16(kf[6],qr[3],C0,0,0,0),   P1[10],P1[11],P1[12],P1[13], pw3[0]=PKW(P1,8), pw3[1]=PKW(P1,10), pw3); \
    VRDA(7); SBAR(); GAPA(C1=__builtin_amdgcn_mfma_f32_32x32x16_bf16(kf[7],qr[3],C1,0,0,0),   P1[14],P1[15],0.f,0.f,       pw3[2]=PKW(P1,12),pw3[3]=PKW(P1,14), pw3); \
    l_reg+=sacc; \
    if(GK){DMA_K((t)+3,sl_cur);} if(GV){DMA_V((t)+1,sl_next);} \
    CMASK(C0,C1,t); \
    if(!FIXREF){ float a=MX3(C0[0],C0[1],C1[0]),b=MX3(C0[2],C0[3],C1[1]); a=MX3(a,C1[2],C1[3]); \
      _Pragma("unroll") for(int r=4;r<16;r+=4){a=MX3(a,C0[r],C0[r+1]);b=MX3(b,C0[r+2],C0[r+3]);a=MX3(a,C1[r],C1[r+1]);b=MX3(b,C1[r+2],C1[r+3]);} \
      float rm=__builtin_fmaxf(a,b); { auto rr=__builtin_amdgcn_permlane32_swap(__float_as_uint(rm),__float_as_uint(rm),false,false); rm=__builtin_fmaxf(__uint_as_float(rr[0]),__uint_as_float(rr[1])); } \
      resc=false; \
      if(__builtin_expect(__any(rm>(float)THRL),0)){ const float dl=__builtin_fmaxf(rm,0.f); mhat+=dl; \
        _Pragma("unroll") for(int r=0;r<16;++r){C0[r]-=dl;C1[r]-=dl;} \
        _Pragma("unroll") for(int r=0;r<16;++r)negm[r]=-mhat; asm volatile("":"+v"(negm)); \
        const float f=__builtin_amdgcn_exp2f(-dl); l_reg*=f; if(hi==0)wsf[r32]=f; resc=true; } } \
    SBAR(); \
    if(NDB==2){ \
    GAPB(o[0]=__builtin_amdgcn_mfma_f32_32x32x16_bf16(PAF(0),VFR(0),o[0],0,0,0), C0,0); \
    GAPB(o[1]=__builtin_amdgcn_mfma_f32_32x32x16_bf16(PAF(0),VFR(4),o[1],0,0,0), C0,4); \
    KRD(GL,0); GAPB(o[0]=__builtin_amdgcn_mfma_f32_32x32x16_bf16(PAF(1),VFR(1),o[0],0,0,0), C0,8); \
    KRD(GL,1); GAPB(o[1]=__builtin_amdgcn_mfma_f32_32x32x16_bf16(PAF(1),VFR(5),o[1],0,0,0), C0,12); \
    KRD(GL,2); GAPB(o[0]=__builtin_amdgcn_mfma_f32_32x32x16_bf16(PAF(2),VFR(2),o[0],0,0,0), C1,0); \
    KRD(GL,3); GAPB(o[1]=__builtin_amdgcn_mfma_f32_32x32x16_bf16(PAF(2),VFR(6),o[1],0,0,0), C1,4); \
    GAPB(o[0]=__builtin_amdgcn_mfma_f32_32x32x16_bf16(PAF(3),VFR(3),o[0],0,0,0), C1,8); \
    GAPB(o[1]=__builtin_amdgcn_mfma_f32_32x32x16_bf16(PAF(3),VFR(7),o[1],0,0,0), C1,12); \
    } else { \
    GAPB2(o[0]=__builtin_amdgcn_mfma_f32_32x32x16_bf16(PAF(0),VFR(0),o[0],0,0,0), C0,0); VRDX(0,2,0); SBAR(); \
    GAPB2(o[1]=__builtin_amdgcn_mfma_f32_32x32x16_bf16(PAF(0),VFR(1),o[1],0,0,0), C0,2); VRDX(1,2,1); SBAR(); \
    GAPB2(o[0]=__builtin_amdgcn_mfma_f32_32x32x16_bf16(PAF(1),VFR(2),o[0],0,0,0), C0,4); VRDX(2,3,0); SBAR(); \
    GAPB2(o[1]=__builtin_amdgcn_mfma_f32_32x32x16_bf16(PAF(1),VFR(3),o[1],0,0,0), C0,6); VRDX(3,3,1); SBAR(); \
    GAPB2(o[0]=__builtin_amdgcn_mfma_f32_32x32x16_bf16(PAF(2),VFR(0),o[0],0,0,0), C0,8); VRDX(0,0,2); SBAR(); \
    GAPB2(o[1]=__builtin_amdgcn_mfma_f32_32x32x16_bf16(PAF(2),VFR(1),o[1],0,0,0), C0,10); VRDX(1,0,3); SBAR(); \
    GAPB2(o[0]=__builtin_amdgcn_mfma_f32_32x32x16_bf16(PAF(3),VFR(2),o[0],0,0,0), C0,12); VRDX(2,1,2); SBAR(); \
    GAPB2(o[1]=__builtin_amdgcn_mfma_f32_32x32x16_bf16(PAF(3),VFR(3),o[1],0,0,0), C0,14); VRDX(3,1,3); SBAR(); \
    GAPB2(o[2]=__builtin_amdgcn_mfma_f32_32x32x16_bf16(PAF(0),VFR(0),o[2],0,0,0), C1,0); VRDX(0,2,2); SBAR(); \
    GAPB2(o[3]=__builtin_amdgcn_mfma_f32_32x32x16_bf16(PAF(0),VFR(1),o[3],0,0,0), C1,2); VRDX(1,2,3); SBAR(); \
    GAPB2(o[2]=__builtin_amdgcn_mfma_f32_32x32x16_bf16(PAF(1),VFR(2),o[2],0,0,0), C1,4); VRDX(2,3,2); SBAR(); \
    GAPB2(o[3]=__builtin_amdgcn_mfma_f32_32x32x16_bf16(PAF(1),VFR(3),o[3],0,0,0), C1,6); VRDX(3,3,3); SBAR(); \
    KRD(GL,0); GAPB2(o[2]=__builtin_amdgcn_mfma_f32_32x32x16_bf16(PAF(2),VFR(0),o[2],0,0,0), C1,8); \
    KRD(GL,1); GAPB2(o[3]=__builtin_amdgcn_mfma_f32_32x32x16_bf16(PAF(2),VFR(1),o[3],0,0,0), C1,10); \
    KRD(GL,2); GAPB2(o[2]=__builtin_amdgcn_mfma_f32_32x32x16_bf16(PAF(3),VFR(2),o[2],0,0,0), C1,12); \
    KRD(GL,3); GAPB2(o[3]=__builtin_amdgcn_mfma_f32_32x32x16_bf16(PAF(3),VFR(3),o[3],0,0,0), C1,14); \
    } \
    }while(0)
  int t=1;
  #undef CMASK
  #define CMASK(P0,P1,t) do{}while(0)
  for(;t+5<NT;t+=2){
    STEP(pB0,pB1,pA0,pA1,t,true,true,true);     WAIT_KV(); RESC(); ROT();
    STEP(pA0,pA1,pB0,pB1,t+1,true,true,true);   WAIT_KV(); RESC(); ROT();
  }
  #undef CMASK
  #define CMASK(P0,P1,t) do{}while(0)
  #define ENDW(tt) do{ if((tt)+3<NT){WAIT_KV();} else if((tt)+2<NT){WAIT_V();} else {WAIT_BAR(0);} }while(0)
  for(;t+1<NT;t+=2){
    STEP(pB0,pB1,pA0,pA1,t,(t+3<NT),(t+1<NT),(t+1<NT));       ENDW(t);   RESC(); ROT();
    STEP(pA0,pA1,pB0,pB1,t+1,(t+4<NT),(t+2<NT),(t+2<NT));     ENDW(t+1); RESC(); ROT();
  }
  STEP(pB0,pB1,pA0,pA1,NT-1,false,false,false); RESC();
  { float sacc=pB0[0]+pB0[1]; _Pragma("unroll") for(int r=2;r<16;++r)sacc+=pB0[r]; _Pragma("unroll") for(int r=0;r<16;++r)sacc+=pB1[r]; l_reg+=sacc;
    pw0=(u32x4){PKW(pB0,0),PKW(pB0,2),PKW(pB0,4),PKW(pB0,6)};pw1=(u32x4){PKW(pB0,8),PKW(pB0,10),PKW(pB0,12),PKW(pB0,14)};pw2=(u32x4){PKW(pB1,0),PKW(pB1,2),PKW(pB1,4),PKW(pB1,6)};pw3=(u32x4){PKW(pB1,8),PKW(pB1,10),PKW(pB1,12),PKW(pB1,14)};
    SBAR(); pv<NDB>(o,vb0+sl_cur*(VSLOTB/SLOTB),PAF(0),PAF(1),PAF(2),PAF(3)); }
  #undef PKW
  #undef PAF
  #undef VFR
  #undef PIN
  #undef MX3
  #undef GAPA
  #undef GAPB
  #undef EX
  #undef VRD
  #undef VRDX
  #undef VRDA
  #undef GAPB2
  #undef KRD
  #undef STEP
  #undef ENDW
  {auto rr=__builtin_amdgcn_permlane32_swap(__float_as_uint(l_reg),__float_as_uint(l_reg),false,false);l_reg=__uint_as_float(rr[0])+__uint_as_float(rr[1]);}
  if(hi==0)wsf[32+r32]=l_reg;asm volatile("s_waitcnt lgkmcnt(0)":::"memory");
  float rli[16];
  #pragma unroll
  for(int r=0;r<16;++r)rli[r]=__builtin_amdgcn_rcpf(wsf[32+crow(r,hi)]);
  bf16*Ow=Ob+(long)(q0+wid*QBLK)*opitch;
  _Pragma("unroll") for(int hf=0;hf<NDB/2;++hf){ __attribute__((address_space(3))) unsigned short*stg=(__attribute__((address_space(3))) unsigned short*)((lds_cptr)shm+LDS_OST)+wid*2048;
    #pragma unroll
    for(int r=0;r<16;++r){const int orow=crow(r,hi);
      #pragma unroll
      for(int d0=0;d0<2;++d0)stg[orow*64+d0*32+r32]=(unsigned short)(cvtpk_s(o[2*hf+d0][r]*rli[r],0.f)&0xffffu);}
    asm volatile("s_waitcnt lgkmcnt(0)":::"memory");
    #pragma unroll
    for(int i=0;i<4;++i){const int row=i*8+(lane>>3),ch=lane&7; const u32x4 v=*(const __attribute__((address_space(3))) u32x4*)(stg+row*64+ch*8); ATTN_STORE16(Ow+(long)row*opitch+hf*64+ch*8,v);}
    asm volatile("s_waitcnt lgkmcnt(0)":::"memory"); }
  asm volatile("s_waitcnt lgkmcnt(0)\n\ts_barrier":::"memory");
  #undef DMA_K
  #undef DMA_V
  #undef CMASK
  #undef START
  #undef RESC
  #undef ROT
  #undef WAIT_KV
  #undef WAIT_V
}
constexpr int ATTN_LDS_BYTES=LDS_BYTES;
#undef SBAR
#undef WAIT_BAR
}

#ifndef MK_SPLIT
#define MK_SPLIT 0
#endif
constexpr int NWAVES = 8;
constexpr int DM = 1024, NBATCH = 4, SEQ = 8192, TOK = NBATCH * SEQ, NLAYER = 2, INC = 7440;
constexpr float EPS = 1e-6f;
constexpr float QSCALE = 0.125f * 1.4426950408889634f;
constexpr int NPH = 26;
constexpr size_t MiB = 1u << 20;
constexpr size_t WS_CTL = 0, CTL_ZERO_BYTES = 1 * MiB;
constexpr size_t WS_COS1 = 1 * MiB, WS_SIN1 = 2 * MiB;
constexpr size_t WS_AX = 3 * MiB;
constexpr size_t WS_WBA = 3 * MiB + 64 * 1024;
constexpr size_t WS_WRT = 3 * MiB + 256 * 1024;
constexpr size_t WS_RSTD1 = 4 * MiB, WS_RSTD2 = 4 * MiB + 128 * 1024, WS_RSTDF = 4 * MiB + 256 * 1024;
constexpr size_t WS_BA = 4 * MiB + 512 * 1024;
constexpr size_t WS_TOKL = 7 * MiB;
constexpr size_t WS_WL = 11 * MiB;
constexpr size_t WS_TSLOT = 15 * MiB;
constexpr size_t WS_WROW = 15 * MiB + 256 * 1024;
constexpr size_t WS_RROW = 15 * MiB + 576 * 1024;
constexpr size_t WS_WIN = 16 * MiB;
constexpr size_t WS_WG = 33 * MiB;
constexpr size_t WS_WBR = 45 * MiB;
constexpr size_t WS_WO3 = 51 * MiB;
constexpr size_t WS_XB = 55 * MiB;
constexpr size_t WS_MM = 520 * MiB, WS_INTRA = 552 * MiB;
constexpr size_t WS_PP = 119 * MiB;
constexpr size_t WS_RAW = 295 * MiB;
constexpr size_t WS_OF = 295 * MiB, WS_OB = 327 * MiB;
constexpr size_t WS_KN = 391 * MiB, WS_KT = 423 * MiB, WS_QN = 455 * MiB, WS_VC = 487 * MiB;
constexpr size_t WS_GC = 519 * MiB;
constexpr size_t WS_OD = 391 * MiB;
constexpr size_t WS_YBR = 295 * MiB;
constexpr size_t WS_MGT = 183 * MiB;
constexpr size_t WS_MG = 119 * MiB;
constexpr size_t WS_W13T = 487 * MiB, WS_W2T = 551 * MiB;
constexpr size_t WS_XG = 215 * MiB;
constexpr size_t WS_HH = 359 * MiB;
constexpr size_t WS_END = 584 * MiB;
constexpr int PPW = 2816, PC_Z = 0, PC_DQ = 512, PC_DK = 1024, PC_DV = 1536, PC_CQ = 2048, PC_CK = 2560, PC_CV = 2688;
constexpr int CW_BAR = 4096, CW_CNT = 8192, CW_NRM = 8448;
constexpr int RING_BYTES = 131072, LDSCTL_OFF = 145408, LDS_TBASE = LDSCTL_OFF + 256, LDS_TILEE = LDSCTL_OFF + 512;
constexpr int LDS_ROWTAB = LDSCTL_OFF + 2048, LDS_RSTAB = LDS_ROWTAB + 5120, LDS_WTAB = LDS_RSTAB + 5120, LDS_BYTES = LDS_WTAB + 5120;
static_assert(LDS_BYTES <= 163840, "LDS");

#define GAS __attribute__((address_space(1)))
#define LAS __attribute__((address_space(3)))
typedef unsigned short bf16;
typedef unsigned v4u __attribute__((ext_vector_type(4)));
typedef unsigned v2u __attribute__((ext_vector_type(2)));
typedef float f32x4 __attribute__((ext_vector_type(4)));
typedef short bf16x8 __attribute__((ext_vector_type(8)));
typedef GAS unsigned gu32;
#define RLX_AGENT __ATOMIC_RELAXED, __HIP_MEMORY_SCOPE_AGENT
#define LDS_WAIT() asm volatile("s_waitcnt lgkmcnt(0)" ::: "memory")
#define LBAR() do { asm volatile("s_waitcnt lgkmcnt(0)" ::: "memory"); __builtin_amdgcn_s_barrier(); asm volatile("" ::: "memory"); } while (0)
__device__ __forceinline__ unsigned pk2(float lo, float hi) { return pg8::cvt_pk_bf16(lo, hi); }
__device__ __forceinline__ float bflo(unsigned w) { return __uint_as_float(w << 16); }
__device__ __forceinline__ float bfhi(unsigned w) { return __uint_as_float(w & 0xffff0000u); }
__device__ __forceinline__ float bf2f(bf16 v) { return __uint_as_float((unsigned)v << 16); }
__device__ __forceinline__ float lshfl(float v, int src) { return __int_as_float(__builtin_amdgcn_ds_bpermute(src << 2, __float_as_int(v))); }
__device__ __forceinline__ int lshfl(int v, int src) { return __builtin_amdgcn_ds_bpermute(src << 2, v); }
#define SHFL_XOR(v, m) lshfl((v), lane ^ (m))
#define SHFL_UP(v, o) lshfl((v), (lane - (o)) & 63)
#define SHFL(v, s) lshfl((v), (s))
__device__ __forceinline__ float wave_sum(float v, int) {
    v += __int_as_float(__builtin_amdgcn_update_dpp(0, __float_as_int(v), 0xB1, 0xf, 0xf, false));
    v += __int_as_float(__builtin_amdgcn_update_dpp(0, __float_as_int(v), 0x4E, 0xf, 0xf, false));
    v += __int_as_float(__builtin_amdgcn_update_dpp(0, __float_as_int(v), 0x141, 0xf, 0xf, false));
    v += __int_as_float(__builtin_amdgcn_update_dpp(0, __float_as_int(v), 0x140, 0xf, 0xf, false));
    v += __int_as_float(__builtin_amdgcn_update_dpp(0, __float_as_int(v), 0x142, 0xa, 0xf, false));
    v += __int_as_float(__builtin_amdgcn_update_dpp(0, __float_as_int(v), 0x143, 0xc, 0xf, false));
    return __int_as_float(__builtin_amdgcn_readlane(__float_as_int(v), 63));
}
__device__ __forceinline__ float row16_sum(float v) {
    v += __int_as_float(__builtin_amdgcn_update_dpp(0, __float_as_int(v), 0xB1, 0xf, 0xf, false));
    v += __int_as_float(__builtin_amdgcn_update_dpp(0, __float_as_int(v), 0x4E, 0xf, 0xf, false));
    v += __int_as_float(__builtin_amdgcn_update_dpp(0, __float_as_int(v), 0x141, 0xf, 0xf, false));
    v += __int_as_float(__builtin_amdgcn_update_dpp(0, __float_as_int(v), 0x140, 0xf, 0xf, false));
    return v;
}
__device__ __forceinline__ float sigm(float x) { return __builtin_amdgcn_rcpf(1.0f + __expf(-x)); }
__device__ __forceinline__ f32x4 mfma16(bf16x8 a, bf16x8 b, f32x4 c) { return __builtin_amdgcn_mfma_f32_16x16x32_bf16(a, b, c, 0, 0, 0); }
#define XB_TMO      128
#define XB_XCNT(j)  (256  + 64 * (j))
#define XB_XSUB(j)  (1280 + 64 * (j))
#define XB_XGEN(j)  (2304 + 64 * (j))
#define XB_TOP      3328
#define XB_TOPGEN   3392
#define XCD_BAR_WORDS 3456
#define XB_SPIN_CAP (1u << 18)

__device__ __forceinline__ unsigned xb_ld(unsigned* p)              { return __hip_atomic_load(p, __ATOMIC_RELAXED, __HIP_MEMORY_SCOPE_AGENT); }
__device__ __forceinline__ unsigned xb_add(unsigned* p, unsigned v) { asm volatile("" : "+v"(v));
    return __hip_atomic_fetch_add(p, v, __ATOMIC_RELAXED, __HIP_MEMORY_SCOPE_AGENT); }
__device__ __forceinline__ unsigned xb_xcc_id() { return (unsigned)__builtin_amdgcn_s_getreg((3 << 11) | 20) & 0xFu; }
#define XB_SPIN(cond, bar) do { unsigned _sp = 0; while (cond) { __builtin_amdgcn_s_sleep(1); \
    if ((++_sp & 255u) == 0u) { if (xb_ld(&(bar)[XB_TMO])) break; if (_sp > XB_SPIN_CAP) { atomicAdd(&(bar)[XB_TMO], 1u); break; } } } } while (0)

struct XcdBarrier {
    unsigned* bar; unsigned x;
    volatile LAS unsigned* st;
};

__device__ __forceinline__ XcdBarrier xcd_barrier_post(unsigned* bar, volatile LAS unsigned* st) {
    XcdBarrier b; b.bar = bar; b.x = xb_xcc_id(); b.st = st;
    if (threadIdx.x == 0) (void)xb_add(&bar[XB_XCNT(b.x)], 1u);
    return b;
}
__device__ __forceinline__ void xcd_barrier_complete(unsigned* bar, unsigned x, unsigned& nloc, unsigned& nx) {
    const unsigned G = gridDim.x * gridDim.y * gridDim.z;
    unsigned sum, cnt, mine, sp = 0u;
    for (;;) {
        sum = 0u; cnt = 0u; mine = 0u;
#pragma unroll
        for (unsigned j = 0; j < 16; ++j) { const unsigned c = xb_ld(&bar[XB_XCNT(j)]); sum += c; cnt += (c > 0u) ? 1u : 0u; mine = (j == x) ? c : mine; }
        if (sum == G) break;
        __builtin_amdgcn_s_sleep(1);
        if ((++sp & 255u) == 0u) { if (xb_ld(&bar[XB_TMO])) break; if (sp > XB_SPIN_CAP) { atomicAdd(&bar[XB_TMO], 1u); break; } }
    }
    nloc = mine > 0u ? mine : 1u; nx = cnt > 0u ? cnt : 1u;
}

__device__ __forceinline__ void xcd_barrier(const XcdBarrier& b) {
    asm volatile("s_waitcnt vmcnt(0)" ::: "memory");
    __syncthreads();
    if (threadIdx.x == 0) {
        unsigned* bar = b.bar;
        __builtin_amdgcn_s_waitcnt(0);
        unsigned nloc = b.st[0], nx = b.st[1];
        if (nloc == 0u) { xcd_barrier_complete(bar, b.x, nloc, nx); b.st[0] = nloc; b.st[1] = nx; }
        const unsigned old = xb_add(&bar[XB_XSUB(b.x)], 1u);
        const unsigned gen = old / nloc;
        if (old + 1u == (gen + 1u) * nloc) {
            __builtin_amdgcn_fence(__ATOMIC_RELEASE, "agent");
            asm volatile("s_waitcnt vmcnt(0)" ::: "memory");
            const unsigned og = xb_add(&bar[XB_TOP], 1u);
            const unsigned tg = og / nx;
            if (og + 1u == (tg + 1u) * nx) xb_add(&bar[XB_TOPGEN], 1u);
            else XB_SPIN(xb_ld(&bar[XB_TOPGEN]) == tg, bar);
            __builtin_amdgcn_fence(__ATOMIC_ACQUIRE, "agent");
            xb_add(&bar[XB_XGEN(b.x)], 1u);
            asm volatile("s_waitcnt vmcnt(0)" ::: "memory");
        } else {
            XB_SPIN(xb_ld(&bar[XB_XGEN(b.x)]) == gen, bar);
            __builtin_amdgcn_fence(__ATOMIC_ACQUIRE, "agent");
            asm volatile("s_waitcnt vmcnt(0)" ::: "memory");
        }
    }
    __syncthreads();
}

struct Args { const float* in[24]; float* out; unsigned char* ws; int ph_lo, ph_hi; };
struct Frame {
    LAS unsigned char* lds; unsigned char* ldsg;
    volatile LAS unsigned* MISC;
    gu32* ctl;
    int tid, lane, wave, vcu, G;
    const __attribute__((address_space(4))) Args* A; float* out; unsigned char* ws;
};
#define INP(k) (F.A->in[k])
#define WSP(T, off) ((T*)(F.ws + (off)))
#define WSG(T, off) ((GAS T*)(F.ws + (off)))

__device__ __forceinline__ void tr_item(const float* W, int ldw, int srccol0, int k0, bf16* WT, int ldt, int dstrow0, int dstk0, const float* ksc, LAS float* scr, int lane) {
    f32x4 v[8];
#pragma unroll
    for (int i = 0; i < 8; ++i) v[i] = __builtin_nontemporal_load((const f32x4*)(W + (size_t)(k0 + 8 * i + (lane >> 3)) * ldw + srccol0 + 4 * (lane & 7)));
#pragma unroll
    for (int i = 0; i < 8; ++i) { const int kk = 8 * i + (lane >> 3); const float sc = ksc ? ksc[k0 + kk] : 1.0f; LAS float* d = scr + kk * 33 + 4 * (lane & 7);
        d[0] = v[i][0] * sc; d[1] = v[i][1] * sc; d[2] = v[i][2] * sc; d[3] = v[i][3] * sc; }
    LDS_WAIT(); asm volatile("" ::: "memory");
    const int c = lane & 7;
#pragma unroll
    for (int j = 0; j < 4; ++j) { const int n = (lane >> 3) + 8 * j; const LAS float* s = scr + (8 * c) * 33 + n;
        v4u o; o.x = pk2(s[0 * 33], s[1 * 33]); o.y = pk2(s[2 * 33], s[3 * 33]); o.z = pk2(s[4 * 33], s[5 * 33]); o.w = pk2(s[6 * 33], s[7 * 33]);
        *(GAS v4u*)(WT + (size_t)(dstrow0 + n) * ldt + dstk0 + 8 * c) = o; }
    LDS_WAIT(); asm volatile("" ::: "memory");
}
__device__ __forceinline__ void sincos_d(double x, double& s, double& c) {
    const double q = rint(x * 0.6366197723675814); double r = fma(-q, 1.5707963267948966, x); r = fma(-q, 6.123233995736766e-17, r);
    const double r2 = r * r;
    double sp = -7.647163731819816e-13; sp = fma(sp, r2, 1.6059043836821613e-10); sp = fma(sp, r2, -2.505210838544172e-08); sp = fma(sp, r2, 2.7557319223985893e-06); sp = fma(sp, r2, -1.984126984126984e-04); sp = fma(sp, r2, 8.333333333333333e-03); sp = fma(sp, r2, -1.6666666666666666e-01);
    const double sr = fma(sp * r2, r, r);
    double cp = 4.779477332387385e-14; cp = fma(cp, r2, -1.1470745597729725e-11); cp = fma(cp, r2, 2.08767569878681e-09); cp = fma(cp, r2, -2.755731922398589e-07); cp = fma(cp, r2, 2.48015873015873e-05); cp = fma(cp, r2, -1.388888888888889e-03); cp = fma(cp, r2, 4.1666666666666664e-02); cp = fma(cp, r2, -0.5);
    const double cr = fma(cp, r2, 1.0);
    const int qi = ((int)q) & 3;
    s = (qi == 0) ? sr : (qi == 1) ? cr : (qi == 2) ? -sr : -cr;
    c = (qi == 0) ? cr : (qi == 1) ? -sr : (qi == 2) ? -cr : sr;
}
__device__ __forceinline__ void p0_prologue(Frame& F) {
    LAS float* scr = (LAS float*)(F.lds + F.wave * 16384);
    const int gw = F.vcu * NWAVES + F.wave, NGW = F.G * NWAVES;
    constexpr int I_A = 136 * 16, I_B = 96 * 16, I_C = 3 * 256, I_D = 512, I_L = I_A + I_B + I_C + I_D;
    for (int it0 = gw; it0 < NLAYER * I_L; it0 += NGW) {
        const int l = it0 / I_L; int r = it0 % I_L;
        const float* anw = INP(1) + l * DM;
        if (r < I_A) { const int db = r / 16, kb = r % 16, d0 = 32 * db; const int pt_ = (d0 >> 8) - 6, rho = d0 & 255;
            const int lc = ((pt_ >= 2 && pt_ <= 5) || pt_ >= 8) ? (d0 & ~255) + ((rho >> 5) & 3) * 64 + (rho >> 7) * 32 : d0;
            tr_item(INP(2) + (size_t)l * DM * INC, INC, lc < 2048 ? lc : lc + 16, 64 * kb, WSP(bf16, WS_WIN) + (size_t)l * 4352 * 1024, 1024, d0, 64 * kb, anw, scr, F.lane); continue; } r -= I_A;
        if (r < I_B) { const int db = r / 16, kb = r % 16, d0 = 32 * db; tr_item(INP(2) + (size_t)l * DM * INC, INC, 4368 + d0, 64 * kb, WSP(bf16, WS_WG) + (size_t)l * 3072 * 1024, 1024, d0, 64 * kb, anw, scr, F.lane); continue; } r -= I_B;
        if (r < I_C) { const int i = r / 256, rr = r % 256, db = rr / 8, kb = rr % 8; tr_item((i == 0 ? INP(11) : (i == 1 ? INP(12) : INP(13))) + (size_t)l * 512 * 1024, 1024, 32 * db, 64 * kb, WSP(bf16, WS_WBR) + (size_t)l * 3072 * 512, 512, i * 1024 + 32 * db, 64 * kb, nullptr, scr, F.lane); continue; } r -= I_C;
        { const int db = r / 16, kb = r % 16; tr_item(INP(14) + (size_t)l * 1024 * 1024, 1024, 32 * db, 64 * kb, WSP(bf16, WS_WO3) + (size_t)l * 1024 * 1024, 1024, 32 * db, 64 * kb, nullptr, scr, F.lane); }
    }
    const int gt = (F.vcu * NWAVES + F.wave) * 64 + F.lane, NGT = F.G * NWAVES * 64;
    float* wba = WSP(float, WS_WBA); float* wrt = WSP(float, WS_WRT);
    for (int i = gt; i < NLAYER * 16 * 1024; i += NGT) { const int l = i / (16 * 1024), j = (i / 1024) % 16, k = i % 1024; wba[i] = INP(1)[l * DM + k] * INP(2)[((size_t)l * DM + k) * INC + 2048 + j]; }
    for (int i = gt; i < NLAYER * 48 * 1024; i += NGT) { const int l = i / (48 * 1024), j = (i / 1024) % 48, k = i % 1024; const float nw = INP(15)[l * DM + k];
        float v = 0.f; if (j < 4) v = nw * INP(16)[((size_t)l * DM + k) * 4 + j]; else if (j < 36) v = nw * INP(18)[((size_t)l * DM + k) * 32 + (j - 4)]; wrt[i] = v; }
    float* c1 = WSP(float, WS_COS1); float* s1 = WSP(float, WS_SIN1);
    for (int i = gt; i < SEQ * 32; i += NGT) { const int s = i >> 5, f = i & 31; const double inv = exp(-((double)f / 32.0) * 9.210340371976184); double sn, cs; sincos_d((double)s * inv, sn, cs); c1[i] = (float)cs; s1[i] = (float)sn; }
    float* ax = WSP(float, WS_AX);
    for (int i = gt; i < 192 * 16; i += NGT) { const int p = i >> 4, f = i & 15; const double inv = exp(-((double)f / 16.0) * 9.210340371976184); const int pos = p < 128 ? p : p - 128; double sn, cs; sincos_d((double)pos * inv, sn, cs);
        if (p < 128) { ax[p * 16 + f] = (float)cs; ax[2048 + p * 16 + f] = (float)sn; } else { ax[4096 + (p - 128) * 16 + f] = (float)cs; ax[5120 + (p - 128) * 16 + f] = (float)sn; } }
}
struct TrDesc { const float* src; bf16* dst; int ldw, ldt, k0; bool scale; };
__device__ __forceinline__ TrDesc expert_item(Frame& F, int l, int it) {
    const int e = it / 768, r = it % 768, kind = r / 256, rr = r % 256; TrDesc d;
    if (kind < 2) { const int cb = rr / 16, kb = rr % 16, c0 = 32 * cb;
        d.src = (kind == 0 ? INP(20) : INP(21)) + ((size_t)l * 32 + e) * 1024 * 512 + (size_t)(64 * kb) * 512 + c0; d.ldw = 512;
        d.dst = WSP(bf16, WS_W13T) + (size_t)e * 1024 * 1024 + (size_t)((c0 / 128) * 256 + (c0 % 128) + kind * 128) * 1024 + 64 * kb; d.ldt = 1024; d.k0 = 64 * kb; d.scale = true; }
    else { const int cb = rr / 8, kb = rr % 8;
        d.src = INP(22) + ((size_t)l * 32 + e) * 512 * 1024 + (size_t)(64 * kb) * 1024 + 32 * cb; d.ldw = 1024;
        d.dst = WSP(bf16, WS_W2T) + (size_t)e * 1024 * 512 + (size_t)(32 * cb) * 512 + 64 * kb; d.ldt = 512; d.k0 = 64 * kb; d.scale = false; }
    return d;
}
template <class V> __device__ __forceinline__ void st16s_hidden(unsigned voff, const void* sbase, const V v) { asm volatile("global_store_dwordx4 %0, %1, %2\n\ts_nop 1" :: "v"(voff), "v"(v), "s"(sbase) : "memory"); }
template <class T, class V> __device__ __forceinline__ void st16_hidden(GAS T* p, const V v) { asm volatile("global_store_dwordx4 %0, %1, off\n\ts_nop 1" :: "v"(p), "v"(v) : "memory"); }
__device__ __forceinline__ void expert_convert(Frame& F, int l) {
    int lane; asm volatile("v_mbcnt_lo_u32_b32 %0, -1, 0\n\tv_mbcnt_hi_u32_b32 %0, -1, %0" : "=v"(lane));
    const int gw = F.vcu * NWAVES + F.wave, NGW = F.G * NWAVES, NIT = 32 * 768;
    LAS float* scr = (LAS float*)(F.lds + F.wave * 16896); LAS float* fnl = scr + 64 * 33;
    { const GAS float* fnw = (const GAS float*)INP(15) + l * DM;
#pragma unroll
      for (int i = 0; i < 4; ++i) *(LAS f32x4*)(fnl + 4 * (i * 64 + lane)) = *(const GAS f32x4*)(fnw + 4 * (i * 64 + lane)); }
    LDS_WAIT(); asm volatile("" ::: "memory");
    constexpr int EC_D = 4;
    int its[EC_D]; f32x4 v[EC_D][8];
#define EC_ISSUE(s, IT) do { its[s] = (IT); const bool ok_ = its[s] < NIT; TrDesc di_ = expert_item(F, l, ok_ ? its[s] : gw); if (!ok_) { di_.src = INP(15); di_.ldw = 0; } \
        const unsigned vo_ = (unsigned)(((lane >> 3) * di_.ldw + 4 * (lane & 7)) * 4);     \
        _Pragma("unroll") for (int i = 0; i < 8; ++i) v[s][i] = __builtin_nontemporal_load((const GAS f32x4*)((const GAS char*)(di_.src + (size_t)(8 * i) * di_.ldw) + vo_)); } while (0)
#pragma unroll
    for (int s = 0; s < EC_D; ++s) EC_ISSUE(s, gw + s * NGW);
    for (int it = gw; it < NIT; it += EC_D * NGW) {
#pragma unroll
        for (int s = 0; s < EC_D; ++s) {
            if (its[s] < NIT) { const TrDesc dd = expert_item(F, l, its[s]); const unsigned vd = (unsigned)(((lane >> 3) * dd.ldt + 8 * (lane & 7)) * 2);
#pragma unroll
                for (int i = 0; i < 8; ++i) { const int kk = 8 * i + (lane >> 3); const float sc = dd.scale ? fnl[dd.k0 + kk] : 1.0f; LAS float* q = scr + kk * 33 + 4 * (lane & 7);
                    q[0] = v[s][i][0] * sc; q[1] = v[s][i][1] * sc; q[2] = v[s][i][2] * sc; q[3] = v[s][i][3] * sc; }
                LDS_WAIT(); asm volatile("" ::: "memory");
                const int c = lane & 7;
#pragma unroll
                for (int j = 0; j < 4; ++j) { const int n = (lane >> 3) + 8 * j; const LAS float* sp = scr + (8 * c) * 33 + n;
                    v4u o; o.x = pk2(sp[0 * 33], sp[1 * 33]); o.y = pk2(sp[2 * 33], sp[3 * 33]); o.z = pk2(sp[4 * 33], sp[5 * 33]); o.w = pk2(sp[6 * 33], sp[7 * 33]);
                    st16s_hidden(vd, dd.dst + (size_t)(8 * j) * dd.ldt, o); }
                LDS_WAIT(); asm volatile("" ::: "memory");
            }
            EC_ISSUE(s, it + (s + EC_D) * NGW);
        }
    }
#undef EC_ISSUE
    asm volatile("s_waitcnt vmcnt(0)" ::: "memory");
}

template <int MODE> __device__ __forceinline__ void norm_pass(Frame& F, int l) {
    const int lane = F.lane, r16 = lane & 15, q4 = lane >> 4;
    const int gw = F.vcu * NWAVES + F.wave, NGW = F.G * NWAVES;
    constexpr int NCT = (MODE == 1) ? 3 : (MODE == 3 ? 0 : 1);
    const GAS float* Wt = (MODE == 1) ? WSG(float, WS_WRT) + (size_t)l * 48 * 1024 : WSG(float, WS_WBA) + (size_t)l * 16 * 1024;
    GAS float* rstd_out = WSG(float, MODE == 1 ? WS_RSTD2 : (MODE == 3 ? WS_RSTDF : WS_RSTD1));
    GAS bf16* XB = WSG(bf16, WS_XB);
    const GAS bf16* YB = WSG(bf16, WS_XG);
    int tb = 0;
    if (MODE >= 2) {
        const int lp = (MODE == 2) ? l - 1 : NLAYER - 1;
        const int cnt = lane < 32 ? (int)F.ctl[CW_CNT + 64 * lp + lane] : 0; const int nt = (cnt + 255) >> 8; int inc = nt;
#pragma unroll
        for (int o = 1; o < 32; o <<= 1) { const int t = SHFL_UP(inc, o); if (lane >= o) inc += t; }
        tb = inc - nt;
    }
    LAS float* scr = (LAS float*)(F.lds + F.wave * 16384 + 12288);
    for (int tile = gw; tile < TOK / 16; tile += NGW) {
        const int row = tile * 16 + r16;
        const GAS float* src = (const GAS float*)INP(0) + (size_t)row * DM + 16 * q4;
        GAS float* dst = (GAS float*)F.out + (size_t)row * DM + 16 * q4;
        const GAS bf16* xb = XB + (size_t)row * DM + 16 * q4;
        size_t y1 = 0, y2 = 0;
        if (MODE >= 2) { const GAS int* ts = WSG(int, WS_TSLOT) + row * 2; const int s1 = ts[0], s2 = ts[1];
            const int b1 = SHFL(tb, s1 >> 15), b2 = SHFL(tb, s2 >> 15);
            y1 = ((size_t)b1 * 256 + (s1 & 32767)) * DM + 16 * q4; y2 = ((size_t)b2 * 256 + (s2 & 32767)) * DM + 16 * q4; }
        f32x4 acc[NCT > 0 ? NCT : 1];
#pragma unroll
        for (int c = 0; c < (NCT > 0 ? NCT : 1); ++c) acc[c] = (f32x4){0.f, 0.f, 0.f, 0.f};
        float ss = 0.f;
        f32x4 vv[2][2][4]; v4u xa[2][2][2]; v4u ya[2][2][4];
#define NP_LOAD(B, KB) do { _Pragma("unroll") for (int gq = 0; gq < 2; ++gq) { const int kb_ = (KB) + 64 * gq; \
            if (MODE == 0) { _Pragma("unroll") for (int i = 0; i < 4; ++i) vv[B][gq][i] = __builtin_nontemporal_load((const GAS f32x4*)(src + kb_ + 4 * i)); } \
            else { xa[B][gq][0] = *(const GAS v4u*)(xb + kb_); xa[B][gq][1] = *(const GAS v4u*)(xb + kb_ + 8); } \
            if (MODE >= 2) { ya[B][gq][0] = __builtin_nontemporal_load((const GAS v4u*)(YB + y1 + kb_)); ya[B][gq][1] = __builtin_nontemporal_load((const GAS v4u*)(YB + y1 + kb_ + 8)); \
                             ya[B][gq][2] = __builtin_nontemporal_load((const GAS v4u*)(YB + y2 + kb_)); ya[B][gq][3] = __builtin_nontemporal_load((const GAS v4u*)(YB + y2 + kb_ + 8)); } } } while (0)
#define NP_TRIP(B, KB0, PF) do { const int kb0 = (KB0); \
            f32x4 wv[2][NCT > 0 ? NCT : 1][4]; \
            _Pragma("unroll") for (int gq = 0; gq < 2; ++gq) _Pragma("unroll") for (int c = 0; c < NCT; ++c) _Pragma("unroll") for (int i = 0; i < 4; ++i) \
                wv[gq][c][i] = *(const GAS f32x4*)(Wt + (size_t)(c * 16 + r16) * DM + kb0 + 64 * gq + 16 * q4 + 4 * i); \
            __builtin_amdgcn_sched_barrier(0); \
            if (PF) NP_LOAD((B) ^ 1, kb0 + 128); \
            __builtin_amdgcn_sched_barrier(0);     \
            _Pragma("unroll") for (int gq = 0; gq < 2; ++gq) { const int kb = kb0 + 64 * gq; \
                f32x4 v[4]; \
                if (MODE == 0) { _Pragma("unroll") for (int i = 0; i < 4; ++i) v[i] = vv[B][gq][i]; } \
                else { const v4u x0 = xa[B][gq][0], x1 = xa[B][gq][1]; \
                    v[0] = (f32x4){bflo(x0.x), bfhi(x0.x), bflo(x0.y), bfhi(x0.y)}; v[1] = (f32x4){bflo(x0.z), bfhi(x0.z), bflo(x0.w), bfhi(x0.w)}; \
                    v[2] = (f32x4){bflo(x1.x), bfhi(x1.x), bflo(x1.y), bfhi(x1.y)}; v[3] = (f32x4){bflo(x1.z), bfhi(x1.z), bflo(x1.w), bfhi(x1.w)}; } \
                if (MODE >= 2) { \
                    const v4u a0 = ya[B][gq][0], a1 = ya[B][gq][1], b0 = ya[B][gq][2], b1 = ya[B][gq][3]; \
                    v[0] += (f32x4){bflo(a0.x) + bflo(b0.x), bfhi(a0.x) + bfhi(b0.x), bflo(a0.y) + bflo(b0.y), bfhi(a0.y) + bfhi(b0.y)}; \
                    v[1] += (f32x4){bflo(a0.z) + bflo(b0.z), bfhi(a0.z) + bfhi(b0.z), bflo(a0.w) + bflo(b0.w), bfhi(a0.w) + bfhi(b0.w)}; \
                    v[2] += (f32x4){bflo(a1.x) + bflo(b1.x), bfhi(a1.x) + bfhi(b1.x), bflo(a1.y) + bflo(b1.y), bfhi(a1.y) + bfhi(b1.y)}; \
                    v[3] += (f32x4){bflo(a1.z) + bflo(b1.z), bfhi(a1.z) + bfhi(b1.z), bflo(a1.w) + bflo(b1.w), bfhi(a1.w) + bfhi(b1.w)}; \
                } \
                _Pragma("unroll") for (int i = 0; i < 4; ++i) ss += (v[i][0] * v[i][0] + v[i][1] * v[i][1]) + (v[i][2] * v[i][2] + v[i][3] * v[i][3]); \
                if (MODE == 0 || MODE == 2) { \
                    v4u o0, o1; o0.x = pk2(v[0][0], v[0][1]); o0.y = pk2(v[0][2], v[0][3]); o0.z = pk2(v[1][0], v[1][1]); o0.w = pk2(v[1][2], v[1][3]); \
                    o1.x = pk2(v[2][0], v[2][1]); o1.y = pk2(v[2][2], v[2][3]); o1.z = pk2(v[3][0], v[3][1]); o1.w = pk2(v[3][2], v[3][3]); \
                    GAS bf16* xo = XB + (size_t)row * DM + 16 * q4 + kb; st16_hidden(xo, o0); st16_hidden(xo + 8, o1); \
                } \
                _Pragma("unroll") for (int c = 0; c < NCT; ++c) _Pragma("unroll") for (int i = 0; i < 4; ++i) _Pragma("unroll") for (int e = 0; e < 4; ++e) \
                    acc[c] = __builtin_amdgcn_mfma_f32_16x16x4f32(v[i][e], wv[gq][c][i][e], acc[c], 0, 0, 0); \
            } } while (0)
        NP_LOAD(0, 0);
#pragma unroll 1
        for (int kbq = 0; kbq < DM - 256; kbq += 256) { NP_TRIP(0, kbq, true); NP_TRIP(1, kbq + 128, true); }
        NP_TRIP(0, DM - 256, true); NP_TRIP(1, DM - 128, false);
#undef NP_LOAD
#undef NP_TRIP
        ss += SHFL_XOR(ss, 16); ss += SHFL_XOR(ss, 32);
        const float rstd = 1.0f / sqrtf(ss * (1.0f / DM) + EPS);
        if (q4 == 0) rstd_out[row] = rstd;
        if (MODE == 3) {
            const GAS float* fw = (const GAS float*)INP(23) + 16 * q4;
#pragma unroll 2
            for (int kb = 0; kb < DM; kb += 64) {
                const v4u x0 = *(const GAS v4u*)(xb + kb), x1 = *(const GAS v4u*)(xb + kb + 8);
                const v4u a0 = *(const GAS v4u*)(YB + y1 + kb), a1 = *(const GAS v4u*)(YB + y1 + kb + 8), b0 = *(const GAS v4u*)(YB + y2 + kb), b1 = *(const GAS v4u*)(YB + y2 + kb + 8);
                f32x4 wv[4];
#pragma unroll
                for (int i = 0; i < 4; ++i) wv[i] = *(const GAS f32x4*)(fw + kb + 4 * i);
                f32x4 v[4];
                v[0] = (f32x4){bflo(x0.x), bfhi(x0.x), bflo(x0.y), bfhi(x0.y)}; v[1] = (f32x4){bflo(x0.z), bfhi(x0.z), bflo(x0.w), bfhi(x0.w)};
                v[2] = (f32x4){bflo(x1.x), bfhi(x1.x), bflo(x1.y), bfhi(x1.y)}; v[3] = (f32x4){bflo(x1.z), bfhi(x1.z), bflo(x1.w), bfhi(x1.w)};
                v[0] += (f32x4){bflo(a0.x) + bflo(b0.x), bfhi(a0.x) + bfhi(b0.x), bflo(a0.y) + bflo(b0.y), bfhi(a0.y) + bfhi(b0.y)};
                v[1] += (f32x4){bflo(a0.z) + bflo(b0.z), bfhi(a0.z) + bfhi(b0.z), bflo(a0.w) + bflo(b0.w), bfhi(a0.w) + bfhi(b0.w)};
                v[2] += (f32x4){bflo(a1.x) + bflo(b1.x), bfhi(a1.x) + bfhi(b1.x), bflo(a1.y) + bflo(b1.y), bfhi(a1.y) + bfhi(b1.y)};
                v[3] += (f32x4){bflo(a1.z) + bflo(b1.z), bfhi(a1.z) + bfhi(b1.z), bflo(a1.w) + bflo(b1.w), bfhi(a1.w) + bfhi(b1.w)};
#pragma unroll
                for (int i = 0; i < 4; ++i) st16_hidden(dst + kb + 4 * i, v[i] * rstd * wv[i]);
            }
        }
        float rr[4];
#pragma unroll
        for (int g = 0; g < 4; ++g) rr[g] = SHFL(rstd, q4 * 4 + g);
        if (MODE == 0 || MODE == 2) { GAS float* ba = WSG(float, WS_BA);
#pragma unroll
            for (int g = 0; g < 4; ++g) ba[(size_t)(tile * 16 + q4 * 4 + g) * 16 + r16] = acc[0][g] * rr[g]; }
        if (MODE == 1) {
#pragma unroll
            for (int c = 0; c < NCT; ++c) { const int col = c * 16 + r16; float bias = 0.f; if (col < 4) bias = ((const GAS float*)INP(17))[l * 4 + col]; else if (col < 36) bias = ((const GAS float*)INP(19))[l * 32 + col - 4];
#pragma unroll
                for (int g = 0; g < 4; ++g) scr[(q4 * 4 + g) * 48 + col] = acc[c][g] * rr[g] + bias; }
            LDS_WAIT(); asm volatile("" ::: "memory");
            if (lane < 16) {
                const LAS float* lg = scr + lane * 48; const int t = tile * 16 + lane;
                int gi = 0; float gm = lg[0];
#pragma unroll
                for (int j = 1; j < 4; ++j) if (lg[j] > gm) { gm = lg[j]; gi = j; }
                float gs = 0.f;
#pragma unroll
                for (int j = 0; j < 4; ++j) gs += __expf(lg[j] - gm);
                const float gp = 1.0f / gs;
                const LAS float* el = lg + 4 + gi * 8;
                int i1 = 0; float m1 = el[0];
#pragma unroll
                for (int j = 1; j < 8; ++j) if (el[j] > m1) { m1 = el[j]; i1 = j; }
                int i2 = -1; float m2 = -3.0e38f;
#pragma unroll
                for (int j = 0; j < 8; ++j) if (j != i1 && el[j] > m2) { m2 = el[j]; i2 = j; }
                const float p2 = __expf(m2 - m1), w1 = gp / (1.0f + p2), w2 = gp * p2 / (1.0f + p2);
                const int E1 = gi * 8 + i1, E2 = gi * 8 + i2;
                GAS unsigned* cnt = (GAS unsigned*)(F.ctl + CW_CNT + 64 * l);
                const int p1 = (int)__hip_atomic_fetch_add(cnt + E1, 1u, __ATOMIC_RELAXED, __HIP_MEMORY_SCOPE_AGENT), pp2 = (int)__hip_atomic_fetch_add(cnt + E2, 1u, __ATOMIC_RELAXED, __HIP_MEMORY_SCOPE_AGENT);
                GAS int* tokl = WSG(int, WS_TOKL); GAS float* wl = WSG(float, WS_WL); GAS int* ts = WSG(int, WS_TSLOT);
                tokl[E1 * 32768 + p1] = t; wl[E1 * 32768 + p1] = w1; ts[t * 2] = (E1 << 15) | p1;
                tokl[E2 * 32768 + pp2] = t; wl[E2 * 32768 + pp2] = w2; ts[t * 2 + 1] = (E2 << 15) | pp2;
            }
            LDS_WAIT(); asm volatile("" ::: "memory");
        }
    }
}

__device__ __forceinline__ void unpack8(const v4u w, float (&x)[8]) { x[0] = bflo(w.x); x[1] = bfhi(w.x); x[2] = bflo(w.y); x[3] = bfhi(w.y); x[4] = bflo(w.z); x[5] = bfhi(w.z); x[6] = bflo(w.w); x[7] = bfhi(w.w); }
__device__ __forceinline__ v4u pack8(const float (&x)[8]) { v4u w; w.x = pk2(x[0], x[1]); w.y = pk2(x[2], x[3]); w.z = pk2(x[4], x[5]); w.w = pk2(x[6], x[7]); return w; }
__device__ __forceinline__ void rope_pass(Frame& F, int l) {
    const int lane = F.lane, jl = lane & 7;
    const int gw = F.vcu * NWAVES + F.wave, NGW = F.G * NWAVES;
    const float* c1 = WSP(float, WS_COS1); const float* s1 = WSP(float, WS_SIN1); const float* ax = WSP(float, WS_AX);
    bf16* PP = WSP(bf16, WS_PP);
    float qnw[8], knw[8];
#pragma unroll
    for (int e = 0; e < 8; ++e) { qnw[e] = INP(9)[l * 64 + 8 * jl + e]; knw[e] = INP(10)[l * 64 + 8 * jl + e]; }
    for (int t = gw; t < TOK; t += NGW) {
        const int s = t & (SEQ - 1); bf16* prow = PP + (size_t)t * PPW;
        float cs[8], sn[8];
        { const f32x4 ca = *(const f32x4*)(c1 + s * 32 + 8 * (jl & 3)), cb = *(const f32x4*)(c1 + s * 32 + 8 * (jl & 3) + 4), sa = *(const f32x4*)(s1 + s * 32 + 8 * (jl & 3)), sb = *(const f32x4*)(s1 + s * 32 + 8 * (jl & 3) + 4);
#pragma unroll
          for (int e = 0; e < 4; ++e) { cs[e] = ca[e]; cs[4 + e] = cb[e]; sn[e] = sa[e]; sn[4 + e] = sb[e]; } }
#pragma unroll
        for (int which = 0; which < 2; ++which) {
            bf16* p = prow + (which == 0 ? PC_DQ : PC_DK) + 8 * lane; float x[8], o[8]; unpack8(*(const v4u*)p, x);
#pragma unroll
            for (int e = 0; e < 8; ++e) { const float pv = SHFL_XOR(x[e], 4); o[e] = (jl < 4) ? x[e] * cs[e] - pv * sn[e] : x[e] * cs[e] + pv * sn[e]; if (which == 0) o[e] *= QSCALE; }
            *(v4u*)p = pack8(o);
        }
        float ac[8], as[8];
        { const float* tbc = (jl < 4) ? ax + (s >> 6) * 16 : ax + 4096 + (s & 63) * 16; const float* tbs = (jl < 4) ? ax + 2048 + (s >> 6) * 16 : ax + 5120 + (s & 63) * 16;
          const f32x4 ca = *(const f32x4*)(tbc + 8 * (jl & 1)), cb = *(const f32x4*)(tbc + 8 * (jl & 1) + 4), sa = *(const f32x4*)(tbs + 8 * (jl & 1)), sb = *(const f32x4*)(tbs + 8 * (jl & 1) + 4);
#pragma unroll
          for (int e = 0; e < 4; ++e) { ac[e] = ca[e]; ac[4 + e] = cb[e]; as[e] = sa[e]; as[4 + e] = sb[e]; } }
#pragma unroll
        for (int which = 0; which < 2; ++which) {
            bf16* p = prow + (which == 0 ? PC_CQ + 8 * lane : PC_CK + 8 * (lane & 15)); float x[8], o[8]; unpack8(*(const v4u*)p, x);
            float ssq = 0.f;
#pragma unroll
            for (int e = 0; e < 8; ++e) ssq += x[e] * x[e];
            ssq += SHFL_XOR(ssq, 1); ssq += SHFL_XOR(ssq, 2); ssq += SHFL_XOR(ssq, 4);
            const float rn = 1.0f / sqrtf(ssq * (1.0f / 64.0f) + EPS);
#pragma unroll
            for (int e = 0; e < 8; ++e) x[e] = x[e] * rn * (which == 0 ? qnw[e] : knw[e]);
#pragma unroll
            for (int e = 0; e < 8; ++e) { const float pv = SHFL_XOR(x[e], 2); o[e] = ((jl & 3) < 2) ? x[e] * ac[e] - pv * as[e] : x[e] * ac[e] + pv * as[e]; if (which == 0) o[e] *= QSCALE; }
            if (which == 0 || lane < 16) *(v4u*)p = pack8(o);
        }
    }
}

__host__ __device__ __forceinline__ constexpr int frag_off(int row, int col, int C) { return (((row >> 4) * (C / 32) + (col >> 5)) * 64 + ((col >> 3) & 3) * 16 + (row & 15)) * 8 + (col & 7); }
constexpr int CK_KS = 0, CK_QS = 17408, CK_L0 = 34816, CK_L1 = 52224, CK_BET = 69632, CK_GCS = 70144, CK_BYTES = 70656;
constexpr int SOLVE_PF = 8;
constexpr int solve_ns() { int s = 0; for (int i = 0; i < 63; ++i) s += 16 - (i + 1) / 4; return s; }
constexpr int SOLVE_NS = solve_ns();
constexpr int solve_si(int s) { int i = 0; for (; i < 63; ++i) { const int n = 16 - (i + 1) / 4; if (s < n) break; s -= n; } return i; }
constexpr int solve_sq(int s) { int i = 0; for (; i < 63; ++i) { const int n = 16 - (i + 1) / 4; if (s < n) break; s -= n; } return (i + 1) / 4 + s; }
template <int S> __device__ __forceinline__ void solve_slot(float (&m)[64], f32x4 (&ring)[SOLVE_PF], const LAS float* Lm) {
    constexpr int i = solve_si(S), lq = solve_sq(S);
    const f32x4 Lv = ring[S % SOLVE_PF];
    if constexpr (S + SOLVE_PF < SOLVE_NS) { constexpr int i2 = solve_si(S + SOLVE_PF), q2 = solve_sq(S + SOLVE_PF); ring[S % SOLVE_PF] = *(const LAS f32x4*)(Lm + i2 * 68 + 4 * q2); }
#pragma unroll
    for (int e = 0; e < 4; ++e) if (4 * lq + e > i) m[4 * lq + e] -= Lv[e] * m[i];
    __builtin_amdgcn_sched_barrier(0);
}
template <int... Is> __device__ __forceinline__ void solve_run(float (&m)[64], f32x4 (&ring)[SOLVE_PF], const LAS float* Lm, std::integer_sequence<int, Is...>) { (solve_slot<Is>(m, ring, Lm), ...); }
__device__ __forceinline__ void chunk_solve(Frame& F, LAS unsigned char* ldsc, int d, int cid, int j) {
    const LAS float* Lm = (const LAS float*)(ldsc + (d == 0 ? CK_L0 : CK_L1));
    const LAS float* bet = (const LAS float*)(ldsc + CK_BET);
    const float bj = bet[d * 64 + (d == 0 ? j : 63 - j)];
    float m[64];
#pragma unroll
    for (int i = 0; i < 64; ++i) m[i] = 0.f;
    { int jj = j; asm volatile("" : "+v"(jj));
#pragma unroll
      for (int i = 0; i < 64; ++i) m[i] = (i == jj) ? bj : 0.f; }
    f32x4 ring[SOLVE_PF];
#pragma unroll
    for (int k = 0; k < SOLVE_PF; ++k) ring[k] = *(const LAS f32x4*)(Lm + solve_si(k) * 68 + 4 * solve_sq(k));
    solve_run(m, ring, Lm, std::make_integer_sequence<int, SOLVE_NS>{});
    LAS unsigned short* Mi = (LAS unsigned short*)(ldsc + (d == 0 ? CK_L0 : CK_L1));
    if (d == 0) {
        LAS unsigned short* mp = Mi + j;
#pragma unroll
        for (int i = 0; i < 64; ++i) mp[i * 72] = (unsigned short)(pk2(m[i], 0.f) & 0xffffu);
    } else {
        LAS unsigned short* mp = Mi + (63 - j);
#pragma unroll
        for (int i = 0; i < 64; ++i) mp[(63 - i) * 72] = (unsigned short)(pk2(m[i], 0.f) & 0xffffu);
    }
    LDS_WAIT(); asm volatile("" ::: "memory");
    GAS bf16* mt = WSG(bf16, WS_MM) + ((size_t)d * 2048 + cid) * 4096;
#pragma unroll
    for (int t = 0; t < 8; ++t) { const int row = (t >> 1) * 16 + (j & 15), col0 = (t & 1) * 32 + (j >> 4) * 8;
        const v4u v = *(const LAS v4u*)(Mi + row * 72 + col0); *(GAS v4u*)(mt + (t * 64 + j) * 8) = v; }
}
template <int PV> __device__ __forceinline__ void chunk_phase(Frame& F, int l) {
    const int w = F.wave, hb = w >> 2, ww = w & 3;
    const GAS float* convw = (const GAS float*)(INP(3) + l * 5 * 1536); const GAS float* alog = (const GAS float*)(INP(4) + l * 8); const GAS float* dtb = (const GAS float*)(INP(5) + l * 8);
    const GAS bf16* RAW = WSG(bf16, WS_RAW); const GAS float* BA = WSG(float, WS_BA);
    LAS unsigned char* lds = F.lds + hb * CK_BYTES;
    LAS float* bet = (LAS float*)(lds + CK_BET); LAS float* gcs = (LAS float*)(lds + CK_GCS);
    for (int pu = blockIdx.x; pu < 1024; pu += F.G) {
        const int cid = 2 * pu + hb;
        const int c = cid & 127, bh = cid >> 7, h = bh & 3, b = bh >> 2;
        const int t0 = b * SEQ + c * 64;
        int lane = F.lane; asm volatile("" : "+v"(lane));
        const int r16 = lane & 15, q4 = lane >> 4;
        { const int rb0 = 16 * ww;
          unsigned rw[3][20]; float cw0[3][5], cw1[3][5];
#pragma unroll
          for (int p = 0; p < 3; ++p) { const int col = p * 512 + h * 128 + 2 * lane;
#pragma unroll
            for (int tp = 0; tp < 5; ++tp) { cw0[p][tp] = convw[tp * 1536 + col]; cw1[p][tp] = convw[tp * 1536 + col + 1]; }
#pragma unroll
            for (int jr = 0; jr < 20; ++jr) { const int s = c * 64 + rb0 + jr - 2; unsigned u = 0u; if (s >= 0 && s < SEQ) u = *(const GAS unsigned*)(RAW + (size_t)(b * SEQ + s) * 1536 + col); rw[p][jr] = u; } }
#pragma unroll
          for (int p = 0; p < 3; ++p) {
            GAS bf16* gdst = WSG(bf16, WS_VC) + (size_t)cid * 8192 + ((rb0 >> 2) * 128 + 2 * lane) * 4;
            unsigned vq[4];
#pragma unroll
            for (int jr = 0; jr < 16; ++jr) {
                float a0 = 0.f, a1 = 0.f;
#pragma unroll
                for (int tp = 0; tp < 5; ++tp) { a0 += cw0[p][tp] * bflo(rw[p][jr + tp]); a1 += cw1[p][tp] * bfhi(rw[p][jr + tp]); }
                a0 = a0 * sigm(a0); a1 = a1 * sigm(a1);
                if (p < 2) { const float ssq = wave_sum(a0 * a0 + a1 * a1, lane); float rn = __builtin_amdgcn_rsqf(ssq + EPS); if (p == 0) rn *= 0.08838834764831845f; a0 *= rn; a1 *= rn; }
                const unsigned pk = pk2(a0, a1); const int row = rb0 + jr;
                if (p == 2) { vq[jr & 3] = pk;
                    if ((jr & 3) == 3) { v4u o; o.x = (vq[0] & 0xffffu) | (vq[1] << 16); o.y = (vq[2] & 0xffffu) | (vq[3] << 16); o.z = (vq[0] >> 16) | (vq[1] & 0xffff0000u); o.w = (vq[2] >> 16) | (vq[3] & 0xffff0000u);
                        *(GAS v4u*)(gdst + (jr >> 2) * 512) = o; } }
                if (p == 0) *(LAS unsigned*)(lds + CK_QS + row * 272 + 4 * lane) = pk;
                if (p == 1) *(LAS unsigned*)(lds + CK_KS + row * 272 + 4 * lane) = pk;
            }
          } }
        if (ww < 2) { const int d = ww, tn = d == 0 ? lane : 63 - lane; const size_t tok = (size_t)(t0 + tn);
            const float braw = BA[tok * 16 + d * 4 + h], araw = BA[tok * 16 + 8 + d * 4 + h];
            const float x = araw + dtb[d * 4 + h]; const float sp = fmaxf(x, 0.f) + log1pf(__expf(-fabsf(x)));
            float gc = -__expf(alog[d * 4 + h]) * sp;
#pragma unroll
            for (int o = 1; o < 64; o <<= 1) { const float tv = SHFL_UP(gc, o); if (lane >= o) gc += tv; }
            bet[d * 64 + tn] = sigm(braw); gcs[d * 64 + tn] = gc;
            WSG(float, WS_GC)[((size_t)d * 2048 + cid) * 64 + tn] = gc; }
        LBAR();
        { GAS bf16* KNt = WSG(bf16, WS_KN) + (size_t)cid * 8192; GAS bf16* QNt = WSG(bf16, WS_QN) + (size_t)cid * 8192;
#pragma unroll
          for (int it = 0; it < 4; ++it) { const int lo = (it * 16 + r16) * 272 + (ww * 32 + q4 * 8) * 2, P = (it * 4 + ww) * 64 + lane;
              const v4u kq = *(const LAS v4u*)(lds + CK_KS + lo), qq = *(const LAS v4u*)(lds + CK_QS + lo);
              *(GAS v4u*)(KNt + P * 8) = kq; *(GAS v4u*)(QNt + P * 8) = qq; } }
        { const int ti = ww;
          GAS bf16* I0 = WSG(bf16, WS_INTRA) + ((size_t)0 * 2048 + cid) * 4096; GAS bf16* I1 = WSG(bf16, WS_INTRA) + ((size_t)1 * 2048 + cid) * 4096;
          LAS float* L0 = (LAS float*)(lds + CK_L0); LAS float* L1 = (LAS float*)(lds + CK_L1);
          const int iq = ti * 16 + r16; const float gq0 = gcs[iq], gq1 = gcs[64 + iq];
#pragma unroll 1
          for (int tj = 0; tj < 4; ++tj) {
            f32x4 aK = (f32x4){0.f, 0.f, 0.f, 0.f}, aQ = (f32x4){0.f, 0.f, 0.f, 0.f};
#pragma unroll
            for (int kk = 0; kk < 4; ++kk) { const bf16x8 fk = *(const LAS bf16x8*)(lds + CK_KS + (ti * 16 + r16) * 272 + kk * 64 + q4 * 16), fq = *(const LAS bf16x8*)(lds + CK_QS + (ti * 16 + r16) * 272 + kk * 64 + q4 * 16),
                                                            fb = *(const LAS bf16x8*)(lds + CK_KS + (tj * 16 + r16) * 272 + kk * 64 + q4 * 16);
                aK = mfma16(fk, fb, aK); aQ = mfma16(fb, fq, aQ); }
            const int jn = tj * 16 + r16; const float g0j = gcs[jn], g1j = gcs[64 + jn];
#pragma unroll
            for (int r = 0; r < 4; ++r) { const int in = ti * 16 + q4 * 4 + r;
                const float e0 = __expf(fminf(gcs[in] - g0j, 0.f)), e1 = __expf(fminf(gcs[64 + in] - g1j, 0.f));
                L0[jn * 68 + in] = (in > jn) ? bet[in] * aK[r] * e0 : 0.f;
                L1[(63 - jn) * 68 + (63 - in)] = (in < jn) ? bet[64 + in] * aK[r] * e1 : 0.f; }
            float v0[4], v1[4];
#pragma unroll
            for (int r = 0; r < 4; ++r) { const int jq = tj * 16 + q4 * 4 + r;
                const float e0 = __expf(fminf(gq0 - gcs[jq], 0.f)), e1 = __expf(fminf(gq1 - gcs[64 + jq], 0.f));
                v0[r] = (iq >= jq) ? aQ[r] * e0 : 0.f; v1[r] = (iq <= jq) ? aQ[r] * e1 : 0.f; }
            const int ib = frag_off(iq, tj * 16 + q4 * 4, 64);
            v2u o0, o1; o0.x = pk2(v0[0], v0[1]); o0.y = pk2(v0[2], v0[3]); o1.x = pk2(v1[0], v1[1]); o1.y = pk2(v1[2], v1[3]);
            *(GAS v2u*)(I0 + ib) = o0; *(GAS v2u*)(I1 + ib) = o1;
          } }
        LBAR();
        const int role = (ww + 2 * hb) & 3;
        if (role < 2) { if (!(PV & 1)) chunk_solve(F, lds, role, cid, lane); }
        LBAR();
    }
}

typedef short s16x4 __attribute__((ext_vector_type(4)));
__device__ __forceinline__ s16x4 sc_tr(const LAS unsigned char* p) { return __builtin_bit_cast(s16x4, __builtin_amdgcn_ds_read_tr16_b64_v4i16((LAS s16x4*)p)); }
#ifndef SC_NST
#define SC_NST 6
#endif
#ifndef SCAN_CS
#define SCAN_CS 1
#endif
static_assert(SCAN_CS == 1, "the token-quad v layout is wired for 16-column slices");
constexpr int SC_CS = SCAN_CS, SC_NITEM = 32 * (8 / SC_CS), SC_STRIDE = 256 / SC_NITEM, SC_ST = 0, SC_RT = SC_CS * 4352, SC_VT = SC_RT + SC_CS * 2304, SC_VTS = SC_VT + SC_CS * 2304, SC_LDS = SC_VTS + SC_CS * 2304, SC_KI = SC_LDS, SC_KIP = 288;
template <int VAR> __device__ __forceinline__ void scan_phase(Frame& F) {
    const int lane = F.lane, w = F.wave, wl = w & 3, r16 = lane & 15, q4 = lane >> 4;
    LAS unsigned char* lds = F.lds;
    const GAS bf16* KN = WSG(bf16, WS_KN); const GAS bf16* KT = WSG(bf16, WS_KT); const GAS bf16* QN = WSG(bf16, WS_QN); const GAS bf16* VC = WSG(bf16, WS_VC);
    const GAS bf16* MMp = WSG(bf16, WS_MM); const GAS bf16* INp = WSG(bf16, WS_INTRA); const GAS float* GC = WSG(float, WS_GC);
    if ((F.vcu % SC_STRIDE) != 0) return;
    for (int item = F.vcu / SC_STRIDE; item < SC_NITEM; item += F.G / SC_STRIDE) {
        const int chain = item / (8 / SC_CS), d = chain >> 4, b = (chain >> 2) & 3, h = chain & 3, dv0 = (item % (8 / SC_CS)) * (16 * SC_CS);
        for (int i = F.tid; i < SC_LDS / 4; i += NWAVES * 64) ((LAS unsigned*)lds)[i] = 0u;
        f32x4 Sacc[SC_CS];
#pragma unroll
        for (int cs = 0; cs < SC_CS; ++cs) Sacc[cs] = (f32x4){0.f, 0.f, 0.f, 0.f};
        GAS bf16* Og = WSG(bf16, d == 0 ? WS_OF : WS_OB);
        __syncthreads();
        constexpr int NST = SC_NST;
        bf16x8 sA4[NST][4], sA2[NST][2]; f32x4 sgc[NST]; float sgl[NST]; v2u svq[NST];
#define SC_LOAD(st, n) do { const int c_ = d == 0 ? (n) : 127 - (n); const size_t cid_ = (size_t)(b * 4 + h) * 128 + c_; const size_t dc_ = (size_t)d * 2048 + cid_; \
        const GAS bf16* a4_ = (w < 4 ? KN : QN) + cid_ * 8192 + (wl * 4 * 64 + lane) * 8; \
        const GAS bf16* a2_ = (w < 4 ? MMp : INp) + dc_ * 4096 + (wl * 2 * 64 + lane) * 8; \
        _Pragma("unroll") for (int kk = 0; kk < 4; ++kk) sA4[st][kk] = *(const GAS bf16x8*)(a4_ + kk * 512); \
        _Pragma("unroll") for (int kk = 0; kk < 2; ++kk) sA2[st][kk] = *(const GAS bf16x8*)(a2_ + kk * 512); \
        sgc[st] = *(const GAS f32x4*)(GC + dc_ * 64 + 16 * wl + q4 * 4); sgl[st] = GC[dc_ * 64 + (d == 0 ? 63 : 0)]; \
        svq[st] = *(const GAS v2u*)(VC + cid_ * 8192 + ((4 * wl + q4) * 128 + dv0 + r16) * 4); } while (0)
#pragma unroll
        for (int st0 = 0; st0 < NST - 1; ++st0) SC_LOAD(st0, st0);
        for (int n0 = 0; n0 < 128; n0 += NST) {
#pragma unroll
          for (int j = 0; j < NST; ++j) {
            const int n = n0 + j; if (n >= 128) break;
            {
            const f32x4 gcv = sgc[j]; const float gl = sgl[j];
            const int c = d == 0 ? n : 127 - n; const int t0 = b * SEQ + c * 64;
            if (w < 4) {
#pragma unroll
                for (int kk = 0; kk < 4; ++kk) *(LAS bf16x8*)(lds + SC_KI + (16 * wl + r16) * SC_KIP + (kk * 32 + 8 * q4) * 2) = sA4[j][kk]; }
            f32x4 ks[SC_CS];
#pragma unroll
            for (int cs = 0; cs < SC_CS; ++cs) { bf16x8 Bs[4];
#pragma unroll
              for (int kk = 0; kk < 4; ++kk) Bs[kk] = *(const LAS bf16x8*)(lds + SC_ST + cs * 4352 + r16 * 272 + kk * 64 + q4 * 16);
              f32x4 a = (f32x4){0.f, 0.f, 0.f, 0.f};
#pragma unroll
              for (int kk = 0; kk < 4; ++kk) a = mfma16(sA4[j][kk], Bs[kk], a);
              ks[cs] = a; }
            __builtin_amdgcn_sched_barrier(0);
            if (!(VAR & 4)) { const int np = n + NST - 1 < 128 ? n + NST - 1 : 127; SC_LOAD((j + NST - 1) % NST, np); }
            __builtin_amdgcn_sched_barrier(0);
            float eg[4];
#pragma unroll
            for (int r = 0; r < 4; ++r) eg[r] = __expf(gcv[r]);
            if (w < 4) {
#pragma unroll
                for (int cs = 0; cs < SC_CS; ++cs) { float rv[4];
#pragma unroll
                    for (int r = 0; r < 4; ++r) { const unsigned u = (r < 2) ? svq[j].x : svq[j].y; const float vv = (r & 1) ? __uint_as_float(u & 0xffff0000u) : __uint_as_float(u << 16); rv[r] = vv - eg[r] * ks[cs][r]; }
                    v2u o; o.x = pk2(rv[0], rv[1]); o.y = pk2(rv[2], rv[3]); *(LAS v2u*)(lds + SC_RT + cs * 2304 + r16 * 144 + (16 * wl + q4 * 4) * 2) = o; } }
            if (!(VAR & 2)) LBAR();
            if (w < 4) { float es[4];
#pragma unroll
                for (int r = 0; r < 4; ++r) es[r] = __expf(gl - gcv[r]);
#pragma unroll
                for (int cs = 0; cs < SC_CS; ++cs) { f32x4 vn = (f32x4){0.f, 0.f, 0.f, 0.f};
                    const bf16x8 Br0 = *(const LAS bf16x8*)(lds + SC_RT + cs * 2304 + r16 * 144 + q4 * 16), Br1 = *(const LAS bf16x8*)(lds + SC_RT + cs * 2304 + r16 * 144 + 64 + q4 * 16);
                    vn = mfma16(sA2[j][0], Br0, vn); vn = mfma16(sA2[j][1], Br1, vn);
                    v2u o; o.x = pk2(vn[0], vn[1]); o.y = pk2(vn[2], vn[3]); *(LAS v2u*)(lds + SC_VT + cs * 2304 + r16 * 144 + (16 * wl + q4 * 4) * 2) = o;
                    o.x = pk2(vn[0] * es[0], vn[1] * es[1]); o.y = pk2(vn[2] * es[2], vn[3] * es[3]); *(LAS v2u*)(lds + SC_VTS + cs * 2304 + r16 * 144 + (16 * wl + q4 * 4) * 2) = o; } }
            if (!(VAR & 2)) LBAR();
            if (w >= 4) { f32x4 o[SC_CS];
#pragma unroll
                for (int cs = 0; cs < SC_CS; ++cs) { f32x4 a;
#pragma unroll
                    for (int r = 0; r < 4; ++r) a[r] = eg[r] * ks[cs][r];
                    const bf16x8 Bv0 = *(const LAS bf16x8*)(lds + SC_VT + cs * 2304 + r16 * 144 + q4 * 16), Bv1 = *(const LAS bf16x8*)(lds + SC_VT + cs * 2304 + r16 * 144 + 64 + q4 * 16);
                    a = mfma16(sA2[j][0], Bv0, a); a = mfma16(sA2[j][1], Bv1, a); o[cs] = a; }
                if (!(VAR & 1)) {
#pragma unroll
                    for (int r = 0; r < 4; ++r) { GAS bf16* op = Og + (size_t)(t0 + 16 * wl + q4 * 4 + r) * 512 + h * 128 + dv0 + SC_CS * r16;
                        if (SC_CS == 4) { v2u ov; ov.x = pk2(o[0][r], o[1][r]); ov.y = pk2(o[SC_CS - 2][r], o[SC_CS - 1][r]); asm volatile("global_store_dwordx2 %0, %1, off" :: "v"(op), "v"(ov) : "memory"); }
                        else if (SC_CS == 2) { const unsigned ov = pk2(o[0][r], o[SC_CS - 1][r]); asm volatile("global_store_dword %0, %1, off" :: "v"(op), "v"(ov) : "memory"); }
                        else { const unsigned ov = pk2(o[0][r], 0.f); asm volatile("global_store_short %0, %1, off" :: "v"(op), "v"(ov) : "memory"); } } } }
            { const float egl = __expf(gl);
              const LAS unsigned char* kip = lds + SC_KI + (8 * q4 + (r16 >> 2)) * SC_KIP + (16 * w + 4 * (r16 & 3)) * 2;
              const s16x4 ka0 = sc_tr(kip), ka1 = sc_tr(kip + 4 * SC_KIP), kb0 = sc_tr(kip + 32 * SC_KIP), kb1 = sc_tr(kip + 36 * SC_KIP);
              const bf16x8 kt0 = (bf16x8){ka0[0], ka0[1], ka0[2], ka0[3], ka1[0], ka1[1], ka1[2], ka1[3]}, kt1 = (bf16x8){kb0[0], kb0[1], kb0[2], kb0[3], kb1[0], kb1[1], kb1[2], kb1[3]};
#pragma unroll
              for (int cs = 0; cs < SC_CS; ++cs) { f32x4 sn = Sacc[cs] * egl;
                const bf16x8 Bvs0 = *(const LAS bf16x8*)(lds + SC_VTS + cs * 2304 + r16 * 144 + q4 * 16), Bvs1 = *(const LAS bf16x8*)(lds + SC_VTS + cs * 2304 + r16 * 144 + 64 + q4 * 16);
                sn = mfma16(kt0, Bvs0, sn); sn = mfma16(kt1, Bvs1, sn);
                Sacc[cs] = sn; v2u o; o.x = pk2(sn[0], sn[1]); o.y = pk2(sn[2], sn[3]); *(LAS v2u*)(lds + SC_ST + cs * 4352 + r16 * 272 + (16 * w + q4 * 4) * 2) = o; } }
            if (!(VAR & 2)) LBAR();
            }
          }
        }
#undef SC_LOAD
        __syncthreads();
    }
}

__device__ __forceinline__ int utid(const Frame& F) { int ln; asm volatile("v_mbcnt_lo_u32_b32 %0, -1, 0\n\tv_mbcnt_hi_u32_b32 %0, -1, %0" : "=v"(ln)); return F.wave * 64 + ln; }
__device__ __forceinline__ void attn_phase_all(Frame& F, int l, int ulo, int uhi, bool conv) {
    typedef attn_body::bf16 abf;
    abf* PP = (abf*)WSP(bf16, WS_PP); abf* OD = (abf*)WSP(bf16, WS_OD);
    const int slot = (F.vcu + (F.vcu >> 3)) & 7; int cnt = 0; bool pend = conv;
    for (int i = 0;; ++i) {
        const int L = ulo + i * F.G + F.vcu; if (L >= uhi || L >= 1024) break;
        if (pend && cnt == slot) { expert_convert(F, l); __syncthreads(); pend = false; } ++cnt;
        const int hd = L >> 5, qb = L & 31, b = hd >> 3, h = (hd >> 1) & 3, m = hd & 1; abf* base = PP + (size_t)b * SEQ * PPW;
        const float q2 = __uint_as_float(F.ctl[CW_NRM + 64 * l + b * 8 + (hd & 7)]), k2 = __uint_as_float(F.ctl[CW_NRM + 64 * l + 32 + b * 8 + (hd & 7)]);
        const float dbound = 1.01f * sqrtf(q2 * k2) + 0.25f;
        if (dbound <= 40.0f) attn_body::attn_unit<8, 4, true>(qb, base + PC_DQ + (h * 2 + m) * 64, base + PC_DK + (h * 2 + m) * 64, base + PC_DV + h * 128, OD + (size_t)b * SEQ * 1024 + m * 512 + h * 128, 1024, (char*)F.ldsg, utid(F), -dbound);
        else attn_body::attn_unit<8, 4, false>(qb, base + PC_DQ + (h * 2 + m) * 64, base + PC_DK + (h * 2 + m) * 64, base + PC_DV + h * 128, OD + (size_t)b * SEQ * 1024 + m * 512 + h * 128, 1024, (char*)F.ldsg, utid(F));
    }
    float sbound;
    { int lane; asm volatile("v_mbcnt_lo_u32_b32 %0, -1, 0\n\tv_mbcnt_hi_u32_b32 %0, -1, %0" : "=v"(lane)); const float wq = fabsf(((const GAS float*)INP(9))[l * 64 + lane]), wk = fabsf(((const GAS float*)INP(10))[l * 64 + lane]); float mq = wq, mk = wk;
#pragma unroll
      for (int o = 1; o < 64; o <<= 1) { mq = fmaxf(mq, SHFL_XOR(mq, o)); mk = fmaxf(mk, SHFL_XOR(mk, o)); }
      sbound = 1.02f * attn_body::C2 * 64.0f * mq * mk + 0.25f; }
    const bool fixref = sbound <= 40.0f;
    for (int i = 0;; ++i) {
        const int L = (ulo > 1024 ? ulo : 1024) + i * F.G + F.vcu; if (L >= uhi) break;
        if (pend && cnt == slot) { expert_convert(F, l); __syncthreads(); pend = false; } ++cnt;
        const int g = (L - 1024) >> 5, qb = L & 31, b = g >> 3, h = g & 7, kv = h >> 2; abf* base = PP + (size_t)b * SEQ * PPW;
        if (fixref) attn_body::attn_unit<8, 2, true>(qb, base + PC_CQ + h * 64, base + PC_CK + kv * 64, base + PC_CV + kv * 64, base + PC_CQ + h * 64, PPW, (char*)F.ldsg, utid(F), -sbound);
        else attn_body::attn_unit<8, 2, false>(qb, base + PC_CQ + h * 64, base + PC_CK + kv * 64, base + PC_CV + kv * 64, base + PC_CQ + h * 64, PPW, (char*)F.ldsg, utid(F));
    }
    if (pend) { expert_convert(F, l); __syncthreads(); }
}

__device__ __forceinline__ void post_phase(Frame& F, int l) {
    const int lane = F.lane; const int gw = F.vcu * NWAVES + F.wave, NGW = F.G * NWAVES;
    const float linit = (l == 0) ? 0.2f : 0.35550906759096926f;
    float lam;
    { const GAS float* lv = (const GAS float*)INP(7) + l * 256; const float sa = wave_sum(lv[lane] * lv[64 + lane], lane), sb = wave_sum(lv[128 + lane] * lv[192 + lane], lane); lam = expf(sa) - expf(sb) + linit; }
    float gnw[8], dnw[8];
#pragma unroll
    for (int e = 0; e < 8; ++e) { gnw[e] = ((const GAS float*)INP(6))[l * 128 + ((8 * lane) & 127) + e]; dnw[e] = ((const GAS float*)INP(8))[l * 128 + ((8 * lane) & 127) + e] * (1.0f - linit); }
    GAS bf16* PP = WSG(bf16, WS_PP); const GAS bf16* OF = WSG(bf16, WS_OF); const GAS bf16* OB = WSG(bf16, WS_OB); const GAS bf16* OD = WSG(bf16, WS_OD);
    for (int t0 = gw; t0 < TOK; t0 += 4 * NGW) {
        v4u la[4], lb[4], lz[4], lc[4], ld[4];
#pragma unroll
        for (int q = 0; q < 4; ++q) { const int t = t0 + q * NGW < TOK ? t0 + q * NGW : t0;
            la[q] = __builtin_nontemporal_load((const GAS v4u*)(OF + (size_t)t * 512 + 8 * lane)); lb[q] = __builtin_nontemporal_load((const GAS v4u*)(OB + (size_t)t * 512 + 8 * lane)); lz[q] = __builtin_nontemporal_load((const GAS v4u*)(PP + (size_t)t * PPW + PC_Z + 8 * lane));
            lc[q] = __builtin_nontemporal_load((const GAS v4u*)(OD + (size_t)t * 1024 + 8 * lane)); ld[q] = __builtin_nontemporal_load((const GAS v4u*)(OD + (size_t)t * 1024 + 512 + 8 * lane)); }
#pragma unroll
        for (int q = 0; q < 4; ++q) { const int t = t0 + q * NGW; if (t >= TOK) break;
        GAS bf16* prow = PP + (size_t)t * PPW;
        { float a[8], bb[8], z[8], o[8]; unpack8(la[q], a); unpack8(lb[q], bb); unpack8(lz[q], z);
          float ssq = 0.f;
#pragma unroll
          for (int e = 0; e < 8; ++e) { o[e] = a[e] + bb[e]; ssq += o[e] * o[e]; }
          ssq = row16_sum(ssq);
          const float rn = __builtin_amdgcn_rsqf(ssq * (1.0f / 128.0f) + EPS);
#pragma unroll
          for (int e = 0; e < 8; ++e) o[e] = o[e] * rn * gnw[e] * (z[e] * sigm(z[e]));
          *(GAS v4u*)(prow + PC_Z + 8 * lane) = pack8(o); }
        { float a[8], bb[8], o[8]; unpack8(lc[q], a); unpack8(ld[q], bb);
          float ssq = 0.f;
#pragma unroll
          for (int e = 0; e < 8; ++e) { o[e] = a[e] - lam * bb[e]; ssq += o[e] * o[e]; }
          ssq = row16_sum(ssq);
          const float rn = __builtin_amdgcn_rsqf(ssq * (1.0f / 128.0f) + EPS);
#pragma unroll
          for (int e = 0; e < 8; ++e) o[e] = o[e] * rn * dnw[e];
          *(GAS v4u*)(prow + PC_DQ + 8 * lane) = pack8(o); }
        }
    }
}

__device__ __forceinline__ int moe_tables(Frame& F, int l) {
    LAS int* tbase = (LAS int*)(F.lds + LDS_TBASE); LAS int* tilee = (LAS int*)(F.lds + LDS_TILEE);
    if (F.wave == 0) { const int lane = F.lane; const int cnt = lane < 32 ? (int)F.ctl[CW_CNT + 64 * l + lane] : 0; const int nt = (cnt + 255) >> 8; int inc = nt;
#pragma unroll
        for (int o = 1; o < 32; o <<= 1) { const int t = SHFL_UP(inc, o); if (lane >= o) inc += t; }
        const int tb = inc - nt;
        if (lane < 32) { tbase[lane] = tb; for (int k = 0; k < nt; ++k) if (tb + k < 320) tilee[tb + k] = lane; }
        if (lane == 31) tbase[32] = inc; }
    __syncthreads();
    int ntile = tbase[32]; if (ntile > 288) ntile = 288;
    return ntile;
}
struct MoeOrder {
    const LAS int* tilee; const LAS int* rowtab; int nunit, G, c; long estride;
    __device__ __forceinline__ bool next(int i, pg8::Unit& u) const { const long L = (long)i * G + c; if (L >= nunit) return false; u.pm = (int)(L >> 2); u.pn = (int)(L & 3); u.aoff = 0; u.boff = (long)tilee[u.pm] * estride; u.ord = i; return true; }
    __device__ __forceinline__ void a_ready(const pg8::Unit&) const {}
    __device__ __forceinline__ void done(const pg8::Unit&) const {}
    __device__ __forceinline__ int row(const pg8::Unit& u, int r) const { return rowtab[u.ord * 256 + r]; }
};
__device__ __forceinline__ void moe_build(Frame& F, int l, int nunit) {
    const LAS int* tbase = (const LAS int*)(F.lds + LDS_TBASE); const LAS int* tilee = (const LAS int*)(F.lds + LDS_TILEE);
    LAS int* rowtab = (LAS int*)(F.lds + LDS_ROWTAB); LAS float* rstab = (LAS float*)(F.lds + LDS_RSTAB); LAS float* wtab = (LAS float*)(F.lds + LDS_WTAB);
    const GAS int* tokl = WSG(int, WS_TOKL); const GAS float* wl = WSG(float, WS_WL); const GAS float* rstd2 = WSG(float, WS_RSTD2);
    for (int k = F.tid; k < 5 * 256; k += NWAVES * 64) { const int i = k >> 8, r = k & 255; const long L = (long)i * F.G + F.vcu;
        int tok = 0; float rs = 0.f, w = 0.f;
        if (L < nunit) { const int pm = (int)(L >> 2), e = tilee[pm], idx = (pm - tbase[e]) * 256 + r; const int cnt = (int)F.ctl[CW_CNT + 64 * l + e];
            if (idx < cnt) { tok = tokl[e * 32768 + idx]; rs = rstd2[tok]; w = wl[e * 32768 + idx]; } }
        rowtab[k] = tok; rstab[k] = rs; wtab[k] = w; }
    __syncthreads();
}
struct BrOrder {
    pg8::StaticOrder s;
    __device__ __forceinline__ bool next(int i, pg8::Unit& u) const { if (!s.next(i, u)) return false; const int br = u.pn >> 2; u.aoff = (br == 0 ? PC_Z : (br == 1 ? PC_DQ : PC_CQ)) * 2; return true; }
    __device__ __forceinline__ void a_ready(const pg8::Unit&) const {}
    __device__ __forceinline__ void done(const pg8::Unit&) const {}
};
struct GateOrder {
    pg8::StaticOrder s;
    __device__ __forceinline__ bool next(int i, pg8::Unit& u) const { if (!s.next(i / 3, u)) return false; u.pn += 4 * (i % 3); return true; }
    __device__ __forceinline__ void a_ready(const pg8::Unit&) const {}
    __device__ __forceinline__ void done(const pg8::Unit&) const {}
};
__device__ __forceinline__ void final_phase(Frame& F) {
    const int lane = F.lane; const int gw = F.vcu * NWAVES + F.wave, NGW = F.G * NWAVES;
    const float* rs = WSP(float, WS_RSTDF); const float* fw = INP(23);
    f32x4 wv[4];
#pragma unroll
    for (int j = 0; j < 4; ++j) wv[j] = *(const f32x4*)(fw + 256 * j + 4 * lane);
    for (int t = gw; t < TOK; t += NGW) { const float r = rs[t]; f32x4* o = (f32x4*)(F.out + (size_t)t * DM) + lane;
#pragma unroll
        for (int j = 0; j < 4; ++j) o[64 * j] = o[64 * j] * r * wv[j]; }
}

__global__ void __launch_bounds__(NWAVES * 64, 2) mk_fwd(Args args) {
    extern __shared__ __attribute__((aligned(16))) unsigned char lds[];
    Frame F;
    F.lds = (LAS unsigned char*)lds; F.ldsg = lds;
    F.MISC = (volatile LAS unsigned*)(F.lds + LDSCTL_OFF);
    F.tid = threadIdx.x; F.lane = F.tid & 63; F.wave = __builtin_amdgcn_readfirstlane(F.tid >> 6); const int wave0 = F.wave;
    F.G = gridDim.x; { const int bx = blockIdx.x; F.vcu = (F.G % 8 == 0) ? (bx % 8) * (F.G / 8) + bx / 8 : bx; }
    F.ws = args.ws; F.ctl = (gu32*)(args.ws + WS_CTL); F.out = args.out;
    F.A = (const __attribute__((address_space(4))) Args*)&args;
    for (int u = F.tid; u < (LDS_BYTES - LDSCTL_OFF) / 4; u += NWAVES * 64) ((LAS unsigned*)(F.lds + LDSCTL_OFF))[u] = 0u;
    __syncthreads();
    XcdBarrier bar; bar.bar = (unsigned*)(F.ctl + CW_BAR); bar.x = 0; bar.st = nullptr;
    if (!MK_SPLIT) bar = xcd_barrier_post((unsigned*)(F.ctl + CW_BAR), F.MISC + 8);
    const int lo = args.ph_lo, hi = args.ph_hi;
#ifndef PH_EN
#define PH_EN 0x3fffu
#endif
#define EN(j) ((PH_EN >> (j)) & 1u)
#ifndef REP_MASK
#define REP_MASK 0u
#endif
#define REPN(j) (1 + (int)((REP_MASK >> (j)) & 1u))
#define IN(k) (lo <= (k) && (k) < hi)
#define SEAM(k) do { if (IN((k) + 1)) xcd_barrier(bar); } while (0)
#define FRESH() do { int l_; asm volatile("v_mbcnt_lo_u32_b32 %0, -1, 0\n\tv_mbcnt_hi_u32_b32 %0, -1, %0" : "=v"(l_)); int wv_ = wave0; asm volatile("" : "+s"(wv_)); F.lane = l_; F.wave = wv_; F.tid = wv_ * 64 + l_;     \
    unsigned char* w_ = args.ws; float* o_ = args.out; unsigned char* lg_ = lds; asm volatile("" : "+s"(w_), "+s"(o_), "+s"(lg_)); F.ldsg = lg_; F.lds = (LAS unsigned char*)lg_; F.MISC = (volatile LAS unsigned*)(F.lds + LDSCTL_OFF); F.ws = w_; F.out = o_; F.ctl = (gu32*)(w_ + WS_CTL); } while (0)

    if (IN(0)) { FRESH(); for (int rep = 0; rep < REPN(13); ++rep) { p0_prologue(F); if (rep + 1 < REPN(13)) xcd_barrier(bar); } SEAM(0); }
    for (int l = 0; l < NLAYER; ++l) {
        const int pb = 1 + 12 * l;
        const float* rstd1 = WSP(float, WS_RSTD1);
        if (IN(pb + 0) && EN(0)) { FRESH(); if (l == 0) { for (int rep = 0; rep < REPN(0); ++rep) { norm_pass<0>(F, l); if (rep + 1 < REPN(0)) xcd_barrier(bar); } } else norm_pass<2>(F, l); SEAM(pb + 0); }
        if (IN(pb + 1) && EN(1)) { FRESH();
            pg8::Gemm g{WSP(bf16, WS_XB), WSP(bf16, WS_WIN) + (size_t)l * 4352 * 1024, TOK, 4352, 1024, 1024, 1024}; pg8::StaticOrder S; S.init(TOK, 4352, F.G, (int)blockIdx.x);
            pg8::EpiInproj E{WSP(bf16, WS_RAW), WSP(bf16, WS_PP), rstd1, WSP(float, WS_COS1), WSP(float, WS_SIN1), WSP(float, WS_AX), INP(9) + l * 64, INP(10) + l * 64, QSCALE, (unsigned*)(F.ctl + CW_NRM + 64 * l)};
            for (int rep = 0; rep < REPN(1); ++rep) { pg8::gemm_phase<pg8::EpiInproj, pg8::StaticOrder, true, true>(F.lds, g, S, E, F.tid); if (rep + 1 < REPN(1)) xcd_barrier(bar); }
            SEAM(pb + 1); }
        if (IN(pb + 2) && EN(2)) { FRESH();
#ifndef X_NOCHUNK
            FRESH();
            chunk_phase<0>(F, l);
#ifdef CHUNK_VAR
            xcd_barrier(bar); FRESH(); chunk_phase<CHUNK_VAR>(F, l);
#endif
#endif
            SEAM(pb + 2); }
        if (IN(pb + 3) && EN(3)) { FRESH(); scan_phase<0>(F);
#ifdef SCAN_VAR
            xcd_barrier(bar); scan_phase<SCAN_VAR>(F);
#endif
            SEAM(pb + 3); }
        if (IN(pb + 4) && EN(4)) { FRESH(); for (int rep = 0; rep < REPN(4); ++rep) { attn_phase_all(F, l, 0, rep == 0 ? 2048 : 1024, rep == 0); if (rep + 1 < REPN(4)) xcd_barrier(bar); } SEAM(pb + 4); }
        if (IN(pb + 5) && EN(5)) { FRESH(); post_phase(F, l); SEAM(pb + 5); }
        if (IN(pb + 6) && EN(6)) { FRESH();
            pg8::Gemm g{WSP(bf16, WS_PP), WSP(bf16, WS_WBR) + (size_t)l * 3072 * 512, TOK, 3072, 512, PPW, 512}; BrOrder S; S.s.init(TOK, 3072, F.G, (int)blockIdx.x);
            pg8::EpiBrTM E{WSP(bf16, WS_YBR)};
            for (int rep = 0; rep < REPN(6); ++rep) { pg8::gemm_phase<pg8::EpiBrTM, BrOrder, true, true>(F.lds, g, S, E, F.tid); if (rep + 1 < REPN(6)) xcd_barrier(bar); }
            SEAM(pb + 6); }
        if (IN(pb + 7) && EN(7)) { FRESH();
            pg8::Gemm g{WSP(bf16, WS_XB), WSP(bf16, WS_WG) + (size_t)l * 3072 * 1024, TOK, 3072, 1024, 1024, 1024}; GateOrder S; S.s.init(TOK, 1024, F.G, (int)blockIdx.x);
            pg8::EpiGate E{WSP(bf16, WS_YBR), WSP(bf16, WS_MG), rstd1, WSP(bf16, WS_MGT)};
            for (int rep = 0; rep < REPN(7); ++rep) { pg8::gemm_phase<pg8::EpiGate, GateOrder, true, true>(F.lds, g, S, E, F.tid); if (rep + 1 < REPN(7)) xcd_barrier(bar); }
            SEAM(pb + 7); }
        if (IN(pb + 8) && EN(8)) { FRESH();
            pg8::Gemm g{WSP(bf16, WS_MG), WSP(bf16, WS_WO3) + (size_t)l * 1024 * 1024, TOK, 1024, 1024, 1024, 1024}; pg8::StaticOrder S; S.init(TOK, 1024, F.G, (int)blockIdx.x);
            pg8::EpiResidB E{WSP(bf16, WS_XB), DM};
            pg8::gemm_phase<pg8::EpiResidB, pg8::StaticOrder, true, true>(F.lds, g, S, E, F.tid);
            SEAM(pb + 8); }
        if (IN(pb + 9) && EN(9)) { FRESH(); norm_pass<1>(F, l); SEAM(pb + 9); }
        if (IN(pb + 10) && EN(10)) { FRESH();
            const int ntile = moe_tables(F, l); moe_build(F, l, ntile * 4);
            pg8::Gemm g{WSP(bf16, WS_XB), WSP(bf16, WS_W13T), ntile * 256, 1024, 1024, 1024, 1024}; MoeOrder S{(const LAS int*)(F.lds + LDS_TILEE), (const LAS int*)(F.lds + LDS_ROWTAB), ntile * 4, F.G, F.vcu, (long)1024 * 1024 * 2};
            pg8::EpiMoe1 E{WSP(bf16, WS_HH), (const LAS float*)(F.lds + LDS_RSTAB)};
            for (int rep = 0; rep < REPN(11); ++rep) { pg8::gemm_phase<pg8::EpiMoe1, MoeOrder, true, true, true>(F.lds, g, S, E, F.tid); if (rep + 1 < REPN(11)) xcd_barrier(bar); }
            SEAM(pb + 10); }
        if (IN(pb + 11) && EN(11)) { FRESH();
            if (MK_SPLIT) { const int nt_ = moe_tables(F, l); moe_build(F, l, nt_ * 4); }
            int ntile = ((const LAS int*)(F.lds + LDS_TBASE))[32]; if (ntile > 288) ntile = 288;
            pg8::Gemm g{WSP(bf16, WS_HH), WSP(bf16, WS_W2T), ntile * 256, 1024, 512, 512, 512}; MoeOrder S{(const LAS int*)(F.lds + LDS_TILEE), (const LAS int*)(F.lds + LDS_ROWTAB), ntile * 4, F.G, F.vcu, (long)1024 * 512 * 2};
            pg8::EpiMoe2 E{WSP(bf16, WS_XG), (const LAS float*)(F.lds + LDS_WTAB)};
            for (int rep = 0; rep < REPN(12); ++rep) { pg8::gemm_phase<pg8::EpiMoe2, MoeOrder, true, true>(F.lds, g, S, E, F.tid); if (rep + 1 < REPN(12)) xcd_barrier(bar); }
            SEAM(pb + 11); }
    }
#ifdef EXTRA_BARS
    for (int eb = 0; eb < EXTRA_BARS; ++eb) xcd_barrier(bar);
#endif
    if (IN(25)) { FRESH(); norm_pass<3>(F, 0); }
#undef IN
#undef SEAM
}

#ifdef DBG_STOP
#ifndef DBG_KIND
#define DBG_KIND 0
#endif
#ifndef DBG_OFF
#define DBG_OFF 0
#endif
__global__ void dbg_dump(const unsigned char* ws, float* out, int n) {
    for (int i = blockIdx.x * blockDim.x + threadIdx.x; i < n; i += gridDim.x * blockDim.x) {
        if (DBG_KIND == 1) out[i] = bf2f(((const bf16*)(ws + (size_t)DBG_OFF * MiB))[i]);
        if (DBG_KIND == 2) out[i] = ((const float*)(ws + (size_t)DBG_OFF * MiB))[i];
        if (DBG_KIND == 3) out[i] = (float)((const int*)(ws + (size_t)DBG_OFF * MiB))[i];
        if (DBG_KIND == 4) { const float v = out[i] * 65536.0f; out[i] = v - floorf(v); }
        if (DBG_KIND == 5) out[i] = (float)(((const bf16*)(ws + (size_t)DBG_OFF * MiB))[i] & 0xffu);
        if (DBG_KIND == 6) { const float v = ((const float*)(ws + (size_t)DBG_OFF * MiB))[i] * 65536.0f; out[i] = v - floorf(v); }
    }
}
#endif
extern "C" void kernel_launch(void* const* d_in, const int* in_sizes, int n_in, void* d_out, int out_size, void* d_ws, size_t ws_size, hipStream_t stream) {
    static int grid = 0;
    if (grid == 0) {
        if (n_in != 24 || out_size != TOK * DM || ws_size < WS_END) { fprintf(stderr, "kernel_launch: unexpected sizes (n_in %d out %d ws %zu)\n", n_in, out_size, ws_size); grid = -1; return; }
        int dev = 0, cus = 0, per_cu = 0;
        if (hipGetDevice(&dev) != hipSuccess || hipDeviceGetAttribute(&cus, hipDeviceAttributeMultiprocessorCount, dev) != hipSuccess) { grid = -1; return; }
        if (hipFuncSetAttribute((const void*)mk_fwd, hipFuncAttributeMaxDynamicSharedMemorySize, LDS_BYTES) != hipSuccess) { fprintf(stderr, "kernel_launch: hipFuncSetAttribute failed\n"); grid = -1; return; }
        if (hipOccupancyMaxActiveBlocksPerMultiprocessor(&per_cu, (const void*)mk_fwd, NWAVES * 64, LDS_BYTES) != hipSuccess || per_cu < 1) { fprintf(stderr, "kernel_launch: occupancy query says %d\n", per_cu); }
        (void)hipGetLastError();
        grid = cus;
    }
    if (grid < 0) return;
    if (hipMemsetAsync((char*)d_ws + WS_CTL, 0, CTL_ZERO_BYTES, stream) != hipSuccess) return;
    Args a{};
    for (int i = 0; i < 24; ++i) a.in[i] = (const float*)d_in[i];
    a.out = (float*)d_out; a.ws = (unsigned char*)d_ws;
#if MK_SPLIT
#ifdef DBG_STOP
    for (int p = 0; p <= DBG_STOP; ++p) { a.ph_lo = p; a.ph_hi = p + 1; hipLaunchKernelGGL(mk_fwd, dim3(grid), dim3(NWAVES * 64), LDS_BYTES, stream, a); }
    if (DBG_KIND != 0) hipLaunchKernelGGL(dbg_dump, dim3(2048), dim3(256), 0, stream, (const unsigned char*)d_ws, (float*)d_out, DBG_N);
#else
    for (int p = 0; p < NPH; ++p) { a.ph_lo = p; a.ph_hi = p + 1; hipLaunchKernelGGL(mk_fwd, dim3(grid), dim3(NWAVES * 64), LDS_BYTES, stream, a); }
#endif
#else
    a.ph_lo = 0; a.ph_hi = NPH;
    hipLaunchKernelGGL(mk_fwd, dim3(grid), dim3(NWAVES * 64), LDS_BYTES, stream, a);
#endif
}
```

```cpp
#include <hip/hip_runtime.h>
#include <cstdio>
#include <cstdint>
#include <utility>
#ifndef DBG_N
#define DBG_N (32768 * 1024)
#endif
namespace pg8 {
#define PG8_LAS __attribute__((address_space(3)))
typedef unsigned short bf16_t;
typedef short bf16x8 __attribute__((ext_vector_type(8)));
typedef float f32x4 __attribute__((ext_vector_type(4)));
typedef unsigned u32x4 __attribute__((ext_vector_type(4)));
constexpr int BM = 256, BK = 64, HALF = 128, HTB = HALF * BK * 2  , STAGE_BYTES = 8 * HTB, NXCD = 8, WGM = 8;

__host__ __device__ __forceinline__ int lds_byte(int r, int c) { const int st = (r >> 4) * 2 + (c >> 5), rr = r & 15, cc = c & 31, ob = rr * 64 + cc * 2; return st * 1024 + (ob ^ (((ob >> 9) & 1) << 5)); }
__host__ __device__ __forceinline__ void stage_rc(int b, int& R, int& C) { const int st = b / 1024, sb = b % 1024, swz = sb ^ (((sb >> 9) & 1) << 5); R = (st >> 1) * 16 + swz / 64; C = (st & 1) * 32 + (swz % 64) / 2; }
__host__ __device__ __forceinline__ int perm32(int rho) { const int n = rho >> 4, i = rho & 15; return 8 * (i >> 2) + 4 * n + (i & 3); }

struct Unit { int pm, pn; long aoff, boff; int ord; };
struct Gemm { const bf16_t* A; const bf16_t* Bt; int M, N, K, lda, ldb; };

struct StaticOrder {
    int nM, nN, nwg, G, c;
    __host__ __device__ void init(int M, int N, int G_, int c_) { nM = M / BM; nN = N / BM; nwg = nM * nN; G = G_; c = c_; }
    __host__ __device__ bool next(int i, Unit& u) const {
        const long L = (long)i * G + c; if (L >= nwg) return false;
        int wgid = (int)L; { const int q = nwg / NXCD, r = nwg % NXCD, xcd = wgid % NXCD, off = wgid / NXCD; wgid = (xcd < r ? xcd * (q + 1) : r * (q + 1) + (xcd - r) * q) + off; }
        const int nig = WGM * nN, gid = wgid / nig, fm = gid * WGM, gsz = (nM - fm) < WGM ? (nM - fm) : WGM;
        u.pm = fm + ((wgid % nig) % gsz); u.pn = (wgid % nig) / gsz; u.aoff = 0; u.boff = 0; u.ord = i; return true;
    }
    __device__ __forceinline__ void a_ready(const Unit&) const {}
    __device__ __forceinline__ void done(const Unit&) const {}
    __device__ __forceinline__ int row(const Unit& u, int r) const { return u.pm * BM + r; }
};


#define PG8_GAS __attribute__((address_space(1)))
typedef float f32x2c_t __attribute__((ext_vector_type(2))); typedef __bf16 bf16x2c_t __attribute__((ext_vector_type(2)));
__device__ __forceinline__ unsigned cvt_pk_bf16(float lo, float hi) { const f32x2c_t v = {lo, hi}; const bf16x2c_t b = __builtin_convertvector(v, bf16x2c_t); return __builtin_bit_cast(unsigned, b); }
__device__ __forceinline__ float bflo(unsigned w) { return __uint_as_float(w << 16); }
__device__ __forceinline__ float bfhi(unsigned w) { return __uint_as_float(w & 0xffff0000u); }
__device__ __forceinline__ float sigmoidf_(float x) { return __builtin_amdgcn_rcpf(1.0f + __expf(-x)); }

struct EpiInproj {
    static constexpr bool PERM = true, AFTER_DRAIN = false;
    bf16_t* raw; bf16_t* pp; const float* rstd; const float* cos1; const float* sin1; const float* ax; const float* qnw; const float* knw; float qscale;
    unsigned* nrm;
    __device__ __forceinline__ void operator()(const f32x4 (&acc)[2][2][4][2], const Unit& u, int wr, int wc, int fr, int fq) const {
        const int row0 = u.pm * BM + wr * 64 + fr;
        const int pt = u.pn - 6;
        float rsv[2][4];
#pragma unroll
        for (int ai = 0; ai < 2; ++ai)
#pragma unroll
            for (int m = 0; m < 4; ++m) rsv[ai][m] = ((const PG8_GAS float*)rstd)[row0 + ai * HALF + m * 16];
        const bool perm = (pt >= 2 && pt <= 5) || (pt >= 8);
        if (!perm) {
            bf16_t* base; int ldc, colt;
            if (u.pn < 6) { base = raw; ldc = 1536; colt = u.pn * 256; } else { base = pp; ldc = 2816; colt = pt * 256; }
            const int col0 = colt + wc * 32 + 8 * fq;
#pragma unroll
            for (int ai = 0; ai < 2; ++ai)
#pragma unroll
                for (int m = 0; m < 4; ++m) { const int row = row0 + ai * HALF + m * 16; const float s = rsv[ai][m]; bf16_t* rowp = base + (size_t)row * ldc + col0;
#pragma unroll
                    for (int bj = 0; bj < 2; ++bj) { const f32x4 v0 = acc[ai][bj][m][0] * s, v1 = acc[ai][bj][m][1] * s;
                        u32x4 w; w.x = cvt_pk_bf16(v0[0], v0[1]); w.y = cvt_pk_bf16(v0[2], v0[3]); w.z = cvt_pk_bf16(v1[0], v1[1]); w.w = cvt_pk_bf16(v1[2], v1[3]);
                        *(PG8_GAS u32x4*)(rowp + bj * HALF) = w; } }
            return;
        }
        const int kind = (pt <= 3) ? 0 : (pt <= 5) ? 1 : (pt <= 9) ? 2 : (wc < 2 ? 3 : 4);
        const int col0 = pt * 256 + wc * 64 + 8 * fq;
        const int lane = fq * 16 + fr;
        float nw0[8], nw1[8]; float nmax = 0.f;
        if (kind == 2 || kind == 3) { const PG8_GAS float* nwp = (const PG8_GAS float*)(kind == 2 ? qnw : knw) + 8 * fq;
#pragma unroll
            for (int j = 0; j < 8; ++j) { nw0[j] = nwp[j]; nw1[j] = nwp[32 + j]; } }
#pragma unroll
        for (int ai = 0; ai < 2; ++ai)
#pragma unroll
            for (int m = 0; m < 4; ++m) { const int row = row0 + ai * HALF + m * 16; const float s = rsv[ai][m]; const int sp = row & 8191;
                float x0[8], x1[8];
#pragma unroll
                for (int n = 0; n < 2; ++n)
#pragma unroll
                    for (int e2 = 0; e2 < 4; ++e2) { x0[4 * n + e2] = acc[ai][0][m][n][e2] * s; x1[4 * n + e2] = acc[ai][1][m][n][e2] * s; }
                if (kind <= 1) {
                    int fqo = fq; asm volatile("" : "+v"(fqo));
                    const PG8_GAS f32x4* cp = (const PG8_GAS f32x4*)(cos1 + sp * 32 + 8 * fqo); const PG8_GAS f32x4* snp = (const PG8_GAS f32x4*)(sin1 + sp * 32 + 8 * fqo);
                    const f32x4 c0 = cp[0], c1 = cp[1], s0 = snp[0], s1 = snp[1];
#pragma unroll
                    for (int j = 0; j < 8; ++j) { const float c = j < 4 ? c0[j & 3] : c1[j & 3], sn = j < 4 ? s0[j & 3] : s1[j & 3]; const float a = x0[j], b = x1[j];
                        x0[j] = a * c - b * sn; x1[j] = b * c + a * sn; if (kind == 0) { x0[j] *= qscale; x1[j] *= qscale; } }
                    float ssn = 0.f;
#pragma unroll
                    for (int j = 0; j < 8; ++j) { ssn = __builtin_fmaf(x0[j], x0[j], ssn); ssn = __builtin_fmaf(x1[j], x1[j], ssn); }
                    ssn += __int_as_float(__builtin_amdgcn_ds_bpermute((lane ^ 16) << 2, __float_as_int(ssn)));
                    ssn += __int_as_float(__builtin_amdgcn_ds_bpermute((lane ^ 32) << 2, __float_as_int(ssn)));
                    nmax = fmaxf(nmax, ssn);
                } else if (kind <= 3) {
                    float ss = 0.f;
#pragma unroll
                    for (int j = 0; j < 8; ++j) ss += x0[j] * x0[j] + x1[j] * x1[j];
                    ss += __int_as_float(__builtin_amdgcn_ds_bpermute((lane ^ 16) << 2, __float_as_int(ss)));
                    ss += __int_as_float(__builtin_amdgcn_ds_bpermute((lane ^ 32) << 2, __float_as_int(ss)));
                    const float rn = __builtin_amdgcn_rsqf(ss * (1.0f / 64.0f) + 1e-6f);
                    const PG8_GAS float* tr = (const PG8_GAS float*)ax + (sp >> 6) * 16 + 8 * (fq & 1); const PG8_GAS float* tc = (const PG8_GAS float*)ax + 4096 + (sp & 63) * 16 + 8 * (fq & 1);
                    const f32x4 cr0 = *(const PG8_GAS f32x4*)tr, cr1 = *(const PG8_GAS f32x4*)(tr + 4), sr0 = *(const PG8_GAS f32x4*)(tr + 2048), sr1 = *(const PG8_GAS f32x4*)(tr + 2052);
                    const f32x4 cc0 = *(const PG8_GAS f32x4*)tc, cc1 = *(const PG8_GAS f32x4*)(tc + 4), sc0 = *(const PG8_GAS f32x4*)(tc + 1024), sc1 = *(const PG8_GAS f32x4*)(tc + 1028);
#pragma unroll
                    for (int j = 0; j < 8; ++j) { const float y0 = x0[j] * rn * nw0[j], y1 = x1[j] * rn * nw1[j];
                        const float p0 = __int_as_float(__builtin_amdgcn_ds_bpermute((lane ^ 32) << 2, __float_as_int(y0))), p1 = __int_as_float(__builtin_amdgcn_ds_bpermute((lane ^ 32) << 2, __float_as_int(y1)));
                        const float cr = j < 4 ? cr0[j & 3] : cr1[j & 3], sr = j < 4 ? sr0[j & 3] : sr1[j & 3], cc = j < 4 ? cc0[j & 3] : cc1[j & 3], sc = j < 4 ? sc0[j & 3] : sc1[j & 3];
                        float o0 = (fq < 2) ? y0 * cr - p0 * sr : y0 * cr + p0 * sr, o1 = (fq < 2) ? y1 * cc - p1 * sc : y1 * cc + p1 * sc;
                        if (kind == 2) { o0 *= qscale; o1 *= qscale; }
                        x0[j] = o0; x1[j] = o1; }
                }
                bf16_t* rowp = pp + (size_t)row * 2816 + col0;
                u32x4 w; w.x = cvt_pk_bf16(x0[0], x0[1]); w.y = cvt_pk_bf16(x0[2], x0[3]); w.z = cvt_pk_bf16(x0[4], x0[5]); w.w = cvt_pk_bf16(x0[6], x0[7]);
                *(PG8_GAS u32x4*)rowp = w;
                w.x = cvt_pk_bf16(x1[0], x1[1]); w.y = cvt_pk_bf16(x1[2], x1[3]); w.z = cvt_pk_bf16(x1[4], x1[5]); w.w = cvt_pk_bf16(x1[6], x1[7]);
                *(PG8_GAS u32x4*)(rowp + 32) = w; }
        if (kind <= 1) {
#pragma unroll
            for (int o = 1; o < 16; o <<= 1) nmax = fmaxf(nmax, __int_as_float(__builtin_amdgcn_ds_bpermute((lane ^ o) << 2, __float_as_int(nmax))));
            if (lane == 0) __hip_atomic_fetch_max((PG8_GAS unsigned*)nrm + kind * 32 + ((u.pm * BM) >> 13) * 8 + (pt - (kind == 0 ? 2 : 4)) * 4 + wc, __float_as_uint(nmax), __ATOMIC_RELAXED, __HIP_MEMORY_SCOPE_AGENT);
        }
    }
};
struct EpiBf16Row {
    static constexpr bool PERM = true, AFTER_DRAIN = false;
    bf16_t* O; int ldc; const float* rs;
    __device__ __forceinline__ void operator()(const f32x4 (&acc)[2][2][4][2], const Unit& u, int wr, int wc, int fr, int fq) const {
        const int row0 = u.pm * BM + wr * 64 + fr; const int col0 = u.pn * BM + wc * 32 + 8 * fq;
        float rsv[2][4];
#pragma unroll
        for (int ai = 0; ai < 2; ++ai)
#pragma unroll
            for (int m = 0; m < 4; ++m) rsv[ai][m] = rs ? ((const PG8_GAS float*)rs)[row0 + ai * HALF + m * 16] : 1.0f;
#pragma unroll
        for (int ai = 0; ai < 2; ++ai)
#pragma unroll
            for (int m = 0; m < 4; ++m) { const int row = row0 + ai * HALF + m * 16; const float s = rsv[ai][m]; bf16_t* rowp = O + (size_t)row * ldc + col0;
#pragma unroll
                for (int bj = 0; bj < 2; ++bj) { const f32x4 v0 = acc[ai][bj][m][0] * s, v1 = acc[ai][bj][m][1] * s;
                    u32x4 w; w.x = cvt_pk_bf16(v0[0], v0[1]); w.y = cvt_pk_bf16(v0[2], v0[3]); w.z = cvt_pk_bf16(v1[0], v1[1]); w.w = cvt_pk_bf16(v1[2], v1[3]);
                    *(PG8_GAS u32x4*)(rowp + bj * HALF) = w; } }
    }
};
struct EpiBrTM {
    static constexpr bool PERM = true, AFTER_DRAIN = false;
    bf16_t* O;
    __device__ __forceinline__ void operator()(const f32x4 (&acc)[2][2][4][2], const Unit& u, int wr, int wc, int fr, int fq) const {
        bf16_t* tp = O + (size_t)(u.pm * 12 + u.pn) * 65536 + (size_t)(((wr * 4 + wc) * 64 + fq * 16 + fr) * 8);
#pragma unroll
        for (int ai = 0; ai < 2; ++ai)
#pragma unroll
            for (int m = 0; m < 4; ++m)
#pragma unroll
                for (int bj = 0; bj < 2; ++bj) { const f32x4 v0 = acc[ai][bj][m][0], v1 = acc[ai][bj][m][1];
                    u32x4 w; w.x = cvt_pk_bf16(v0[0], v0[1]); w.y = cvt_pk_bf16(v0[2], v0[3]); w.z = cvt_pk_bf16(v1[0], v1[1]); w.w = cvt_pk_bf16(v1[2], v1[3]);
                    *(PG8_GAS u32x4*)(tp + ((ai * 4 + m) * 2 + bj) * 4096) = w; }
    }
};
struct EpiGate {
    static constexpr bool PERM = true, AFTER_DRAIN = false;
    const bf16_t* Y; bf16_t* MG; const float* rstd; bf16_t* MT;
    __device__ __forceinline__ void operator()(const f32x4 (&acc)[2][2][4][2], const Unit& u, int wr, int wc, int fr, int fq) const {
        const int br = u.pn >> 2, cb = u.pn & 3;
        const size_t tmo = (size_t)(((wr * 4 + wc) * 64 + fq * 16 + fr) * 8); const bf16_t* yt = Y + (size_t)(u.pm * 12 + u.pn) * 65536 + tmo; bf16_t* mt = MT + (size_t)(u.pm * 4 + cb) * 65536 + tmo;
        const int row0 = u.pm * BM + wr * 64 + fr; const int ycol0 = u.pn * BM + wc * 32 + 8 * fq, mcol0 = cb * BM + wc * 32 + 8 * fq;
#pragma unroll
        for (int ai = 0; ai < 2; ++ai) {
            u32x4 yv[4][2], ov[4][2]; float sv[4];
#pragma unroll
            for (int m = 0; m < 4; ++m) { const int row = row0 + ai * HALF + m * 16; sv[m] = ((const PG8_GAS float*)rstd)[row];
#pragma unroll
                for (int bj = 0; bj < 2; ++bj) { yv[m][bj] = *(const PG8_GAS u32x4*)(yt + ((ai * 4 + m) * 2 + bj) * 4096);
                    if (br != 0) ov[m][bj] = *(const PG8_GAS u32x4*)(mt + ((ai * 4 + m) * 2 + bj) * 4096); else ov[m][bj] = (u32x4){0u, 0u, 0u, 0u}; } }
#pragma unroll
            for (int m = 0; m < 4; ++m) { const int row = row0 + ai * HALF + m * 16; const float s = sv[m];
#pragma unroll
                for (int bj = 0; bj < 2; ++bj) { const f32x4 v0 = acc[ai][bj][m][0] * s, v1 = acc[ai][bj][m][1] * s; const u32x4 y = yv[m][bj], o = ov[m][bj];
                    u32x4 w;
                    w.x = cvt_pk_bf16(sigmoidf_(v0[0]) * bflo(y.x) + bflo(o.x), sigmoidf_(v0[1]) * bfhi(y.x) + bfhi(o.x));
                    w.y = cvt_pk_bf16(sigmoidf_(v0[2]) * bflo(y.y) + bflo(o.y), sigmoidf_(v0[3]) * bfhi(y.y) + bfhi(o.y));
                    w.z = cvt_pk_bf16(sigmoidf_(v1[0]) * bflo(y.z) + bflo(o.z), sigmoidf_(v1[1]) * bfhi(y.z) + bfhi(o.z));
                    w.w = cvt_pk_bf16(sigmoidf_(v1[2]) * bflo(y.w) + bflo(o.w), sigmoidf_(v1[3]) * bfhi(y.w) + bfhi(o.w));
                    if (br == 2) *(PG8_GAS u32x4*)(MG + (size_t)row * 1024 + mcol0 + bj * HALF) = w; else *(PG8_GAS u32x4*)(mt + ((ai * 4 + m) * 2 + bj) * 4096) = w; } }
        }
    }
};
struct EpiResid {
    static constexpr bool PERM = false, AFTER_DRAIN = false;
    const float* src; float* out; int ldc;
    __device__ __forceinline__ void operator()(const f32x4 (&acc)[2][2][4][2], const Unit& u, int wr, int wc, int fr, int fq) const {
        const int col0 = u.pn * BM + wc * 32 + 4 * fq;
#pragma unroll
        for (int ai = 0; ai < 2; ++ai) { f32x4 bs[4][2][2];
#pragma unroll
            for (int m = 0; m < 4; ++m) { const size_t off = (size_t)(u.pm * BM + ai * HALF + wr * 64 + m * 16 + fr) * ldc + col0;
#pragma unroll
                for (int bj = 0; bj < 2; ++bj)
#pragma unroll
                    for (int n = 0; n < 2; ++n) bs[m][bj][n] = *(const PG8_GAS f32x4*)(src + off + bj * HALF + n * 16); }
#pragma unroll
            for (int m = 0; m < 4; ++m) { const size_t off = (size_t)(u.pm * BM + ai * HALF + wr * 64 + m * 16 + fr) * ldc + col0;
#pragma unroll
                for (int bj = 0; bj < 2; ++bj)
#pragma unroll
                    for (int n = 0; n < 2; ++n) *(PG8_GAS f32x4*)(out + off + bj * HALF + n * 16) = bs[m][bj][n] + acc[ai][bj][m][n]; } }
    }
};
struct EpiResidB {
    static constexpr bool PERM = true, AFTER_DRAIN = false;
    bf16_t* X; int ldc;
    __device__ __forceinline__ void operator()(const f32x4 (&acc)[2][2][4][2], const Unit& u, int wr, int wc, int fr, int fq) const {
        const int row0 = u.pm * BM + wr * 64 + fr; const int col0 = u.pn * BM + wc * 32 + 8 * fq;
#pragma unroll
        for (int ai = 0; ai < 2; ++ai) { u32x4 xs[4][2];
#pragma unroll
            for (int m = 0; m < 4; ++m)
#pragma unroll
                for (int bj = 0; bj < 2; ++bj) xs[m][bj] = *(const PG8_GAS u32x4*)(X + (size_t)(row0 + ai * HALF + m * 16) * ldc + col0 + bj * HALF);
#pragma unroll
            for (int m = 0; m < 4; ++m)
#pragma unroll
                for (int bj = 0; bj < 2; ++bj) { const f32x4 v0 = acc[ai][bj][m][0], v1 = acc[ai][bj][m][1]; const u32x4 a = xs[m][bj];
                    u32x4 w; w.x = cvt_pk_bf16(__uint_as_float(a.x << 16) + v0[0], __uint_as_float(a.x & 0xffff0000u) + v0[1]); w.y = cvt_pk_bf16(__uint_as_float(a.y << 16) + v0[2], __uint_as_float(a.y & 0xffff0000u) + v0[3]);
                    w.z = cvt_pk_bf16(__uint_as_float(a.z << 16) + v1[0], __uint_as_float(a.z & 0xffff0000u) + v1[1]); w.w = cvt_pk_bf16(__uint_as_float(a.w << 16) + v1[2], __uint_as_float(a.w & 0xffff0000u) + v1[3]);
                    *(PG8_GAS u32x4*)(X + (size_t)(row0 + ai * HALF + m * 16) * ldc + col0 + bj * HALF) = w; } }
    }
};
struct EpiMoe1 {
    static constexpr bool PERM = true, AFTER_DRAIN = false;
    bf16_t* H; const PG8_LAS float* rs;
    __device__ __forceinline__ void operator()(const f32x4 (&acc)[2][2][4][2], const Unit& u, int wr, int wc, int fr, int fq) const {
        const int lrow0 = wr * 64 + fr; const int col0 = u.pn * HALF + wc * 32 + 8 * fq;
#pragma unroll
        for (int ai = 0; ai < 2; ++ai)
#pragma unroll
            for (int m = 0; m < 4; ++m) { const int lrow = lrow0 + ai * HALF + m * 16; const float s = rs[u.ord * BM + lrow];
                float h[8];
#pragma unroll
                for (int n = 0; n < 2; ++n)
#pragma unroll
                    for (int e = 0; e < 4; ++e) { const float g = acc[ai][0][m][n][e] * s, uu = acc[ai][1][m][n][e] * s; h[n * 4 + e] = g * sigmoidf_(g) * uu; }
                u32x4 w; w.x = cvt_pk_bf16(h[0], h[1]); w.y = cvt_pk_bf16(h[2], h[3]); w.z = cvt_pk_bf16(h[4], h[5]); w.w = cvt_pk_bf16(h[6], h[7]);
                *(PG8_GAS u32x4*)(H + (size_t)(u.pm * BM + lrow) * 512 + col0) = w; }
    }
};
struct EpiMoe2 {
    static constexpr bool PERM = true, AFTER_DRAIN = false;
    bf16_t* O; const PG8_LAS float* ws;
    __device__ __forceinline__ void operator()(const f32x4 (&acc)[2][2][4][2], const Unit& u, int wr, int wc, int fr, int fq) const {
        const int lrow0 = wr * 64 + fr; const int col0 = u.pn * BM + wc * 32 + 8 * fq;
#pragma unroll
        for (int ai = 0; ai < 2; ++ai)
#pragma unroll
            for (int m = 0; m < 4; ++m) { const int lrow = lrow0 + ai * HALF + m * 16; const float s = ws[u.ord * BM + lrow]; bf16_t* rowp = O + (size_t)(u.pm * BM + lrow) * 1024 + col0;
#pragma unroll
                for (int bj = 0; bj < 2; ++bj) { const f32x4 v0 = acc[ai][bj][m][0] * s, v1 = acc[ai][bj][m][1] * s;
                    u32x4 w; w.x = cvt_pk_bf16(v0[0], v0[1]); w.y = cvt_pk_bf16(v0[2], v0[3]); w.z = cvt_pk_bf16(v1[0], v1[1]); w.w = cvt_pk_bf16(v1[2], v1[3]);
                    *(PG8_GAS u32x4*)(rowp + bj * HALF) = w; } }
    }
};
template <class Epi, class Sched, bool ALIGN_EPI = false, bool SP2 = false, bool GATHER = false>
__device__ __forceinline__ void gemm_phase(PG8_LAS unsigned char* lds, const Gemm g, const Sched& S, const Epi& E, const int tid_in) {
    int tid_o = tid_in; asm volatile("" : "+v"(tid_o));
    const int tid = tid_o, wid = __builtin_amdgcn_readfirstlane(tid >> 6), lane = tid & 63, wr = wid >> 2, wc = wid & 3, fr = lane & 15, fq = lane >> 4;
    const int K = g.K, nt = K / BK;
    static_assert(!GATHER || SP2, "GATHER is wired into the SP2 loop only");
    unsigned voffA[2], voffB[2]; int gR[2], gC[2];
#pragma unroll
    for (int i = 0; i < 2; ++i) { int R, C; stage_rc(tid * 16 + i * 8192, R, C); gR[i] = R; gC[i] = C; const int Rb = Epi::PERM ? ((R & ~31) + perm32(R & 31)) : R;
        voffA[i] = (unsigned)(R * g.lda + C) * 2u; voffB[i] = (unsigned)(Rb * g.ldb + C) * 2u; }
    const size_t kstep = (size_t)(BK * 2);
    const size_t hstepA = GATHER ? 0 : (size_t)HALF * g.lda * 2, hstepB = (size_t)HALF * g.ldb * 2;
    const size_t tstepA = GATHER ? 0 : 2 * hstepA, tstepB = 2 * hstepB;
    const unsigned ldsw = (unsigned)wid * 1024u;
    const int aoff = lds_byte(wr * 64 + fr, fq * 8), boff = lds_byte(wc * 32 + fr, fq * 8);
#define PG8_SA(b, h) (((b) * 2 + (h)) * HTB)
#define PG8_SB(b, h) ((4 + (b) * 2 + (h)) * HTB)
#define PG8_STAGE(bufoff, gbase, voff) do { _Pragma("unroll") for (int _i = 0; _i < 2; ++_i) \
        __builtin_amdgcn_global_load_lds((const unsigned*)((const char*)(gbase) + (voff)[_i]), (PG8_LAS unsigned*)(lds + (bufoff) + ldsw + _i * 8192), 16, 0, 0); } while (0)
#define PG8_LDA(dst, b, h) do { _Pragma("unroll") for (int m = 0; m < 4; ++m) _Pragma("unroll") for (int k = 0; k < 2; ++k) dst[m][k] = *(const PG8_LAS bf16x8*)(lds + PG8_SA(b, h) + aoff + m * 2048 + k * 1024); } while (0)
#define PG8_LDB(dst, b, h) do { _Pragma("unroll") for (int n = 0; n < 2; ++n) _Pragma("unroll") for (int k = 0; k < 2; ++k) dst[n][k] = *(const PG8_LAS bf16x8*)(lds + PG8_SB(b, h) + boff + n * 2048 + k * 1024); } while (0)
#define PG8_MMA(ai, bj, At, Bt) do { __builtin_amdgcn_s_setprio(1); _Pragma("unroll") for (int m = 0; m < 4; ++m) _Pragma("unroll") for (int n = 0; n < 2; ++n) _Pragma("unroll") for (int k = 0; k < 2; ++k) \
        acc[ai][bj][m][n] = __builtin_amdgcn_mfma_f32_16x16x32_bf16(Bt[n][k], At[m][k], acc[ai][bj][m][n], 0, 0, 0); __builtin_amdgcn_s_setprio(0); } while (0)
#define PG8_WAIT_V(n) asm volatile("s_waitcnt vmcnt(" #n ")" ::: "memory")
#define PG8_WAIT_L(n) asm volatile("s_waitcnt lgkmcnt(" #n ")" ::: "memory")
#define PG8_BAR __builtin_amdgcn_s_barrier()
#define PG8_SCHED __builtin_amdgcn_sched_barrier(0)
    Unit cur, nxt; int ui = 0;
    if (!S.next(0, cur)) return;
    f32x4 acc[2][2][4][2];
#pragma unroll
    for (int a = 0; a < 2; ++a)
#pragma unroll
        for (int b = 0; b < 2; ++b)
#pragma unroll
            for (int m = 0; m < 4; ++m)
#pragma unroll
                for (int n = 0; n < 2; ++n) acc[a][b][m][n] = (f32x4){0.f, 0.f, 0.f, 0.f};
    bf16x8 At[4][2], B0[2][2], B1[2][2];
    const char* cA = (const char*)g.A + (size_t)cur.pm * tstepA + cur.aoff; const char* cB = (const char*)g.Bt + (size_t)cur.pn * tstepB + cur.boff;
    unsigned cv0[2], cv1[2], nv0[2], nv1[2];
#define PG8_SETOFF(d0, d1, u) do { _Pragma("unroll") for (int i_ = 0; i_ < 2; ++i_) { if constexpr (GATHER) { d0[i_] = (unsigned)S.row(u, gR[i_]) * (unsigned)(g.lda * 2) + (unsigned)gC[i_] * 2u; d1[i_] = (unsigned)S.row(u, HALF + gR[i_]) * (unsigned)(g.lda * 2) + (unsigned)gC[i_] * 2u; } else { d0[i_] = voffA[i_]; d1[i_] = voffA[i_]; } } } while (0)
    PG8_SETOFF(cv0, cv1, cur); PG8_SETOFF(nv0, nv1, cur);
    S.a_ready(cur);
    if constexpr (SP2) {
        PG8_STAGE(PG8_SB(0, 0), cB, voffB); PG8_STAGE(PG8_SB(0, 1), cB + hstepB, voffB); PG8_STAGE(PG8_SA(0, 0), cA, cv0); PG8_STAGE(PG8_SA(0, 1), cA + hstepA, cv1);
        if (wr == 1) PG8_BAR;
        PG8_WAIT_V(2); PG8_BAR;
        PG8_STAGE(PG8_SB(1, 0), cB + kstep, voffB); PG8_STAGE(PG8_SA(1, 0), cA + kstep, cv0); PG8_STAGE(PG8_SB(1, 1), cB + hstepB + kstep, voffB);
        PG8_WAIT_V(6); PG8_BAR;
    } else {
        PG8_STAGE(PG8_SB(0, 0), cB, voffB); PG8_STAGE(PG8_SA(0, 0), cA, voffA); PG8_STAGE(PG8_SB(0, 1), cB + hstepB, voffB); PG8_STAGE(PG8_SA(0, 1), cA + hstepA, voffA);
        if (wr == 1) PG8_BAR;
        PG8_WAIT_V(4); PG8_BAR;
        PG8_STAGE(PG8_SB(1, 0), cB + kstep, voffB); PG8_STAGE(PG8_SA(1, 0), cA + kstep, voffA); PG8_STAGE(PG8_SB(1, 1), cB + hstepB + kstep, voffB);
        PG8_WAIT_V(6); PG8_BAR;
    }
    for (;;) {
        const bool has_next = S.next(ui + 1, nxt);
        if constexpr (GATHER) { if (has_next) PG8_SETOFF(nv0, nv1, nxt); else { _Pragma("unroll") for (int i = 0; i < 2; ++i) { nv0[i] = cv0[i]; nv1[i] = cv1[i]; } } }
        const char* nA = has_next ? (const char*)g.A + (size_t)nxt.pm * tstepA + nxt.aoff : cA; const char* nB = has_next ? (const char*)g.Bt + (size_t)nxt.pn * tstepB + nxt.boff : cB;
        for (int t = 0; t < nt; t += 2) {
            const bool last = (t == nt - 2);
            unsigned s0[2], s1[2];
#pragma unroll
            for (int i = 0; i < 2; ++i) { s0[i] = last ? nv0[i] : cv0[i]; s1[i] = last ? nv1[i] : cv1[i]; }
            const char* a1 = cA + (size_t)(t + 1) * kstep;
            const char* a2 = last ? nA : cA + (size_t)(t + 2) * kstep; const char* b2 = last ? nB : cB + (size_t)(t + 2) * kstep;
            const char* a3 = a2 + kstep; const char* b3 = b2 + kstep;
            if (last && has_next) S.a_ready(nxt);
            if constexpr (SP2) {
            PG8_LDB(B0, 0, 0); PG8_LDB(B1, 0, 1); PG8_SCHED; PG8_LDA(At, 0, 0); PG8_STAGE(PG8_SA(1, 1), a1 + hstepA, cv1);
            PG8_WAIT_V(8); PG8_WAIT_L(0); PG8_BAR; PG8_MMA(0, 0, At, B0); PG8_MMA(0, 1, At, B1); PG8_BAR; PG8_SCHED;
            PG8_LDA(At, 0, 1); PG8_STAGE(PG8_SB(0, 0), b2, voffB); PG8_STAGE(PG8_SB(0, 1), b2 + hstepB, voffB); PG8_STAGE(PG8_SA(0, 0), a2, s0);
            PG8_WAIT_V(8); PG8_WAIT_L(0); PG8_BAR; PG8_MMA(1, 0, At, B0); PG8_MMA(1, 1, At, B1); PG8_BAR; PG8_SCHED;
            PG8_LDB(B0, 1, 0); PG8_LDB(B1, 1, 1); PG8_SCHED; PG8_LDA(At, 1, 0); PG8_STAGE(PG8_SA(0, 1), a2 + hstepA, s1);
            PG8_WAIT_V(8); PG8_WAIT_L(0); PG8_BAR; PG8_MMA(0, 0, At, B0); PG8_MMA(0, 1, At, B1); PG8_BAR; PG8_SCHED;
            PG8_LDA(At, 1, 1); PG8_STAGE(PG8_SB(1, 0), b3, voffB); PG8_STAGE(PG8_SB(1, 1), b3 + hstepB, voffB); PG8_STAGE(PG8_SA(1, 0), a3, s0);
            PG8_WAIT_V(8); PG8_WAIT_L(0); PG8_BAR; PG8_MMA(1, 0, At, B0); PG8_MMA(1, 1, At, B1); PG8_BAR; PG8_SCHED;
            } else {
            PG8_LDB(B0, 0, 0); PG8_SCHED; PG8_LDA(At, 0, 0); PG8_STAGE(PG8_SA(1, 1), a1 + hstepA, voffA);
            PG8_WAIT_L(8); PG8_BAR; PG8_WAIT_L(0); PG8_MMA(0, 0, At, B0); PG8_BAR; PG8_SCHED;
            PG8_LDB(B1, 0, 1); PG8_STAGE(PG8_SB(0, 0), b2, voffB);
            PG8_BAR; PG8_WAIT_L(0); PG8_MMA(0, 1, At, B1); PG8_BAR;
            PG8_LDA(At, 0, 1); PG8_STAGE(PG8_SA(0, 0), a2, voffA);
            PG8_BAR; PG8_WAIT_L(0); PG8_MMA(1, 0, At, B0); PG8_BAR; PG8_SCHED;
            PG8_STAGE(PG8_SB(0, 1), b2 + hstepB, voffB);
            PG8_WAIT_V(6); PG8_BAR; PG8_MMA(1, 1, At, B1); PG8_BAR;
            PG8_LDB(B0, 1, 0); PG8_SCHED; PG8_LDA(At, 1, 0); PG8_STAGE(PG8_SA(0, 1), a2 + hstepA, voffA);
            PG8_WAIT_L(8); PG8_BAR; PG8_WAIT_L(0); PG8_MMA(0, 0, At, B0); PG8_BAR; PG8_SCHED;
            PG8_LDB(B1, 1, 1); PG8_STAGE(PG8_SB(1, 0), b3, voffB);
            PG8_BAR; PG8_WAIT_L(0); PG8_MMA(0, 1, At, B1); PG8_BAR;
            PG8_LDA(At, 1, 1); PG8_STAGE(PG8_SA(1, 0), a3, voffA);
            PG8_BAR; PG8_WAIT_L(0); PG8_MMA(1, 0, At, B0); PG8_BAR; PG8_SCHED;
            PG8_STAGE(PG8_SB(1, 1), b3 + hstepB, voffB);
            PG8_WAIT_V(6); PG8_BAR; PG8_MMA(1, 1, At, B1); PG8_BAR;
            }
        }
        if constexpr (ALIGN_EPI) { if (wr == 0) PG8_BAR; }
        if constexpr (!Epi::AFTER_DRAIN) { E(acc, cur, wr, wc, fr, fq); S.done(cur); }
        if (!has_next) break;
#pragma unroll
        for (int a = 0; a < 2; ++a)
#pragma unroll
            for (int b = 0; b < 2; ++b)
#pragma unroll
                for (int m = 0; m < 4; ++m)
#pragma unroll
                    for (int n = 0; n < 2; ++n) acc[a][b][m][n] = (f32x4){0.f, 0.f, 0.f, 0.f};
        cur = nxt; cA = nA; cB = nB; ++ui;
#pragma unroll
        for (int i = 0; i < 2; ++i) { cv0[i] = nv0[i]; cv1[i] = nv1[i]; }
        if constexpr (ALIGN_EPI) { if (wr == 1) PG8_BAR; }
    }
    PG8_WAIT_V(0);
    if constexpr (!ALIGN_EPI) { if (wr == 0) PG8_BAR; }
    PG8_BAR;
    if constexpr (Epi::AFTER_DRAIN) { E.fused(acc, cur, wr, wc, fr, fq, lds, wid, lane); S.done(cur); }
#undef PG8_SA
#undef PG8_SB
#undef PG8_STAGE
#undef PG8_SETOFF
#undef PG8_LDA
#undef PG8_LDB
#undef PG8_MMA
#undef PG8_WAIT_V
#undef PG8_WAIT_L
#undef PG8_BAR
#undef PG8_SCHED
}
}
#include <hip/hip_bf16.h>
#include <cmath>
namespace attn_body {
using bf16=__hip_bfloat16;
using bf16x8=__attribute__((ext_vector_type(8)))short;
using s16x4=__attribute__((ext_vector_type(4)))short;
using f32x16=__attribute__((ext_vector_type(16)))float;
using u32x4=__attribute__((ext_vector_type(4)))unsigned;
constexpr int SEQ=8192,D=64,DM=2816;
constexpr int NW=8,QBLK=32,QB=QBLK*NW,KVBLK=64,NQB=SEQ/QB;
constexpr int ATTN_PITCH=DM, ATTN_UNIT_ROWS=QB;
__device__ __forceinline__ int crow(int r,int hi){return (r&3)+8*(r>>2)+4*hi;}
#define SBAR() __builtin_amdgcn_sched_barrier(0)
__device__ __forceinline__ void cmask(f32x16&p0,f32x16&p1,int jb,int qrel,int hi){
  const float NEG=-INFINITY; int kb=64*jb+4*hi;
  #pragma unroll
  for(int r=0;r<16;++r){int kv=kb+(r&3)+8*(r>>2); if(kv>qrel)p0[r]=NEG; if(kv+32>qrel)p1[r]=NEG;}
}

constexpr int NSLOT=3, SLOTB=8192;
constexpr int LDS_K=0, LDS_V=NSLOT*SLOTB;
constexpr int LDS_BYTES=LDS_V+NSLOT*16384+NW*64*4+NW*4096;
constexpr float C2=0.125f*1.4426950408889634f;
__device__ __forceinline__ void glds16(const void*gsrc,unsigned lds_dst){unsigned keep;
  asm volatile("s_mov_b32 %0, m0\n\ts_mov_b32 m0, %2\n\ts_nop 0\n\tglobal_load_lds_dwordx4 %1, off\n\ts_mov_b32 m0, %0":"=&s"(keep):"v"(gsrc),"s"(lds_dst):"memory");}
__device__ __forceinline__ void glds16s(unsigned voff,const void*sbase,unsigned lds_dst){unsigned keep;
  asm volatile("s_mov_b32 %0, m0\n\ts_mov_b32 m0, %3\n\ts_nop 0\n\tglobal_load_lds_dwordx4 %1, %2\n\ts_mov_b32 m0, %0":"=&s"(keep):"v"(voff),"s"(sbase),"s"(lds_dst):"memory");}
__device__ __forceinline__ float max3f(float a,float b,float c){float r;asm("v_max3_f32 %0, %1, %2, %3":"=v"(r):"v"(a),"v"(b),"v"(c));return r;}
__device__ __forceinline__ float max2f(float a,float b){float r;asm("v_max_f32_e32 %0, %1, %2":"=v"(r):"v"(a),"v"(b));return r;}
__device__ __forceinline__ float fadd_s(float a,float b){float r;asm("v_add_f32_e32 %0, %1, %2":"=v"(r):"v"(a),"v"(b));return r;}
__device__ __forceinline__ float fsub_s(float a,float b){float r;asm("v_sub_f32_e32 %0, %1, %2":"=v"(r):"v"(a),"v"(b));return r;}
typedef float f32x2_t __attribute__((ext_vector_type(2))); typedef __bf16 bf16x2_t __attribute__((ext_vector_type(2)));
__device__ __forceinline__ unsigned cvtpk_s(float lo,float hi){f32x2_t v={lo,hi};bf16x2_t b=__builtin_convertvector(v,bf16x2_t);return __builtin_bit_cast(unsigned,b);}
#define WAIT_BAR(N) asm volatile("s_waitcnt vmcnt(" #N ") lgkmcnt(0)\n\ts_barrier":::"memory")

typedef __attribute__((address_space(3))) const char* lds_cptr;
__device__ __forceinline__ void qkt(f32x16&p0,f32x16&p1,lds_cptr Kslot,const bf16x8*qr,const f32x16&negm,int r32,int hi){
  const lds_cptr kb=Kslot+hi*1024+r32*16;
  #pragma unroll
  for(int d0=0;d0<4;++d0){
    const bf16x8 b0=*(const __attribute__((address_space(3))) bf16x8*)(kb+d0*2048);
    const bf16x8 b1=*(const __attribute__((address_space(3))) bf16x8*)(kb+d0*2048+512);
    if(d0==0){p0=__builtin_amdgcn_mfma_f32_32x32x16_bf16(b0,qr[0],negm,0,0,0);p1=__builtin_amdgcn_mfma_f32_32x32x16_bf16(b1,qr[0],negm,0,0,0);}
    else{p0=__builtin_amdgcn_mfma_f32_32x32x16_bf16(b0,qr[d0],p0,0,0,0);p1=__builtin_amdgcn_mfma_f32_32x32x16_bf16(b1,qr[d0],p1,0,0,0);}}
}
typedef short v4i16_t __attribute__((ext_vector_type(4)));
__device__ __forceinline__ void kload8(bf16x8*kf,lds_cptr kp){
  kf[0]=*(const __attribute__((address_space(3))) bf16x8*)(kp);      kf[1]=*(const __attribute__((address_space(3))) bf16x8*)(kp+512);
  kf[2]=*(const __attribute__((address_space(3))) bf16x8*)(kp+2048); kf[3]=*(const __attribute__((address_space(3))) bf16x8*)(kp+2560);
  kf[4]=*(const __attribute__((address_space(3))) bf16x8*)(kp+4096); kf[5]=*(const __attribute__((address_space(3))) bf16x8*)(kp+4608);
  kf[6]=*(const __attribute__((address_space(3))) bf16x8*)(kp+6144); kf[7]=*(const __attribute__((address_space(3))) bf16x8*)(kp+6656);
}
__device__ __forceinline__ void kload2(bf16x8*kf,lds_cptr kp,int j){ kf[2*j]=*(const __attribute__((address_space(3))) bf16x8*)(kp+j*2048); kf[2*j+1]=*(const __attribute__((address_space(3))) bf16x8*)(kp+j*2048+512); }
__device__ __forceinline__ s16x4 vtr(lds_cptr p){ return __builtin_bit_cast(s16x4,__builtin_amdgcn_ds_read_tr16_b64_v4i16((__attribute__((address_space(3))) v4i16_t*)p)); }
__device__ __forceinline__ float rowmax(const f32x16&p0,const f32x16&p1){
  float a=max3f(p0[0],p0[1],p1[0]),b=max3f(p0[2],p0[3],p1[1]);a=max3f(a,p1[2],p1[3]);
  #pragma unroll
  for(int r=4;r<16;r+=4){a=max3f(a,p0[r],p0[r+1]);b=max3f(b,p0[r+2],p0[r+3]);a=max3f(a,p1[r],p1[r+1]);b=max3f(b,p1[r+2],p1[r+3]);}
  const float m=max2f(a,b);
  auto rr=__builtin_amdgcn_permlane32_swap(__float_as_uint(m),__float_as_uint(m),false,false);
  return max2f(__uint_as_float(rr[0]),__uint_as_float(rr[1]));
}
template<int NDB> __device__ __forceinline__ void pv(f32x16*o,int vb,bf16x8 pa0,bf16x8 pa1,bf16x8 pa2,bf16x8 pa3){
  #pragma unroll
  for(int d0=0;d0<NDB;++d0){s16x4 lo[4],hi[4];
    #pragma unroll
    for(int ks=0;ks<4;++ks){
      asm volatile("ds_read_b64_tr_b16 %0,%1 offset:%c2":"=&v"(lo[ks]):"v"(vb),"i"(d0*4096+ks*1024):"memory");
      asm volatile("ds_read_b64_tr_b16 %0,%1 offset:%c2":"=&v"(hi[ks]):"v"(vb),"i"(d0*4096+ks*1024+512):"memory");}
    asm volatile("s_waitcnt lgkmcnt(0)":::"memory");SBAR();
    #define PK(k) (bf16x8){lo[k][0],lo[k][1],lo[k][2],lo[k][3],hi[k][0],hi[k][1],hi[k][2],hi[k][3]}
    o[d0]=__builtin_amdgcn_mfma_f32_32x32x16_bf16(pa0,PK(0),o[d0],0,0,0);
    o[d0]=__builtin_amdgcn_mfma_f32_32x32x16_bf16(pa1,PK(1),o[d0],0,0,0);
    o[d0]=__builtin_amdgcn_mfma_f32_32x32x16_bf16(pa2,PK(2),o[d0],0,0,0);
    o[d0]=__builtin_amdgcn_mfma_f32_32x32x16_bf16(pa3,PK(3),o[d0],0,0,0);
    #undef PK
  }
}

#ifndef ATTN_STORE16
#define ATTN_STORE16(p,v) (*(__attribute__((address_space(1))) u32x4*)(p)=(v))
#endif
template<int THRL,int NDB,bool FIXREF=false> __device__ __forceinline__ void attn_unit(int qb,const bf16*Qb,const bf16*__restrict__ Kb,const bf16*__restrict__ Vb,bf16*Ob,int opitch,char*shm,const int tid_in,const float negref=0.f){
  int tid_o=tid_in; asm volatile("":"+v"(tid_o));
  const int tid=tid_o,lane=tid&63,r32=lane&31,hi=lane>>5; const int wid=__builtin_amdgcn_readfirstlane(tid>>6);
  constexpr int VSLOTB=NDB*4096, LDS_WS=LDS_V+NSLOT*VSLOTB, LDS_OST=LDS_WS+NW*64*4;
  const int q0=qb*QB;
  const bf16*Qw=Qb+(long)(q0+wid*QBLK)*DM;
  const bf16*Kh=Kb,*Vh=Vb;
  const unsigned lds0=(unsigned)(uintptr_t)shm;
  __attribute__((address_space(3))) float*wsf=(__attribute__((address_space(3))) float*)((lds_cptr)shm+LDS_WS)+wid*64;
  const unsigned ksrc=(unsigned)((lane*DM+wid*8)*2);
  const unsigned vsrc=(unsigned)(((16*(wid&3)+(lane>>2))*DM+(wid>>2)*32+(lane&3)*8)*2);
  const unsigned kdst=lds0+LDS_K+wid*1024, vdst=lds0+LDS_V+wid*1024;
  #define DMA_K(t,slot) glds16s(ksrc,(const char*)Kh+(long)(t)*(KVBLK*DM*2),(unsigned)__builtin_amdgcn_readfirstlane(kdst+(slot)))
  #define DMA_V(t,slot) do{ glds16s(vsrc,(const char*)Vh+(long)(t)*(KVBLK*DM*2),(unsigned)__builtin_amdgcn_readfirstlane(vdst+(slot)*(VSLOTB/SLOTB))); if(NDB==4) glds16s(vsrc,(const char*)Vh+(long)(t)*(KVBLK*DM*2)+128,(unsigned)__builtin_amdgcn_readfirstlane(vdst+(slot)*(VSLOTB/SLOTB)+8192)); }while(0)
  const int vb0=(int)(lds0+LDS_V)+((lane>>4)&1)*32+(lane&3)*8+(4*hi+((lane&15)>>2))*64;
  const lds_cptr Kbase=(lds_cptr)shm+LDS_K; bf16x8 kf[8];
  const lds_cptr shm3=(lds_cptr)shm; const lds_cptr kp0=shm3+LDS_K+hi*1024+r32*16; const lds_cptr vp0=shm3+LDS_V+((lane>>4)&1)*32+(lane&3)*8+(4*hi+((lane&15)>>2))*64;
  constexpr int NT=SEQ/KVBLK;
  DMA_K(0,0);DMA_V(0,0);DMA_K(1,SLOTB);
  bf16x8 qr[4];
  #pragma unroll
  for(int d0=0;d0<4;++d0)qr[d0]=*(const __attribute__((address_space(1))) bf16x8*)(&Qw[(long)r32*DM+d0*16+hi*8]);
  float mhat=0.f,l_reg=0.f;f32x16 o[NDB];_Pragma("unroll") for(int d_=0;d_<NDB;++d_)o[d_]=f32x16{};f32x16 negm=f32x16{}; if(FIXREF){_Pragma("unroll") for(int r=0;r<16;++r)negm[r]=negref;} asm volatile("":"+v"(negm));
  #define CMASK(P0,P1,t) do{}while(0)
  bool resc=false;
  #define START(P0,P1) do{ resc=false; if(!FIXREF){ const float rm=rowmax(P0,P1); \
    { const float dl=rm; mhat=fadd_s(mhat,dl); \
      _Pragma("unroll") for(int r=0;r<16;++r){P0[r]=fsub_s(P0[r],dl);P1[r]=fsub_s(P1[r],dl);} \
      _Pragma("unroll") for(int r=0;r<16;++r)negm[r]=-mhat; asm volatile("":"+v"(negm)); } } \
    _Pragma("unroll") for(int r=0;r<16;++r)P0[r]=__builtin_amdgcn_exp2f(P0[r]); }while(0)
  #define RESC() do{ if(!FIXREF&&resc){ asm volatile("s_waitcnt lgkmcnt(0)":::"memory"); \
      _Pragma("unroll") for(int d_=0;d_<NDB;++d_) _Pragma("unroll") for(int r=0;r<16;++r)o[d_][r]*=wsf[crow(r,hi)]; } }while(0)
  f32x16 pA0,pA1,pB0,pB1;
  #define WAIT_KV() do{ if(NDB==4){WAIT_BAR(3);}else{WAIT_BAR(2);} }while(0)
  #define WAIT_V() do{ if(NDB==4){WAIT_BAR(2);}else{WAIT_BAR(1);} }while(0)
  int sl_prev=0,sl_cur=0,sl_next=SLOTB;
  #define ROT() do{sl_prev=sl_cur;sl_cur=sl_next;sl_next=(sl_next==(NSLOT-1)*SLOTB)?0:sl_next+SLOTB;}while(0)
  DMA_K(2,2*SLOTB);
  WAIT_BAR(3);
  qkt(pA0,pA1,Kbase,qr,negm,r32,hi);asm volatile("s_nop 15\n\ts_nop 7":"+v"(pA0),"+v"(pA1));CMASK(pA0,pA1,0);
  START(pA0,pA1);
  _Pragma("unroll") for(int r=0;r<16;++r)pA1[r]=__builtin_amdgcn_exp2f(pA1[r]);
  WAIT_BAR(0);
  DMA_K(3,0);DMA_V(1,SLOTB);
  ROT();
  kload8(kf,kp0+sl_cur);
  WAIT_KV();
  s16x4 vlo[8],vhi[8]; u32x4 pw0,pw1,pw2,pw3;
  #define PKW(P,B) cvtpk_s(P[B],P[B+1])
  #define PAF(k) __builtin_bit_cast(bf16x8,pw##k)
  #define VFR(i) (bf16x8){vlo[i][0],vlo[i][1],vlo[i][2],vlo[i][3],vhi[i][0],vhi[i][1],vhi[i][2],vhi[i][3]}
  #define PIN(x) asm volatile("":"+v"(x))
  #define MX3(a,b,c) __builtin_fmaxf(__builtin_fmaxf((a),(b)),(c))
  #define GAPA(MF,A0,A1,A2,A3,W0,W1,PW) do{ MF; sacc+=A0; sacc+=A1; sacc+=A2; sacc+=A3; PIN(sacc); W0; W1; PIN(PW); SBAR(); }while(0)
  #define EX(v) __builtin_amdgcn_exp2f(v)
  #define GAPB(MF,X,B) do{ MF; X[B]=EX(X[B]); X[B+1]=EX(X[B+1]); X[B+2]=EX(X[B+2]); X[B+3]=EX(X[B+3]); PIN(X); SBAR(); }while(0)
  #define GAPB2(MF,X,B) do{ MF; X[B]=EX(X[B]); X[B+1]=EX(X[B+1]); PIN(X); SBAR(); }while(0)
  #define VRDX(s,ks,db) do{ vlo[s]=vtr(vp_+((db)*4096+(ks)*1024)); vhi[s]=vtr(vp_+((db)*4096+(ks)*1024+512)); }while(0)
  #define VRDA(i) do{ if(NDB==2){VRD(i);} else if(((i)&3)<2){ VRDX(2*((i)&3)+((i)>>2),(i)&3,(i)>>2); } }while(0)
  #define VRD(i) do{ vlo[i]=vtr(vp_+(((i)>>2)*4096+((i)&3)*1024)); vhi[i]=vtr(vp_+(((i)>>2)*4096+((i)&3)*1024+512)); }while(0)
  #define KRD(G,j) do{ if(G){ kload2(kf,kp0+sl_next,j); SBAR(); } }while(0)
  #define STEP(C0,C1,P0,P1,t,GK,GV,GL) do{ SBAR(); \
    const lds_cptr vp_=vp0+sl_prev*(VSLOTB/SLOTB); \
    VRDA(0); SBAR(); float sacc=(P0[0]+P0[1]); \
    GAPA(C0=__builtin_amdgcn_mfma_f32_32x32x16_bf16(kf[0],qr[0],negm,0,0,0), P0[2],P0[3],P0[4],P0[5],     pw0[0]=PKW(P0,0), pw0[1]=PKW(P0,2), pw0); \
    VRDA(4); SBAR(); GAPA(C1=__builtin_amdgcn_mfma_f32_32x32x16_bf16(kf[1],qr[0],negm,0,0,0), P0[6],P0[7],P0[8],P0[9],     pw0[2]=PKW(P0,4), pw0[3]=PKW(P0,6), pw0); \
    VRDA(1); SBAR(); GAPA(C0=__builtin_amdgcn_mfma_f32_32x32x16_bf16(kf[2],qr[1],C0,0,0,0),   P0[10],P0[11],P0[12],P0[13], pw1[0]=PKW(P0,8), pw1[1]=PKW(P0,10), pw1); \
    VRDA(5); SBAR(); GAPA(C1=__builtin_amdgcn_mfma_f32_32x32x16_bf16(kf[3],qr[1],C1,0,0,0),   P0[14],P0[15],P1[0],P1[1],   pw1[2]=PKW(P0,12),pw1[3]=PKW(P0,14), pw1); \
    VRDA(2); SBAR(); GAPA(C0=__builtin_amdgcn_mfma_f32_32x32x16_bf16(kf[4],qr[2],C0,0,0,0),   P1[2],P1[3],P1[4],P1[5],     pw2[0]=PKW(P1,0), pw2[1]=PKW(P1,2), pw2); \
    VRDA(6); SBAR(); GAPA(C1=__builtin_amdgcn_mfma_f32_32x32x16_bf16(kf[5],qr[2],C1,0,0,0),   P1[6],P1[7],P1[8],P1[9],     pw2[2]=PKW(P1,4), pw2[3]=PKW(P1,6), pw2); \
    VRDA(3); SBAR(); GAPA(C0=__builtin_amdgcn_mfma_f32_32x32x16_bf16(kf[6],qr[3],C0,0,0,0),   P1[10],P1[11],P1[12],P1[13], pw3[0]=PKW(P1,8), pw3[1]=PKW(P1,10), pw3); \
    VRDA(7); SBAR(); GAPA(C1=__builtin_amdgcn_mfma_f32_32x32x16_bf16(kf[7],qr[3],C1,0,0,0),   P1[14],P1[15],0.f,0.f,       pw3[2]=PKW(P1,12),pw3[3]=PKW(P1,14), pw3); \
    l_reg+=sacc; \
    if(GK){DMA_K((t)+3,sl_cur);} if(GV){DMA_V((t)+1,sl_next);} \
    CMASK(C0,C1,t); \
    if(!FIXREF){ float a=MX3(C0[0],C0[1],C1[0]),b=MX3(C0[2],C0[3],C1[1]); a=MX3(a,C1[2],C1[3]); \
      _Pragma("unroll") for(int r=4;r<16;r+=4){a=MX3(a,C0[r],C0[r+1]);b=MX3(b,C0[r+2],C0[r+3]);a=MX3(a,C1[r],C1[r+1]);b=MX3(b,C1[r+2],C1[r+3]);} \
      float rm=__builtin_fmaxf(a,b); { auto rr=__builtin_amdgcn_permlane32_swap(__float_as_uint(rm),__float_as_uint(rm),false,false); rm=__builtin_fmaxf(__uint_as_float(rr[0]),__uint_as_float(rr[1])); } \
      resc=false; \
      if(__builtin_expect(__any(rm>(float)THRL),0)){ const float dl=__builtin_fmaxf(rm,0.f); mhat+=dl; \
        _Pragma("unroll") for(int r=0;r<16;++r){C0[r]-=dl;C1[r]-=dl;} \
        _Pragma("unroll") for(int r=0;r<16;++r)negm[r]=-mhat; asm volatile("":"+v"(negm)); \
        const float f=__builtin_amdgcn_exp2f(-dl); l_reg*=f; if(hi==0)wsf[r32]=f; resc=true; } } \
    SBAR(); \
    if(NDB==2){ \
    GAPB(o[0]=__builtin_amdgcn_mfma_f32_32x32x16_bf16(PAF(0),VFR(0),o[0],0,0,0), C0,0); \
    GAPB(o[1]=__builtin_amdgcn_mfma_f32_32x32x16_bf16(PAF(0),VFR(4),o[1],0,0,0), C0,4); \
    KRD(GL,0); GAPB(o[0]=__builtin_amdgcn_mfma_f32_32x32x16_bf16(PAF(1),VFR(1),o[0],0,0,0), C0,8); \
    KRD(GL,1); GAPB(o[1]=__builtin_amdgcn_mfma_f32_32x32x16_bf16(PAF(1),VFR(5),o[1],0,0,0), C0,12); \
    KRD(GL,2); GAPB(o[0]=__builtin_amdgcn_mfma_f32_32x32x16_bf16(PAF(2),VFR(2),o[0],0,0,0), C1,0); \
    KRD(GL,3); GAPB(o[1]=__builtin_amdgcn_mfma_f32_32x32x16_bf16(PAF(2),VFR(6),o[1],0,0,0), C1,4); \
    GAPB(o[0]=__builtin_amdgcn_mfma_f32_32x32x16_bf16(PAF(3),VFR(3),o[0],0,0,0), C1,8); \
    GAPB(o[1]=__builtin_amdgcn_mfma_f32_32x32x16_bf16(PAF(3),VFR(7),o[1],0,0,0), C1,12); \
    } else { \
    GAPB2(o[0]=__builtin_amdgcn_mfma_f32_32x32x16_bf16(PAF(0),VFR(0),o[0],0,0,0), C0,0); VRDX(0,2,0); SBAR(); \
    GAPB2(o[1]=__builtin_amdgcn_mfma_f32_32x32x16_bf16(PAF(0),VFR(1),o[1],0,0,0), C0,2); VRDX(1,2,1); SBAR(); \
    GAPB2(o[0]=__builtin_amdgcn_mfma_f32_32x32x16_bf16(PAF(1),VFR(2),o[0],0,0,0), C0,4); VRDX(2,3,0); SBAR(); \
    GAPB2(o[1]=__builtin_amdgcn_mfma_f32_32x32x16_bf16(PAF(1),VFR(3),o[1],0,0,0), C0,6); VRDX(3,3,1); SBAR(); \
    GAPB2(o[0]=__builtin_amdgcn_mfma_f32_32x32x16_bf16(PAF(2),VFR(0),o[0],0,0,0), C0,8); VRDX(0,0,2); SBAR(); \
    GAPB2(o[1]=__builtin_amdgcn_mfma_f32_32x32x16_bf16(PAF(2),VFR(1),o[1],0,0,0), C0,10); VRDX(1,0,3); SBAR(); \
    GAPB2(o[0]=__builtin_amdgcn_mfma_f32_32x32x16_bf16(PAF(3),VFR(2),o[0],0,0,0), C0,12); VRDX(2,1,2); SBAR(); \
    GAPB2(o[1]=__builtin_amdgcn_mfma_f32_32x32x16_bf16(PAF(3),VFR(3),o[1],0,0,0), C0,14); VRDX(3,1,3); SBAR(); \
    GAPB2(o[2]=__builtin_amdgcn_mfma_f32_32x32x16_bf16(PAF(0),VFR(0),o[2],0,0,0), C1,0); VRDX(0,2,2); SBAR(); \
    GAPB2(o[3]=__builtin_amdgcn_mfma_f32_32x32x16_bf16(PAF(0),VFR(1),o[3],0,0,0), C1,2); VRDX(1,2,3); SBAR(); \
    GAPB2(o[2]=__builtin_amdgcn_mfma_f32_32x32x16_bf16(PAF(1),VFR(2),o[2],0,0,0), C1,4); VRDX(2,3,2); SBAR(); \
    GAPB2(o[3]=__builtin_amdgcn_mfma_f32_32x32x16_bf16(PAF(1),VFR(3),o[3],0,0,0), C1,6); VRDX(3,3,3); SBAR(); \
    KRD(GL,0); GAPB2(o[2]=__builtin_amdgcn_mfma_f32_32x32x16_bf16(PAF(2),VFR(0),o[2],0,0,0), C1,8); \
    KRD(GL,1); GAPB2(o[3]=__builtin_amdgcn_mfma_f32_32x32x16_bf16(PAF(2),VFR(1),o[3],0,0,0), C1,10); \
    KRD(GL,2); GAPB2(o[2]=__builtin_amdgcn_mfma_f32_32x32x16_bf16(PAF(3),VFR(2),o[2],0,0,0), C1,12); \
    KRD(GL,3); GAPB2(o[3]=__builtin_amdgcn_mfma_f32_32x32x16_bf16(PAF(3),VFR(3),o[3],0,0,0), C1,14); \
    } \
    }while(0)
  int t=1;
  #undef CMASK
  #define CMASK(P0,P1,t) do{}while(0)
  for(;t+5<NT;t+=2){
    STEP(pB0,pB1,pA0,pA1,t,true,true,true);     WAIT_KV(); RESC(); ROT();
    STEP(pA0,pA1,pB0,pB1,t+1,true,true,true);   WAIT_KV(); RESC(); ROT();
  }
  #undef CMASK
  #define CMASK(P0,P1,t) do{}while(0)
  #define ENDW(tt) do{ if((tt)+3<NT){WAIT_KV();} else if((tt)+2<NT){WAIT_V();} else {WAIT_BAR(0);} }while(0)
  for(;t+1<NT;t+=2){
    STEP(pB0,pB1,pA0,pA1,t,(t+3<NT),(t+1<NT),(t+1<NT));       ENDW(t);   RESC(); ROT();
    STEP(pA0,pA1,pB0,pB1,t+1,(t+4<NT),(t+2<NT),(t+2<NT));     ENDW(t+1); RESC(); ROT();
  }
  STEP(pB0,pB1,pA0,pA1,NT-1,false,false,false); RESC();
  { float sacc=pB0[0]+pB0[1]; _Pragma("unroll") for(int r=2;r<16;++r)sacc+=pB0[r]; _Pragma("unroll") for(int r=0;r<16;++r)sacc+=pB1[r]; l_reg+=sacc;
    pw0=(u32x4){PKW(pB0,0),PKW(pB0,2),PKW(pB0,4),PKW(pB0,6)};pw1=(u32x4){PKW(pB0,8),PKW(pB0,10),PKW(pB0,12),PKW(pB0,14)};pw2=(u32x4){PKW(pB1,0),PKW(pB1,2),PKW(pB1,4),PKW(pB1,6)};pw3=(u32x4){PKW(pB1,8),PKW(pB1,10),PKW(pB1,12),PKW(pB1,14)};
    SBAR(); pv<NDB>(o,vb0+sl_cur*(VSLOTB/SLOTB),PAF(0),PAF(1),PAF(2),PAF(3)); }
  #undef PKW
  #undef PAF
  #undef VFR
  #undef PIN
  #undef MX3
  #undef GAPA
  #undef GAPB
  #undef EX
  #undef VRD
  #undef VRDX
  #undef VRDA
  #undef GAPB2
  #undef KRD
  #undef STEP
  #undef ENDW
  {auto rr=__builtin_amdgcn_permlane32_swap(__float_as_uint(l_reg),__float_as_uint(l_reg),false,false);l_reg=__uint_as_float(rr[0])+__uint_as_float(rr[1]);}
  if(hi==0)wsf[32+r32]=l_reg;asm volatile("s_waitcnt lgkmcnt(0)":::"memory");
  float rli[16];
  #pragma unroll
  for(int r=0;r<16;++r)rli[r]=__builtin_amdgcn_rcpf(wsf[32+crow(r,hi)]);
  bf16*Ow=Ob+(long)(q0+wid*QBLK)*opitch;
  _Pragma("unroll") for(int hf=0;hf<NDB/2;++hf){ __attribute__((address_space(3))) unsigned short*stg=(__attribute__((address_space(3))) unsigned short*)((lds_cptr)shm+LDS_OST)+wid*2048;
    #pragma unroll
    for(int r=0;r<16;++r){const int orow=crow(r,hi);
      #pragma unroll
      for(int d0=0;d0<2;++d0)stg[orow*64+d0*32+r32]=(unsigned short)(cvtpk_s(o[2*hf+d0][r]*rli[r],0.f)&0xffffu);}
    asm volatile("s_waitcnt lgkmcnt(0)":::"memory");
    #pragma unroll
    for(int i=0;i<4;++i){const int row=i*8+(lane>>3),ch=lane&7; const u32x4 v=*(const __attribute__((address_space(3))) u32x4*)(stg+row*64+ch*8); ATTN_STORE16(Ow+(long)row*opitch+hf*64+ch*8,v);}
    asm volatile("s_waitcnt lgkmcnt(0)":::"memory"); }
  asm volatile("s_waitcnt lgkmcnt(0)\n\ts_barrier":::"memory");
  #undef DMA_K
  #undef DMA_V
  #undef CMASK
  #undef START
  #undef RESC
  #undef ROT
  #undef WAIT_KV
  #undef WAIT_V
}
constexpr int ATTN_LDS_BYTES=LDS_BYTES;
#undef SBAR
#undef WAIT_BAR
}

#ifndef MK_SPLIT
#define MK_SPLIT 0
#endif
constexpr int NWAVES = 8;
constexpr int DM = 1024, NBATCH = 4, SEQ = 8192, TOK = NBATCH * SEQ, NLAYER = 2, INC = 7440;
constexpr float EPS = 1e-6f;
constexpr float QSCALE = 0.125f * 1.4426950408889634f;
constexpr int NPH = 26;
constexpr size_t MiB = 1u << 20;
constexpr size_t WS_CTL = 0, CTL_ZERO_BYTES = 1 * MiB;
constexpr size_t WS_COS1 = 1 * MiB, WS_SIN1 = 2 * MiB;
constexpr size_t WS_AX = 3 * MiB;
constexpr size_t WS_WBA = 3 * MiB + 64 * 1024;
constexpr size_t WS_WRT = 3 * MiB + 256 * 1024;
constexpr size_t WS_RSTD1 = 4 * MiB, WS_RSTD2 = 4 * MiB + 128 * 1024, WS_RSTDF = 4 * MiB + 256 * 1024;
constexpr size_t WS_BA = 4 * MiB + 512 * 1024;
constexpr size_t WS_TOKL = 7 * MiB;
constexpr size_t WS_WL = 11 * MiB;
constexpr size_t WS_TSLOT = 15 * MiB;
constexpr size_t WS_WROW = 15 * MiB + 256 * 1024;
constexpr size_t WS_RROW = 15 * MiB + 576 * 1024;
constexpr size_t WS_WIN = 16 * MiB;
constexpr size_t WS_WG = 33 * MiB;
constexpr size_t WS_WBR = 45 * MiB;
constexpr size_t WS_WO3 = 51 * MiB;
constexpr size_t WS_XB = 55 * MiB;
constexpr size_t WS_MM = 520 * MiB, WS_INTRA = 552 * MiB;
constexpr size_t WS_PP = 119 * MiB;
constexpr size_t WS_RAW = 295 * MiB;
constexpr size_t WS_OF = 295 * MiB, WS_OB = 327 * MiB;
constexpr size_t WS_KN = 391 * MiB, WS_KT = 423 * MiB, WS_QN = 455 * MiB, WS_VC = 487 * MiB;
constexpr size_t WS_GC = 519 * MiB;
constexpr size_t WS_OD = 391 * MiB;
constexpr size_t WS_YBR = 295 * MiB;
constexpr size_t WS_MGT = 183 * MiB;
constexpr size_t WS_MG = 119 * MiB;
constexpr size_t WS_W13T = 487 * MiB, WS_W2T = 551 * MiB;
constexpr size_t WS_XG = 215 * MiB;
constexpr size_t WS_HH = 359 * MiB;
constexpr size_t WS_END = 584 * MiB;
constexpr int PPW = 2816, PC_Z = 0, PC_DQ = 512, PC_DK = 1024, PC_DV = 1536, PC_CQ = 2048, PC_CK = 2560, PC_CV = 2688;
constexpr int CW_BAR = 4096, CW_CNT = 8192, CW_NRM = 8448;
constexpr int RING_BYTES = 131072, LDSCTL_OFF = 145408, LDS_TBASE = LDSCTL_OFF + 256, LDS_TILEE = LDSCTL_OFF + 512;
constexpr int LDS_ROWTAB = LDSCTL_OFF + 2048, LDS_RSTAB = LDS_ROWTAB + 5120, LDS_WTAB = LDS_RSTAB + 5120, LDS_BYTES = LDS_WTAB + 5120;
static_assert(LDS_BYTES <= 163840, "LDS");

#define GAS __attribute__((address_space(1)))
#define LAS __attribute__((address_space(3)))
typedef unsigned short bf16;
typedef unsigned v4u __attribute__((ext_vector_type(4)));
typedef unsigned v2u __attribute__((ext_vector_type(2)));
typedef float f32x4 __attribute__((ext_vector_type(4)));
typedef short bf16x8 __attribute__((ext_vector_type(8)));
typedef GAS unsigned gu32;
#define RLX_AGENT __ATOMIC_RELAXED, __HIP_MEMORY_SCOPE_AGENT
#define LDS_WAIT() asm volatile("s_waitcnt lgkmcnt(0)" ::: "memory")
#define LBAR() do { asm volatile("s_waitcnt lgkmcnt(0)" ::: "memory"); __builtin_amdgcn_s_barrier(); asm volatile("" ::: "memory"); } while (0)
__device__ __forceinline__ unsigned pk2(float lo, float hi) { return pg8::cvt_pk_bf16(lo, hi); }
__device__ __forceinline__ float bflo(unsigned w) { return __uint_as_float(w << 16); }
__device__ __forceinline__ float bfhi(unsigned w) { return __uint_as_float(w & 0xffff0000u); }
__device__ __forceinline__ float bf2f(bf16 v) { return __uint_as_float((unsigned)v << 16); }
__device__ __forceinline__ float lshfl(float v, int src) { return __int_as_float(__builtin_amdgcn_ds_bpermute(src << 2, __float_as_int(v))); }
__device__ __forceinline__ int lshfl(int v, int src) { return __builtin_amdgcn_ds_bpermute(src << 2, v); }
#define SHFL_XOR(v, m) lshfl((v), lane ^ (m))
#define SHFL_UP(v, o) lshfl((v), (lane - (o)) & 63)
#define SHFL(v, s) lshfl((v), (s))
__device__ __forceinline__ float wave_sum(float v, int) {
    v += __int_as_float(__builtin_amdgcn_update_dpp(0, __float_as_int(v), 0xB1, 0xf, 0xf, false));
    v += __int_as_float(__builtin_amdgcn_update_dpp(0, __float_as_int(v), 0x4E, 0xf, 0xf, false));
    v += __int_as_float(__builtin_amdgcn_update_dpp(0, __float_as_int(v), 0x141, 0xf, 0xf, false));
    v += __int_as_float(__builtin_amdgcn_update_dpp(0, __float_as_int(v), 0x140, 0xf, 0xf, false));
    v += __int_as_float(__builtin_amdgcn_update_dpp(0, __float_as_int(v), 0x142, 0xa, 0xf, false));
    v += __int_as_float(__builtin_amdgcn_update_dpp(0, __float_as_int(v), 0x143, 0xc, 0xf, false));
    return __int_as_float(__builtin_amdgcn_readlane(__float_as_int(v), 63));
}
__device__ __forceinline__ float row16_sum(float v) {
    v += __int_as_float(__builtin_amdgcn_update_dpp(0, __float_as_int(v), 0xB1, 0xf, 0xf, false));
    v += __int_as_float(__builtin_amdgcn_update_dpp(0, __float_as_int(v), 0x4E, 0xf, 0xf, false));
    v += __int_as_float(__builtin_amdgcn_update_dpp(0, __float_as_int(v), 0x141, 0xf, 0xf, false));
    v += __int_as_float(__builtin_amdgcn_update_dpp(0, __float_as_int(v), 0x140, 0xf, 0xf, false));
    return v;
}
__device__ __forceinline__ float sigm(float x) { return __builtin_amdgcn_rcpf(1.0f + __expf(-x)); }
__device__ __forceinline__ f32x4 mfma16(bf16x8 a, bf16x8 b, f32x4 c) { return __builtin_amdgcn_mfma_f32_16x16x32_bf16(a, b, c, 0, 0, 0); }
#define XB_TMO      128
#define XB_XCNT(j)  (256  + 64 * (j))
#define XB_XSUB(j)  (1280 + 64 * (j))
#define XB_XGEN(j)  (2304 + 64 * (j))
#define XB_TOP      3328
#define XB_TOPGEN   3392
#define XCD_BAR_WORDS 3456
#define XB_SPIN_CAP (1u << 18)

__device__ __forceinline__ unsigned xb_ld(unsigned* p)              { return __hip_atomic_load(p, __ATOMIC_RELAXED, __HIP_MEMORY_SCOPE_AGENT); }
__device__ __forceinline__ unsigned xb_add(unsigned* p, unsigned v) { asm volatile("" : "+v"(v));
    return __hip_atomic_fetch_add(p, v, __ATOMIC_RELAXED, __HIP_MEMORY_SCOPE_AGENT); }
__device__ __forceinline__ unsigned xb_xcc_id() { return (unsigned)__builtin_amdgcn_s_getreg((3 << 11) | 20) & 0xFu; }
#define XB_SPIN(cond, bar) do { unsigned _sp = 0; while (cond) { __builtin_amdgcn_s_sleep(1); \
    if ((++_sp & 255u) == 0u) { if (xb_ld(&(bar)[XB_TMO])) break; if (_sp > XB_SPIN_CAP) { atomicAdd(&(bar)[XB_TMO], 1u); break; } } } } while (0)

struct XcdBarrier {
    unsigned* bar; unsigned x;
    volatile LAS unsigned* st;
};

__device__ __forceinline__ XcdBarrier xcd_barrier_post(unsigned* bar, volatile LAS unsigned* st) {
    XcdBarrier b; b.bar = bar; b.x = xb_xcc_id(); b.st = st;
    if (threadIdx.x == 0) (void)xb_add(&bar[XB_XCNT(b.x)], 1u);
    return b;
}
__device__ __forceinline__ void xcd_barrier_complete(unsigned* bar, unsigned x, unsigned& nloc, unsigned& nx) {
    const unsigned G = gridDim.x * gridDim.y * gridDim.z;
    unsigned sum, cnt, mine, sp = 0u;
    for (;;) {
        sum = 0u; cnt = 0u; mine = 0u;
#pragma unroll
        for (unsigned j = 0; j < 16; ++j) { const unsigned c = xb_ld(&bar[XB_XCNT(j)]); sum += c; cnt += (c > 0u) ? 1u : 0u; mine = (j == x) ? c : mine; }
        if (sum == G) break;
        __builtin_amdgcn_s_sleep(1);
        if ((++sp & 255u) == 0u) { if (xb_ld(&bar[XB_TMO])) break; if (sp > XB_SPIN_CAP) { atomicAdd(&bar[XB_TMO], 1u); break; } }
    }
    nloc = mine > 0u ? mine : 1u; nx = cnt > 0u ? cnt : 1u;
}

__device__ __forceinline__ void xcd_barrier(const XcdBarrier& b) {
    asm volatile("s_waitcnt vmcnt(0)" ::: "memory");
    __syncthreads();
    if (threadIdx.x == 0) {
        unsigned* bar = b.bar;
        __builtin_amdgcn_s_waitcnt(0);
        unsigned nloc = b.st[0], nx = b.st[1];
        if (nloc == 0u) { xcd_barrier_complete(bar, b.x, nloc, nx); b.st[0] = nloc; b.st[1] = nx; }
        const unsigned old = xb_add(&bar[XB_XSUB(b.x)], 1u);
        const unsigned gen = old / nloc;
        if (old + 1u == (gen + 1u) * nloc) {
            __builtin_amdgcn_fence(__ATOMIC_RELEASE, "agent");
            asm volatile("s_waitcnt vmcnt(0)" ::: "memory");
            const unsigned og = xb_add(&bar[XB_TOP], 1u);
            const unsigned tg = og / nx;
            if (og + 1u == (tg + 1u) * nx) xb_add(&bar[XB_TOPGEN], 1u);
            else XB_SPIN(xb_ld(&bar[XB_TOPGEN]) == tg, bar);
            __builtin_amdgcn_fence(__ATOMIC_ACQUIRE, "agent");
            xb_add(&bar[XB_XGEN(b.x)], 1u);
            asm volatile("s_waitcnt vmcnt(0)" ::: "memory");
        } else {
            XB_SPIN(xb_ld(&bar[XB_XGEN(b.x)]) == gen, bar);
            __builtin_amdgcn_fence(__ATOMIC_ACQUIRE, "agent");
            asm volatile("s_waitcnt vmcnt(0)" ::: "memory");
        }
    }
    __syncthreads();
}

struct Args { const float* in[24]; float* out; unsigned char* ws; int ph_lo, ph_hi; };
struct Frame {
    LAS unsigned char* lds; unsigned char* ldsg;
    volatile LAS unsigned* MISC;
    gu32* ctl;
    int tid, lane, wave, vcu, G;
    const __attribute__((address_space(4))) Args* A; float* out; unsigned char* ws;
};
#define INP(k) (F.A->in[k])
#define WSP(T, off) ((T*)(F.ws + (off)))
#define WSG(T, off) ((GAS T*)(F.ws + (off)))

__device__ __forceinline__ void tr_item(const float* W, int ldw, int srccol0, int k0, bf16* WT, int ldt, int dstrow0, int dstk0, const float* ksc, LAS float* scr, int lane) {
    f32x4 v[8];
#pragma unroll
    for (int i = 0; i < 8; ++i) v[i] = __builtin_nontemporal_load((const f32x4*)(W + (size_t)(k0 + 8 * i + (lane >> 3)) * ldw + srccol0 + 4 * (lane & 7)));
#pragma unroll
    for (int i = 0; i < 8; ++i) { const int kk = 8 * i + (lane >> 3); const float sc = ksc ? ksc[k0 + kk] : 1.0f; LAS float* d = scr + kk * 33 + 4 * (lane & 7);
        d[0] = v[i][0] * sc; d[1] = v[i][1] * sc; d[2] = v[i][2] * sc; d[3] = v[i][3] * sc; }
    LDS_WAIT(); asm volatile("" ::: "memory");
    const int c = lane & 7;
#pragma unroll
    for (int j = 0; j < 4; ++j) { const int n = (lane >> 3) + 8 * j; const LAS float* s = scr + (8 * c) * 33 + n;
        v4u o; o.x = pk2(s[0 * 33], s[1 * 33]); o.y = pk2(s[2 * 33], s[3 * 33]); o.z = pk2(s[4 * 33], s[5 * 33]); o.w = pk2(s[6 * 33], s[7 * 33]);
        *(GAS v4u*)(WT + (size_t)(dstrow0 + n) * ldt + dstk0 + 8 * c) = o; }
    LDS_WAIT(); asm volatile("" ::: "memory");
}
__device__ __forceinline__ void sincos_d(double x, double& s, double& c) {
    const double q = rint(x * 0.6366197723675814); double r = fma(-q, 1.5707963267948966, x); r = fma(-q, 6.123233995736766e-17, r);
    const double r2 = r * r;
    double sp = -7.647163731819816e-13; sp = fma(sp, r2, 1.6059043836821613e-10); sp = fma(sp, r2, -2.505210838544172e-08); sp = fma(sp, r2, 2.7557319223985893e-06); sp = fma(sp, r2, -1.984126984126984e-04); sp = fma(sp, r2, 8.333333333333333e-03); sp = fma(sp, r2, -1.6666666666666666e-01);
    const double sr = fma(sp * r2, r, r);
    double cp = 4.779477332387385e-14; cp = fma(cp, r2, -1.1470745597729725e-11); cp = fma(cp, r2, 2.08767569878681e-09); cp = fma(cp, r2, -2.755731922398589e-07); cp = fma(cp, r2, 2.48015873015873e-05); cp = fma(cp, r2, -1.388888888888889e-03); cp = fma(cp, r2, 4.1666666666666664e-02); cp = fma(cp, r2, -0.5);
    const double cr = fma(cp, r2, 1.0);
    const int qi = ((int)q) & 3;
    s = (qi == 0) ? sr : (qi == 1) ? cr : (qi == 2) ? -sr : -cr;
    c = (qi == 0) ? cr : (qi == 1) ? -sr : (qi == 2) ? -cr : sr;
}
__device__ __forceinline__ void p0_prologue(Frame& F) {
    LAS float* scr = (LAS float*)(F.lds + F.wave * 16384);
    const int gw = F.vcu * NWAVES + F.wave, NGW = F.G * NWAVES;
    constexpr int I_A = 136 * 16, I_B = 96 * 16, I_C = 3 * 256, I_D = 512, I_L = I_A + I_B + I_C + I_D;
    for (int it0 = gw; it0 < NLAYER * I_L; it0 += NGW) {
        const int l = it0 / I_L; int r = it0 % I_L;
        const float* anw = INP(1) + l * DM;
        if (r < I_A) { const int db = r / 16, kb = r % 16, d0 = 32 * db; const int pt_ = (d0 >> 8) - 6, rho = d0 & 255;
            const int lc = ((pt_ >= 2 && pt_ <= 5) || pt_ >= 8) ? (d0 & ~255) + ((rho >> 5) & 3) * 64 + (rho >> 7) * 32 : d0;
            tr_item(INP(2) + (size_t)l * DM * INC, INC, lc < 2048 ? lc : lc + 16, 64 * kb, WSP(bf16, WS_WIN) + (size_t)l * 4352 * 1024, 1024, d0, 64 * kb, anw, scr, F.lane); continue; } r -= I_A;
        if (r < I_B) { const int db = r / 16, kb = r % 16, d0 = 32 * db; tr_item(INP(2) + (size_t)l * DM * INC, INC, 4368 + d0, 64 * kb, WSP(bf16, WS_WG) + (size_t)l * 3072 * 1024, 1024, d0, 64 * kb, anw, scr, F.lane); continue; } r -= I_B;
        if (r < I_C) { const int i = r / 256, rr = r % 256, db = rr / 8, kb = rr % 8; tr_item((i == 0 ? INP(11) : (i == 1 ? INP(12) : INP(13))) + (size_t)l * 512 * 1024, 1024, 32 * db, 64 * kb, WSP(bf16, WS_WBR) + (size_t)l * 3072 * 512, 512, i * 1024 + 32 * db, 64 * kb, nullptr, scr, F.lane); continue; } r -= I_C;
        { const int db = r / 16, kb = r % 16; tr_item(INP(14) + (size_t)l * 1024 * 1024, 1024, 32 * db, 64 * kb, WSP(bf16, WS_WO3) + (size_t)l * 1024 * 1024, 1024, 32 * db, 64 * kb, nullptr, scr, F.lane); }
    }
    const int gt = (F.vcu * NWAVES + F.wave) * 64 + F.lane, NGT = F.G * NWAVES * 64;
    bf16* wba = WSP(bf16, WS_WBA); bf16* wrt = WSP(bf16, WS_WRT);
    for (int i = gt; i < NLAYER * 16 * 1024; i += NGT) { const int l = i / (16 * 1024), j = (i / 1024) % 16, k = i % 1024; const float v = INP(1)[l * DM + k] * INP(2)[((size_t)l * DM + k) * INC + 2048 + j];
        const unsigned h = pk2(v, 0.f) & 0xffffu; wba[i] = (bf16)h; wba[NLAYER * 16 * 1024 + i] = (bf16)(pk2(v - __uint_as_float(h << 16), 0.f) & 0xffffu); }
    for (int i = gt; i < NLAYER * 48 * 1024; i += NGT) { const int l = i / (48 * 1024), j = (i / 1024) % 48, k = i % 1024; const float nw = INP(15)[l * DM + k];
        float v = 0.f; if (j < 4) v = nw * INP(16)[((size_t)l * DM + k) * 4 + j]; else if (j < 36) v = nw * INP(18)[((size_t)l * DM + k) * 32 + (j - 4)];
        const unsigned h = pk2(v, 0.f) & 0xffffu; wrt[i] = (bf16)h; wrt[NLAYER * 48 * 1024 + i] = (bf16)(pk2(v - __uint_as_float(h << 16), 0.f) & 0xffffu); }
    float* c1 = WSP(float, WS_COS1); float* s1 = WSP(float, WS_SIN1);
    for (int i = gt; i < SEQ * 32; i += NGT) { const int s = i >> 5, f = i & 31; const double inv = exp(-((double)f / 32.0) * 9.210340371976184); double sn, cs; sincos_d((double)s * inv, sn, cs); c1[i] = (float)cs; s1[i] = (float)sn; }
    float* ax = WSP(float, WS_AX);
    for (int i = gt; i < 192 * 16; i += NGT) { const int p = i >> 4, f = i & 15; const double inv = exp(-((double)f / 16.0) * 9.210340371976184); const int pos = p < 128 ? p : p - 128; double sn, cs; sincos_d((double)pos * inv, sn, cs);
        if (p < 128) { ax[p * 16 + f] = (float)cs; ax[2048 + p * 16 + f] = (float)sn; } else { ax[4096 + (p - 128) * 16 + f] = (float)cs; ax[5120 + (p - 128) * 16 + f] = (float)sn; } }
}
struct TrDesc { const float* src; bf16* dst; int ldw, ldt, k0; bool scale; };
__device__ __forceinline__ TrDesc expert_item(Frame& F, int l, int it) {
    const int e = it / 768, r = it % 768, kind = r / 256, rr = r % 256; TrDesc d;
    if (kind < 2) { const int cb = rr / 16, kb = rr % 16, c0 = 32 * cb;
        d.src = (kind == 0 ? INP(20) : INP(21)) + ((size_t)l * 32 + e) * 1024 * 512 + (size_t)(64 * kb) * 512 + c0; d.ldw = 512;
        d.dst = WSP(bf16, WS_W13T) + (size_t)e * 1024 * 1024 + (size_t)((c0 / 128) * 256 + (c0 % 128) + kind * 128) * 1024 + 64 * kb; d.ldt = 1024; d.k0 = 64 * kb; d.scale = true; }
    else { const int cb = rr / 8, kb = rr % 8;
        d.src = INP(22) + ((size_t)l * 32 + e) * 512 * 1024 + (size_t)(64 * kb) * 1024 + 32 * cb; d.ldw = 1024;
        d.dst = WSP(bf16, WS_W2T) + (size_t)e * 1024 * 512 + (size_t)(32 * cb) * 512 + 64 * kb; d.ldt = 512; d.k0 = 64 * kb; d.scale = false; }
    return d;
}
template <class V> __device__ __forceinline__ void st16s_hidden(unsigned voff, const void* sbase, const V v) { asm volatile("global_store_dwordx4 %0, %1, %2\n\ts_nop 1" :: "v"(voff), "v"(v), "s"(sbase) : "memory"); }
template <class T, class V> __device__ __forceinline__ void st16_hidden(GAS T* p, const V v) { asm volatile("global_store_dwordx4 %0, %1, off\n\ts_nop 1" :: "v"(p), "v"(v) : "memory"); }
__device__ __forceinline__ void expert_convert(Frame& F, int l) {
    int lane; asm volatile("v_mbcnt_lo_u32_b32 %0, -1, 0\n\tv_mbcnt_hi_u32_b32 %0, -1, %0" : "=v"(lane));
    const int gw = F.vcu * NWAVES + F.wave, NGW = F.G * NWAVES, NIT = 32 * 768;
    LAS float* scr = (LAS float*)(F.lds + F.wave * 16896); LAS float* fnl = scr + 64 * 33;
    { const GAS float* fnw = (const GAS float*)INP(15) + l * DM;
#pragma unroll
      for (int i = 0; i < 4; ++i) *(LAS f32x4*)(fnl + 4 * (i * 64 + lane)) = *(const GAS f32x4*)(fnw + 4 * (i * 64 + lane)); }
    LDS_WAIT(); asm volatile("" ::: "memory");
    constexpr int EC_D = 4;
    int its[EC_D]; f32x4 v[EC_D][8];
#define EC_ISSUE(s, IT) do { its[s] = (IT); const bool ok_ = its[s] < NIT; TrDesc di_ = expert_item(F, l, ok_ ? its[s] : gw); if (!ok_) { di_.src = INP(15); di_.ldw = 0; } \
        const unsigned vo_ = (unsigned)(((lane >> 3) * di_.ldw + 4 * (lane & 7)) * 4);     \
        _Pragma("unroll") for (int i = 0; i < 8; ++i) v[s][i] = __builtin_nontemporal_load((const GAS f32x4*)((const GAS char*)(di_.src + (size_t)(8 * i) * di_.ldw) + vo_)); } while (0)
#pragma unroll
    for (int s = 0; s < EC_D; ++s) EC_ISSUE(s, gw + s * NGW);
    for (int it = gw; it < NIT; it += EC_D * NGW) {
#pragma unroll
        for (int s = 0; s < EC_D; ++s) {
            if (its[s] < NIT) { const TrDesc dd = expert_item(F, l, its[s]); const unsigned vd = (unsigned)(((lane >> 3) * dd.ldt + 8 * (lane & 7)) * 2);
#pragma unroll
                for (int i = 0; i < 8; ++i) { const int kk = 8 * i + (lane >> 3); const float sc = dd.scale ? fnl[dd.k0 + kk] : 1.0f; LAS float* q = scr + kk * 33 + 4 * (lane & 7);
                    q[0] = v[s][i][0] * sc; q[1] = v[s][i][1] * sc; q[2] = v[s][i][2] * sc; q[3] = v[s][i][3] * sc; }
                LDS_WAIT(); asm volatile("" ::: "memory");
                const int c = lane & 7;
#pragma unroll
                for (int j = 0; j < 4; ++j) { const int n = (lane >> 3) + 8 * j; const LAS float* sp = scr + (8 * c) * 33 + n;
                    v4u o; o.x = pk2(sp[0 * 33], sp[1 * 33]); o.y = pk2(sp[2 * 33], sp[3 * 33]); o.z = pk2(sp[4 * 33], sp[5 * 33]); o.w = pk2(sp[6 * 33], sp[7 * 33]);
                    st16s_hidden(vd, dd.dst + (size_t)(8 * j) * dd.ldt, o); }
                LDS_WAIT(); asm volatile("" ::: "memory");
            }
            EC_ISSUE(s, it + (s + EC_D) * NGW);
        }
    }
#undef EC_ISSUE
    asm volatile("s_waitcnt vmcnt(0)" ::: "memory");
}

template <int MODE> __device__ __forceinline__ void norm_pass(Frame& F, int l) {
    const int lane = F.lane, r16 = lane & 15, q4 = lane >> 4;
    const int gw = F.vcu * NWAVES + F.wave, NGW = F.G * NWAVES;
    constexpr int NCT = (MODE == 1) ? 3 : (MODE == 3 ? 0 : 1);
    const GAS bf16* Wt = (MODE == 1) ? WSG(bf16, WS_WRT) + (size_t)l * 48 * 1024 : WSG(bf16, WS_WBA) + (size_t)l * 16 * 1024;
    constexpr size_t WLO = (MODE == 1) ? (size_t)NLAYER * 48 * 1024 : (size_t)NLAYER * 16 * 1024;
    GAS float* rstd_out = WSG(float, MODE == 1 ? WS_RSTD2 : (MODE == 3 ? WS_RSTDF : WS_RSTD1));
    GAS bf16* XB = WSG(bf16, WS_XB);
    const GAS bf16* YB = WSG(bf16, WS_XG);
    int tb = 0;
    if (MODE >= 2) {
        const int lp = (MODE == 2) ? l - 1 : NLAYER - 1;
        const int cnt = lane < 32 ? (int)F.ctl[CW_CNT + 64 * lp + lane] : 0; const int nt = (cnt + 255) >> 8; int inc = nt;
#pragma unroll
        for (int o = 1; o < 32; o <<= 1) { const int t = SHFL_UP(inc, o); if (lane >= o) inc += t; }
        tb = inc - nt;
    }
    LAS float* scr = (LAS float*)(F.lds + F.wave * 16384 + 12288);
    for (int tile = gw; tile < TOK / 16; tile += NGW) {
        const int row = tile * 16 + r16;
        const GAS float* src = (const GAS float*)INP(0) + (size_t)row * DM + 16 * q4;
        GAS float* dst = (GAS float*)F.out + (size_t)row * DM + 16 * q4;
        const unsigned xoff = (unsigned)(row * DM + 16 * q4);
#define xb (XB + xoff)
        size_t y1 = 0, y2 = 0;
        if (MODE >= 2) { const GAS int* ts = WSG(int, WS_TSLOT) + row * 2; const int s1 = ts[0], s2 = ts[1];
            const int b1 = SHFL(tb, s1 >> 15), b2 = SHFL(tb, s2 >> 15);
            y1 = ((size_t)b1 * 256 + (s1 & 32767)) * DM + 16 * q4; y2 = ((size_t)b2 * 256 + (s2 & 32767)) * DM + 16 * q4; }
        f32x4 acc[NCT > 0 ? NCT : 1];
#pragma unroll
        for (int c = 0; c < (NCT > 0 ? NCT : 1); ++c) acc[c] = (f32x4){0.f, 0.f, 0.f, 0.f};
        float ss = 0.f;
        f32x4 vv[2][2][4]; v4u xa[2][2][2]; v4u ya[2][2][4];
#define NP_LOAD(B, KB) do { _Pragma("unroll") for (int gq = 0; gq < 2; ++gq) { const int kb_ = (KB) + 64 * gq; \
            if (MODE == 0) { _Pragma("unroll") for (int i = 0; i < 4; ++i) vv[B][gq][i] = __builtin_nontemporal_load((const GAS f32x4*)(src + kb_ + 4 * i)); } \
            else { xa[B][gq][0] = *(const GAS v4u*)(xb + kb_); xa[B][gq][1] = *(const GAS v4u*)(xb + kb_ + 8); } \
            if (MODE >= 2) { ya[B][gq][0] = __builtin_nontemporal_load((const GAS v4u*)(YB + y1 + kb_)); ya[B][gq][1] = __builtin_nontemporal_load((const GAS v4u*)(YB + y1 + kb_ + 8)); \
                             ya[B][gq][2] = __builtin_nontemporal_load((const GAS v4u*)(YB + y2 + kb_)); ya[B][gq][3] = __builtin_nontemporal_load((const GAS v4u*)(YB + y2 + kb_ + 8)); } } } while (0)
#define NP_TRIP(B, KB0, PF) do { const int kb0 = (KB0); \
            bf16x8 wh[2][NCT > 0 ? NCT : 1][2], wl[2][NCT > 0 ? NCT : 1][2];     \
            _Pragma("unroll") for (int gq = 0; gq < 2; ++gq) _Pragma("unroll") for (int c = 0; c < NCT; ++c) _Pragma("unroll") for (int hf = 0; hf < 2; ++hf) { \
                const GAS bf16* wp_ = Wt + (size_t)(c * 16 + r16) * DM + kb0 + 64 * gq + 16 * q4 + 8 * hf; wh[gq][c][hf] = *(const GAS bf16x8*)wp_; wl[gq][c][hf] = *(const GAS bf16x8*)(wp_ + WLO); } \
            __builtin_amdgcn_sched_barrier(0); \
            if (PF) NP_LOAD((B) ^ 1, kb0 + 128); \
            __builtin_amdgcn_sched_barrier(0);     \
            _Pragma("unroll") for (int gq = 0; gq < 2; ++gq) { const int kb = kb0 + 64 * gq; \
                f32x4 v[4]; \
                if (MODE == 0) { _Pragma("unroll") for (int i = 0; i < 4; ++i) v[i] = vv[B][gq][i]; } \
                else { const v4u x0 = xa[B][gq][0], x1 = xa[B][gq][1]; \
                    v[0] = (f32x4){bflo(x0.x), bfhi(x0.x), bflo(x0.y), bfhi(x0.y)}; v[1] = (f32x4){bflo(x0.z), bfhi(x0.z), bflo(x0.w), bfhi(x0.w)}; \
                    v[2] = (f32x4){bflo(x1.x), bfhi(x1.x), bflo(x1.y), bfhi(x1.y)}; v[3] = (f32x4){bflo(x1.z), bfhi(x1.z), bflo(x1.w), bfhi(x1.w)}; } \
                if (MODE >= 2) { \
                    const v4u a0 = ya[B][gq][0], a1 = ya[B][gq][1], b0 = ya[B][gq][2], b1 = ya[B][gq][3]; \
                    v[0] += (f32x4){bflo(a0.x) + bflo(b0.x), bfhi(a0.x) + bfhi(b0.x), bflo(a0.y) + bflo(b0.y), bfhi(a0.y) + bfhi(b0.y)}; \
                    v[1] += (f32x4){bflo(a0.z) + bflo(b0.z), bfhi(a0.z) + bfhi(b0.z), bflo(a0.w) + bflo(b0.w), bfhi(a0.w) + bfhi(b0.w)}; \
                    v[2] += (f32x4){bflo(a1.x) + bflo(b1.x), bfhi(a1.x) + bfhi(b1.x), bflo(a1.y) + bflo(b1.y), bfhi(a1.y) + bfhi(b1.y)}; \
                    v[3] += (f32x4){bflo(a1.z) + bflo(b1.z), bfhi(a1.z) + bfhi(b1.z), bflo(a1.w) + bflo(b1.w), bfhi(a1.w) + bfhi(b1.w)}; \
                } \
                _Pragma("unroll") for (int i = 0; i < 4; ++i) ss += (v[i][0] * v[i][0] + v[i][1] * v[i][1]) + (v[i][2] * v[i][2] + v[i][3] * v[i][3]); \
                v4u o0, o1;                                              \
                if (MODE == 1) { o0 = xa[B][gq][0]; o1 = xa[B][gq][1]; } \
                else { o0.x = pk2(v[0][0], v[0][1]); o0.y = pk2(v[0][2], v[0][3]); o0.z = pk2(v[1][0], v[1][1]); o0.w = pk2(v[1][2], v[1][3]); \
                       o1.x = pk2(v[2][0], v[2][1]); o1.y = pk2(v[2][2], v[2][3]); o1.z = pk2(v[3][0], v[3][1]); o1.w = pk2(v[3][2], v[3][3]); } \
                if (MODE == 0 || MODE == 2) { GAS bf16* xo = XB + (size_t)row * DM + 16 * q4 + kb; st16_hidden(xo, o0); st16_hidden(xo + 8, o1); } \
                _Pragma("unroll") for (int c = 0; c < NCT; ++c) { \
                    acc[c] = mfma16(__builtin_bit_cast(bf16x8, o0), wh[gq][c][0], acc[c]); acc[c] = mfma16(__builtin_bit_cast(bf16x8, o0), wl[gq][c][0], acc[c]); \
                    acc[c] = mfma16(__builtin_bit_cast(bf16x8, o1), wh[gq][c][1], acc[c]); acc[c] = mfma16(__builtin_bit_cast(bf16x8, o1), wl[gq][c][1], acc[c]); } \
            } } while (0)
        NP_LOAD(0, 0);
#pragma unroll 1
        for (int kbq = 0; kbq < DM - 256; kbq += 256) { NP_TRIP(0, kbq, true); NP_TRIP(1, kbq + 128, true); }
        NP_TRIP(0, DM - 256, true); NP_TRIP(1, DM - 128, false);
#undef NP_LOAD
#undef NP_TRIP
        ss += SHFL_XOR(ss, 16); ss += SHFL_XOR(ss, 32);
        const float rstd = 1.0f / sqrtf(ss * (1.0f / DM) + EPS);
        if (q4 == 0) rstd_out[row] = rstd;
        if (MODE == 3) {
            const GAS float* fw = (const GAS float*)INP(23) + 16 * q4;
#pragma unroll 2
            for (int kb = 0; kb < DM; kb += 64) {
                const v4u x0 = *(const GAS v4u*)(xb + kb), x1 = *(const GAS v4u*)(xb + kb + 8);
                const v4u a0 = *(const GAS v4u*)(YB + y1 + kb), a1 = *(const GAS v4u*)(YB + y1 + kb + 8), b0 = *(const GAS v4u*)(YB + y2 + kb), b1 = *(const GAS v4u*)(YB + y2 + kb + 8);
                f32x4 wv[4];
#pragma unroll
                for (int i = 0; i < 4; ++i) wv[i] = *(const GAS f32x4*)(fw + kb + 4 * i);
                f32x4 v[4];
                v[0] = (f32x4){bflo(x0.x), bfhi(x0.x), bflo(x0.y), bfhi(x0.y)}; v[1] = (f32x4){bflo(x0.z), bfhi(x0.z), bflo(x0.w), bfhi(x0.w)};
                v[2] = (f32x4){bflo(x1.x), bfhi(x1.x), bflo(x1.y), bfhi(x1.y)}; v[3] = (f32x4){bflo(x1.z), bfhi(x1.z), bflo(x1.w), bfhi(x1.w)};
                v[0] += (f32x4){bflo(a0.x) + bflo(b0.x), bfhi(a0.x) + bfhi(b0.x), bflo(a0.y) + bflo(b0.y), bfhi(a0.y) + bfhi(b0.y)};
                v[1] += (f32x4){bflo(a0.z) + bflo(b0.z), bfhi(a0.z) + bfhi(b0.z), bflo(a0.w) + bflo(b0.w), bfhi(a0.w) + bfhi(b0.w)};
                v[2] += (f32x4){bflo(a1.x) + bflo(b1.x), bfhi(a1.x) + bfhi(b1.x), bflo(a1.y) + bflo(b1.y), bfhi(a1.y) + bfhi(b1.y)};
                v[3] += (f32x4){bflo(a1.z) + bflo(b1.z), bfhi(a1.z) + bfhi(b1.z), bflo(a1.w) + bflo(b1.w), bfhi(a1.w) + bfhi(b1.w)};
#pragma unroll
                for (int i = 0; i < 4; ++i) st16_hidden(dst + kb + 4 * i, v[i] * rstd * wv[i]);
            }
        }
#undef xb
        float rr[4];
#pragma unroll
        for (int g = 0; g < 4; ++g) rr[g] = SHFL(rstd, q4 * 4 + g);
        if (MODE == 0 || MODE == 2) { GAS float* ba = WSG(float, WS_BA);
#pragma unroll
            for (int g = 0; g < 4; ++g) ba[(size_t)(tile * 16 + q4 * 4 + g) * 16 + r16] = acc[0][g] * rr[g]; }
        if (MODE == 1) {
#pragma unroll
            for (int c = 0; c < NCT; ++c) { const int col = c * 16 + r16; float bias = 0.f; if (col < 4) bias = ((const GAS float*)INP(17))[l * 4 + col]; else if (col < 36) bias = ((const GAS float*)INP(19))[l * 32 + col - 4];
#pragma unroll
                for (int g = 0; g < 4; ++g) scr[(q4 * 4 + g) * 48 + col] = acc[c][g] * rr[g] + bias; }
            LDS_WAIT(); asm volatile("" ::: "memory");
            if (lane < 16) {
                const LAS float* lg = scr + lane * 48; const int t = tile * 16 + lane;
                int gi = 0; float gm = lg[0];
#pragma unroll
                for (int j = 1; j < 4; ++j) if (lg[j] > gm) { gm = lg[j]; gi = j; }
                float gs = 0.f;
#pragma unroll
                for (int j = 0; j < 4; ++j) gs += __expf(lg[j] - gm);
                const float gp = 1.0f / gs;
                const LAS float* el = lg + 4 + gi * 8;
                int i1 = 0; float m1 = el[0];
#pragma unroll
                for (int j = 1; j < 8; ++j) if (el[j] > m1) { m1 = el[j]; i1 = j; }
                int i2 = -1; float m2 = -3.0e38f;
#pragma unroll
                for (int j = 0; j < 8; ++j) if (j != i1 && el[j] > m2) { m2 = el[j]; i2 = j; }
                const float p2 = __expf(m2 - m1), w1 = gp / (1.0f + p2), w2 = gp * p2 / (1.0f + p2);
                const int E1 = gi * 8 + i1, E2 = gi * 8 + i2;
                GAS unsigned* cnt = (GAS unsigned*)(F.ctl + CW_CNT + 64 * l);
                const int p1 = (int)__hip_atomic_fetch_add(cnt + E1, 1u, __ATOMIC_RELAXED, __HIP_MEMORY_SCOPE_AGENT), pp2 = (int)__hip_atomic_fetch_add(cnt + E2, 1u, __ATOMIC_RELAXED, __HIP_MEMORY_SCOPE_AGENT);
                GAS int* tokl = WSG(int, WS_TOKL); GAS float* wl = WSG(float, WS_WL); GAS int* ts = WSG(int, WS_TSLOT);
                tokl[E1 * 32768 + p1] = t; wl[E1 * 32768 + p1] = w1; ts[t * 2] = (E1 << 15) | p1;
                tokl[E2 * 32768 + pp2] = t; wl[E2 * 32768 + pp2] = w2; ts[t * 2 + 1] = (E2 << 15) | pp2;
            }
            LDS_WAIT(); asm volatile("" ::: "memory");
        }
    }
}

__device__ __forceinline__ void unpack8(const v4u w, float (&x)[8]) { x[0] = bflo(w.x); x[1] = bfhi(w.x); x[2] = bflo(w.y); x[3] = bfhi(w.y); x[4] = bflo(w.z); x[5] = bfhi(w.z); x[6] = bflo(w.w); x[7] = bfhi(w.w); }
__device__ __forceinline__ v4u pack8(const float (&x)[8]) { v4u w; w.x = pk2(x[0], x[1]); w.y = pk2(x[2], x[3]); w.z = pk2(x[4], x[5]); w.w = pk2(x[6], x[7]); return w; }
__device__ __forceinline__ void rope_pass(Frame& F, int l) {
    const int lane = F.lane, jl = lane & 7;
    const int gw = F.vcu * NWAVES + F.wave, NGW = F.G * NWAVES;
    const float* c1 = WSP(float, WS_COS1); const float* s1 = WSP(float, WS_SIN1); const float* ax = WSP(float, WS_AX);
    bf16* PP = WSP(bf16, WS_PP);
    float qnw[8], knw[8];
#pragma unroll
    for (int e = 0; e < 8; ++e) { qnw[e] = INP(9)[l * 64 + 8 * jl + e]; knw[e] = INP(10)[l * 64 + 8 * jl + e]; }
    for (int t = gw; t < TOK; t += NGW) {
        const int s = t & (SEQ - 1); bf16* prow = PP + (size_t)t * PPW;
        float cs[8], sn[8];
        { const f32x4 ca = *(const f32x4*)(c1 + s * 32 + 8 * (jl & 3)), cb = *(const f32x4*)(c1 + s * 32 + 8 * (jl & 3) + 4), sa = *(const f32x4*)(s1 + s * 32 + 8 * (jl & 3)), sb = *(const f32x4*)(s1 + s * 32 + 8 * (jl & 3) + 4);
#pragma unroll
          for (int e = 0; e < 4; ++e) { cs[e] = ca[e]; cs[4 + e] = cb[e]; sn[e] = sa[e]; sn[4 + e] = sb[e]; } }
#pragma unroll
        for (int which = 0; which < 2; ++which) {
            bf16* p = prow + (which == 0 ? PC_DQ : PC_DK) + 8 * lane; float x[8], o[8]; unpack8(*(const v4u*)p, x);
#pragma unroll
            for (int e = 0; e < 8; ++e) { const float pv = SHFL_XOR(x[e], 4); o[e] = (jl < 4) ? x[e] * cs[e] - pv * sn[e] : x[e] * cs[e] + pv * sn[e]; if (which == 0) o[e] *= QSCALE; }
            *(v4u*)p = pack8(o);
        }
        float ac[8], as[8];
        { const float* tbc = (jl < 4) ? ax + (s >> 6) * 16 : ax + 4096 + (s & 63) * 16; const float* tbs = (jl < 4) ? ax + 2048 + (s >> 6) * 16 : ax + 5120 + (s & 63) * 16;
          const f32x4 ca = *(const f32x4*)(tbc + 8 * (jl & 1)), cb = *(const f32x4*)(tbc + 8 * (jl & 1) + 4), sa = *(const f32x4*)(tbs + 8 * (jl & 1)), sb = *(const f32x4*)(tbs + 8 * (jl & 1) + 4);
#pragma unroll
          for (int e = 0; e < 4; ++e) { ac[e] = ca[e]; ac[4 + e] = cb[e]; as[e] = sa[e]; as[4 + e] = sb[e]; } }
#pragma unroll
        for (int which = 0; which < 2; ++which) {
            bf16* p = prow + (which == 0 ? PC_CQ + 8 * lane : PC_CK + 8 * (lane & 15)); float x[8], o[8]; unpack8(*(const v4u*)p, x);
            float ssq = 0.f;
#pragma unroll
            for (int e = 0; e < 8; ++e) ssq += x[e] * x[e];
            ssq += SHFL_XOR(ssq, 1); ssq += SHFL_XOR(ssq, 2); ssq += SHFL_XOR(ssq, 4);
            const float rn = 1.0f / sqrtf(ssq * (1.0f / 64.0f) + EPS);
#pragma unroll
            for (int e = 0; e < 8; ++e) x[e] = x[e] * rn * (which == 0 ? qnw[e] : knw[e]);
#pragma unroll
            for (int e = 0; e < 8; ++e) { const float pv = SHFL_XOR(x[e], 2); o[e] = ((jl & 3) < 2) ? x[e] * ac[e] - pv * as[e] : x[e] * ac[e] + pv * as[e]; if (which == 0) o[e] *= QSCALE; }
            if (which == 0 || lane < 16) *(v4u*)p = pack8(o);
        }
    }
}

__host__ __device__ __forceinline__ constexpr int frag_off(int row, int col, int C) { return (((row >> 4) * (C / 32) + (col >> 5)) * 64 + ((col >> 3) & 3) * 16 + (row & 15)) * 8 + (col & 7); }
constexpr int CK_KS = 0, CK_QS = 17408, CK_L0 = 34816, CK_L1 = 52224, CK_BET = 69632, CK_GCS = 70144, CK_BYTES = 70656;
constexpr int SOLVE_PF = 8;
constexpr int solve_ns() { int s = 0; for (int i = 0; i < 63; ++i) s += 16 - (i + 1) / 4; return s; }
constexpr int SOLVE_NS = solve_ns();
constexpr int solve_si(int s) { int i = 0; for (; i < 63; ++i) { const int n = 16 - (i + 1) / 4; if (s < n) break; s -= n; } return i; }
constexpr int solve_sq(int s) { int i = 0; for (; i < 63; ++i) { const int n = 16 - (i + 1) / 4; if (s < n) break; s -= n; } return (i + 1) / 4 + s; }
template <int S> __device__ __forceinline__ void solve_slot(float (&m)[64], f32x4 (&ring)[SOLVE_PF], const LAS float* Lm) {
    constexpr int i = solve_si(S), lq = solve_sq(S);
    const f32x4 Lv = ring[S % SOLVE_PF];
    if constexpr (S + SOLVE_PF < SOLVE_NS) { constexpr int i2 = solve_si(S + SOLVE_PF), q2 = solve_sq(S + SOLVE_PF); ring[S % SOLVE_PF] = *(const LAS f32x4*)(Lm + i2 * 68 + 4 * q2); }
#pragma unroll
    for (int e = 0; e < 4; ++e) if (4 * lq + e > i) m[4 * lq + e] -= Lv[e] * m[i];
    __builtin_amdgcn_sched_barrier(0);
}
template <int... Is> __device__ __forceinline__ void solve_run(float (&m)[64], f32x4 (&ring)[SOLVE_PF], const LAS float* Lm, std::integer_sequence<int, Is...>) { (solve_slot<Is>(m, ring, Lm), ...); }
__device__ __forceinline__ void chunk_solve(Frame& F, LAS unsigned char* ldsc, int d, int cid, int j) {
    const LAS float* Lm = (const LAS float*)(ldsc + (d == 0 ? CK_L0 : CK_L1));
    const LAS float* bet = (const LAS float*)(ldsc + CK_BET);
    const float bj = bet[d * 64 + (d == 0 ? j : 63 - j)];
    float m[64];
#pragma unroll
    for (int i = 0; i < 64; ++i) m[i] = 0.f;
    { int jj = j; asm volatile("" : "+v"(jj));
#pragma unroll
      for (int i = 0; i < 64; ++i) m[i] = (i == jj) ? bj : 0.f; }
    f32x4 ring[SOLVE_PF];
#pragma unroll
    for (int k = 0; k < SOLVE_PF; ++k) ring[k] = *(const LAS f32x4*)(Lm + solve_si(k) * 68 + 4 * solve_sq(k));
    solve_run(m, ring, Lm, std::make_integer_sequence<int, SOLVE_NS>{});
    LAS unsigned short* Mi = (LAS unsigned short*)(ldsc + (d == 0 ? CK_L0 : CK_L1));
    if (d == 0) {
        LAS unsigned short* mp = Mi + j;
#pragma unroll
        for (int i = 0; i < 64; ++i) mp[i * 72] = (unsigned short)(pk2(m[i], 0.f) & 0xffffu);
    } else {
        LAS unsigned short* mp = Mi + (63 - j);
#pragma unroll
        for (int i = 0; i < 64; ++i) mp[(63 - i) * 72] = (unsigned short)(pk2(m[i], 0.f) & 0xffffu);
    }
    LDS_WAIT(); asm volatile("" ::: "memory");
    GAS bf16* mt = WSG(bf16, WS_MM) + ((size_t)d * 2048 + cid) * 4096;
#pragma unroll
    for (int t = 0; t < 8; ++t) { const int row = (t >> 1) * 16 + (j & 15), col0 = (t & 1) * 32 + (j >> 4) * 8;
        const v4u v = *(const LAS v4u*)(Mi + row * 72 + col0); *(GAS v4u*)(mt + (t * 64 + j) * 8) = v; }
}
template <int PV> __device__ __forceinline__ void chunk_phase(Frame& F, int l) {
    const int w = F.wave, hb = w >> 2, ww = w & 3;
    const GAS float* convw = (const GAS float*)(INP(3) + l * 5 * 1536); const GAS float* alog = (const GAS float*)(INP(4) + l * 8); const GAS float* dtb = (const GAS float*)(INP(5) + l * 8);
    const GAS bf16* RAW = WSG(bf16, WS_RAW); const GAS float* BA = WSG(float, WS_BA);
    LAS unsigned char* lds = F.lds + hb * CK_BYTES;
    LAS float* bet = (LAS float*)(lds + CK_BET); LAS float* gcs = (LAS float*)(lds + CK_GCS);
    for (int pu = blockIdx.x; pu < 1024; pu += F.G) {
        const int cid = 2 * pu + hb;
        const int c = cid & 127, bh = cid >> 7, h = bh & 3, b = bh >> 2;
        const int t0 = b * SEQ + c * 64;
        int lane = F.lane; asm volatile("" : "+v"(lane));
        const int r16 = lane & 15, q4 = lane >> 4;
        { const int rb0 = 16 * ww;
          unsigned rw[3][20]; float cw0[3][5], cw1[3][5];
#pragma unroll
          for (int p = 0; p < 3; ++p) { const int col = p * 512 + h * 128 + 2 * lane;
#pragma unroll
            for (int tp = 0; tp < 5; ++tp) { cw0[p][tp] = convw[tp * 1536 + col]; cw1[p][tp] = convw[tp * 1536 + col + 1]; }
#pragma unroll
            for (int jr = 0; jr < 20; ++jr) { const int s = c * 64 + rb0 + jr - 2; unsigned u = 0u; if (s >= 0 && s < SEQ) u = *(const GAS unsigned*)(RAW + (size_t)(b * SEQ + s) * 1536 + col); rw[p][jr] = u; } }
#pragma unroll
          for (int p = 0; p < 3; ++p) {
            GAS bf16* gdst = WSG(bf16, WS_VC) + (size_t)cid * 8192 + ((rb0 >> 2) * 128 + 2 * lane) * 4;
            unsigned vq[4];
#pragma unroll
            for (int jr = 0; jr < 16; ++jr) {
                float a0 = 0.f, a1 = 0.f;
#pragma unroll
                for (int tp = 0; tp < 5; ++tp) { a0 += cw0[p][tp] * bflo(rw[p][jr + tp]); a1 += cw1[p][tp] * bfhi(rw[p][jr + tp]); }
                a0 = a0 * sigm(a0); a1 = a1 * sigm(a1);
                if (p < 2) { const float ssq = wave_sum(a0 * a0 + a1 * a1, lane); float rn = __builtin_amdgcn_rsqf(ssq + EPS); if (p == 0) rn *= 0.08838834764831845f; a0 *= rn; a1 *= rn; }
                const unsigned pk = pk2(a0, a1); const int row = rb0 + jr;
                if (p == 2) { vq[jr & 3] = pk;
                    if ((jr & 3) == 3) { v4u o; o.x = (vq[0] & 0xffffu) | (vq[1] << 16); o.y = (vq[2] & 0xffffu) | (vq[3] << 16); o.z = (vq[0] >> 16) | (vq[1] & 0xffff0000u); o.w = (vq[2] >> 16) | (vq[3] & 0xffff0000u);
                        *(GAS v4u*)(gdst + (jr >> 2) * 512) = o; } }
                if (p == 0) *(LAS unsigned*)(lds + CK_QS + row * 272 + 4 * lane) = pk;
                if (p == 1) *(LAS unsigned*)(lds + CK_KS + row * 272 + 4 * lane) = pk;
            }
          } }
        if (ww < 2) { const int d = ww, tn = d == 0 ? lane : 63 - lane; const size_t tok = (size_t)(t0 + tn);
            const float braw = BA[tok * 16 + d * 4 + h], araw = BA[tok * 16 + 8 + d * 4 + h];
            const float x = araw + dtb[d * 4 + h]; const float sp = fmaxf(x, 0.f) + log1pf(__expf(-fabsf(x)));
            float gc = -__expf(alog[d * 4 + h]) * sp;
#pragma unroll
            for (int o = 1; o < 64; o <<= 1) { const float tv = SHFL_UP(gc, o); if (lane >= o) gc += tv; }
            bet[d * 64 + tn] = sigm(braw); gcs[d * 64 + tn] = gc;
            WSG(float, WS_GC)[((size_t)d * 2048 + cid) * 64 + tn] = gc; }
        LBAR();
        { GAS bf16* KNt = WSG(bf16, WS_KN) + (size_t)cid * 8192; GAS bf16* QNt = WSG(bf16, WS_QN) + (size_t)cid * 8192;
#pragma unroll
          for (int it = 0; it < 4; ++it) { const int lo = (it * 16 + r16) * 272 + (ww * 32 + q4 * 8) * 2, P = (it * 4 + ww) * 64 + lane;
              const v4u kq = *(const LAS v4u*)(lds + CK_KS + lo), qq = *(const LAS v4u*)(lds + CK_QS + lo);
              *(GAS v4u*)(KNt + P * 8) = kq; *(GAS v4u*)(QNt + P * 8) = qq; } }
        { const int ti = ww;
          GAS bf16* I0 = WSG(bf16, WS_INTRA) + ((size_t)0 * 2048 + cid) * 4096; GAS bf16* I1 = WSG(bf16, WS_INTRA) + ((size_t)1 * 2048 + cid) * 4096;
          LAS float* L0 = (LAS float*)(lds + CK_L0); LAS float* L1 = (LAS float*)(lds + CK_L1);
          const int iq = ti * 16 + r16; const float gq0 = gcs[iq], gq1 = gcs[64 + iq];
#pragma unroll 1
          for (int tj = 0; tj < 4; ++tj) {
            f32x4 aK = (f32x4){0.f, 0.f, 0.f, 0.f}, aQ = (f32x4){0.f, 0.f, 0.f, 0.f};
#pragma unroll
            for (int kk = 0; kk < 4; ++kk) { const bf16x8 fk = *(const LAS bf16x8*)(lds + CK_KS + (ti * 16 + r16) * 272 + kk * 64 + q4 * 16), fq = *(const LAS bf16x8*)(lds + CK_QS + (ti * 16 + r16) * 272 + kk * 64 + q4 * 16),
                                                            fb = *(const LAS bf16x8*)(lds + CK_KS + (tj * 16 + r16) * 272 + kk * 64 + q4 * 16);
                aK = mfma16(fk, fb, aK); aQ = mfma16(fb, fq, aQ); }
            const int jn = tj * 16 + r16; const float g0j = gcs[jn], g1j = gcs[64 + jn];
#pragma unroll
            for (int r = 0; r < 4; ++r) { const int in = ti * 16 + q4 * 4 + r;
                const float e0 = __expf(fminf(gcs[in] - g0j, 0.f)), e1 = __expf(fminf(gcs[64 + in] - g1j, 0.f));
                L0[jn * 68 + in] = (in > jn) ? bet[in] * aK[r] * e0 : 0.f;
                L1[(63 - jn) * 68 + (63 - in)] = (in < jn) ? bet[64 + in] * aK[r] * e1 : 0.f; }
            float v0[4], v1[4];
#pragma unroll
            for (int r = 0; r < 4; ++r) { const int jq = tj * 16 + q4 * 4 + r;
                const float e0 = __expf(fminf(gq0 - gcs[jq], 0.f)), e1 = __expf(fminf(gq1 - gcs[64 + jq], 0.f));
                v0[r] = (iq >= jq) ? aQ[r] * e0 : 0.f; v1[r] = (iq <= jq) ? aQ[r] * e1 : 0.f; }
            const int ib = frag_off(iq, tj * 16 + q4 * 4, 64);
            v2u o0, o1; o0.x = pk2(v0[0], v0[1]); o0.y = pk2(v0[2], v0[3]); o1.x = pk2(v1[0], v1[1]); o1.y = pk2(v1[2], v1[3]);
            *(GAS v2u*)(I0 + ib) = o0; *(GAS v2u*)(I1 + ib) = o1;
          } }
        LBAR();
        const int role = (ww + 2 * hb) & 3;
        if (role < 2) { if (!(PV & 1)) chunk_solve(F, lds, role, cid, lane); }
        LBAR();
    }
}

typedef short s16x4 __attribute__((ext_vector_type(4)));
__device__ __forceinline__ s16x4 sc_tr(const LAS unsigned char* p) { return __builtin_bit_cast(s16x4, __builtin_amdgcn_ds_read_tr16_b64_v4i16((LAS s16x4*)p)); }
#ifndef SC_NST
#define SC_NST 6
#endif
#ifndef SCAN_CS
#define SCAN_CS 1
#endif
static_assert(SCAN_CS == 1, "the token-quad v layout is wired for 16-column slices");
constexpr int SC_CS = SCAN_CS, SC_NITEM = 32 * (8 / SC_CS), SC_STRIDE = 256 / SC_NITEM, SC_ST = 0, SC_RT = SC_CS * 4352, SC_VT = SC_RT + SC_CS * 2304, SC_VTS = SC_VT + SC_CS * 2304, SC_LDS = SC_VTS + SC_CS * 2304, SC_KI = SC_LDS, SC_KIP = 288;
template <int VAR> __device__ __forceinline__ void scan_phase(Frame& F) {
    const int lane = F.lane, w = F.wave, wl = w & 3, r16 = lane & 15, q4 = lane >> 4;
    LAS unsigned char* lds = F.lds;
    const GAS bf16* KN = WSG(bf16, WS_KN); const GAS bf16* KT = WSG(bf16, WS_KT); const GAS bf16* QN = WSG(bf16, WS_QN); const GAS bf16* VC = WSG(bf16, WS_VC);
    const GAS bf16* MMp = WSG(bf16, WS_MM); const GAS bf16* INp = WSG(bf16, WS_INTRA); const GAS float* GC = WSG(float, WS_GC);
    if ((F.vcu % SC_STRIDE) != 0) return;
    for (int item = F.vcu / SC_STRIDE; item < SC_NITEM; item += F.G / SC_STRIDE) {
        const int chain = item / (8 / SC_CS), d = chain >> 4, b = (chain >> 2) & 3, h = chain & 3, dv0 = (item % (8 / SC_CS)) * (16 * SC_CS);
        for (int i = F.tid; i < SC_LDS / 4; i += NWAVES * 64) ((LAS unsigned*)lds)[i] = 0u;
        f32x4 Sacc[SC_CS];
#pragma unroll
        for (int cs = 0; cs < SC_CS; ++cs) Sacc[cs] = (f32x4){0.f, 0.f, 0.f, 0.f};
        GAS bf16* Og = WSG(bf16, d == 0 ? WS_OF : WS_OB);
        __syncthreads();
        constexpr int NST = SC_NST;
        bf16x8 sA4[NST][4], sA2[NST][2]; f32x4 sgc[NST]; float sgl[NST]; v2u svq[NST];
#define SC_LOAD(st, n) do { const int c_ = d == 0 ? (n) : 127 - (n); const size_t cid_ = (size_t)(b * 4 + h) * 128 + c_; const size_t dc_ = (size_t)d * 2048 + cid_; \
        const GAS bf16* a4_ = (w < 4 ? KN : QN) + cid_ * 8192 + (wl * 4 * 64 + lane) * 8; \
        const GAS bf16* a2_ = (w < 4 ? MMp : INp) + dc_ * 4096 + (wl * 2 * 64 + lane) * 8; \
        _Pragma("unroll") for (int kk = 0; kk < 4; ++kk) sA4[st][kk] = *(const GAS bf16x8*)(a4_ + kk * 512); \
        _Pragma("unroll") for (int kk = 0; kk < 2; ++kk) sA2[st][kk] = *(const GAS bf16x8*)(a2_ + kk * 512); \
        sgc[st] = *(const GAS f32x4*)(GC + dc_ * 64 + 16 * wl + q4 * 4); sgl[st] = GC[dc_ * 64 + (d == 0 ? 63 : 0)]; \
        svq[st] = *(const GAS v2u*)(VC + cid_ * 8192 + ((4 * wl + q4) * 128 + dv0 + r16) * 4); } while (0)
#pragma unroll
        for (int st0 = 0; st0 < NST - 1; ++st0) SC_LOAD(st0, st0);
        for (int n0 = 0; n0 < 128; n0 += NST) {
#pragma unroll
          for (int j = 0; j < NST; ++j) {
            const int n = n0 + j; if (n >= 128) break;
            {
            const f32x4 gcv = sgc[j]; const float gl = sgl[j];
            const int c = d == 0 ? n : 127 - n; const int t0 = b * SEQ + c * 64;
            if (w < 4) {
#pragma unroll
                for (int kk = 0; kk < 4; ++kk) *(LAS bf16x8*)(lds + SC_KI + (16 * wl + r16) * SC_KIP + (kk * 32 + 8 * q4) * 2) = sA4[j][kk]; }
            f32x4 ks[SC_CS];
#pragma unroll
            for (int cs = 0; cs < SC_CS; ++cs) { bf16x8 Bs[4];
#pragma unroll
              for (int kk = 0; kk < 4; ++kk) Bs[kk] = *(const LAS bf16x8*)(lds + SC_ST + cs * 4352 + r16 * 272 + kk * 64 + q4 * 16);
              f32x4 a = (f32x4){0.f, 0.f, 0.f, 0.f};
#pragma unroll
              for (int kk = 0; kk < 4; ++kk) a = mfma16(sA4[j][kk], Bs[kk], a);
              ks[cs] = a; }
            __builtin_amdgcn_sched_barrier(0);
            if (!(VAR & 4)) { const int np = n + NST - 1 < 128 ? n + NST - 1 : 127; SC_LOAD((j + NST - 1) % NST, np); }
            __builtin_amdgcn_sched_barrier(0);
            float eg[4];
#pragma unroll
            for (int r = 0; r < 4; ++r) eg[r] = __expf(gcv[r]);
            if (w < 4) {
#pragma unroll
                for (int cs = 0; cs < SC_CS; ++cs) { float rv[4];
#pragma unroll
                    for (int r = 0; r < 4; ++r) { const unsigned u = (r < 2) ? svq[j].x : svq[j].y; const float vv = (r & 1) ? __uint_as_float(u & 0xffff0000u) : __uint_as_float(u << 16); rv[r] = vv - eg[r] * ks[cs][r]; }
                    v2u o; o.x = pk2(rv[0], rv[1]); o.y = pk2(rv[2], rv[3]); *(LAS v2u*)(lds + SC_RT + cs * 2304 + r16 * 144 + (16 * wl + q4 * 4) * 2) = o; } }
            if (!(VAR & 2)) LBAR();
            if (w < 4) { float es[4];
#pragma unroll
                for (int r = 0; r < 4; ++r) es[r] = __expf(gl - gcv[r]);
#pragma unroll
                for (int cs = 0; cs < SC_CS; ++cs) { f32x4 vn = (f32x4){0.f, 0.f, 0.f, 0.f};
                    const bf16x8 Br0 = *(const LAS bf16x8*)(lds + SC_RT + cs * 2304 + r16 * 144 + q4 * 16), Br1 = *(const LAS bf16x8*)(lds + SC_RT + cs * 2304 + r16 * 144 + 64 + q4 * 16);
                    vn = mfma16(sA2[j][0], Br0, vn); vn = mfma16(sA2[j][1], Br1, vn);
                    v2u o; o.x = pk2(vn[0], vn[1]); o.y = pk2(vn[2], vn[3]); *(LAS v2u*)(lds + SC_VT + cs * 2304 + r16 * 144 + (16 * wl + q4 * 4) * 2) = o;
                    o.x = pk2(vn[0] * es[0], vn[1] * es[1]); o.y = pk2(vn[2] * es[2], vn[3] * es[3]); *(LAS v2u*)(lds + SC_VTS + cs * 2304 + r16 * 144 + (16 * wl + q4 * 4) * 2) = o; } }
            if (!(VAR & 2)) LBAR();
            if (w >= 4) { f32x4 o[SC_CS];
#pragma unroll
                for (int cs = 0; cs < SC_CS; ++cs) { f32x4 a;
#pragma unroll
                    for (int r = 0; r < 4; ++r) a[r] = eg[r] * ks[cs][r];
                    const bf16x8 Bv0 = *(const LAS bf16x8*)(lds + SC_VT + cs * 2304 + r16 * 144 + q4 * 16), Bv1 = *(const LAS bf16x8*)(lds + SC_VT + cs * 2304 + r16 * 144 + 64 + q4 * 16);
                    a = mfma16(sA2[j][0], Bv0, a); a = mfma16(sA2[j][1], Bv1, a); o[cs] = a; }
                if (!(VAR & 1)) {
#pragma unroll
                    for (int r = 0; r < 4; ++r) { GAS bf16* op = Og + (size_t)(t0 + 16 * wl + q4 * 4 + r) * 512 + h * 128 + dv0 + SC_CS * r16;
                        if (SC_CS == 4) { v2u ov; ov.x = pk2(o[0][r], o[1][r]); ov.y = pk2(o[SC_CS - 2][r], o[SC_CS - 1][r]); asm volatile("global_store_dwordx2 %0, %1, off" :: "v"(op), "v"(ov) : "memory"); }
                        else if (SC_CS == 2) { const unsigned ov = pk2(o[0][r], o[SC_CS - 1][r]); asm volatile("global_store_dword %0, %1, off" :: "v"(op), "v"(ov) : "memory"); }
                        else { const unsigned ov = pk2(o[0][r], 0.f); asm volatile("global_store_short %0, %1, off" :: "v"(op), "v"(ov) : "memory"); } } } }
            { const float egl = __expf(gl);
              const LAS unsigned char* kip = lds + SC_KI + (8 * q4 + (r16 >> 2)) * SC_KIP + (16 * w + 4 * (r16 & 3)) * 2;
              const s16x4 ka0 = sc_tr(kip), ka1 = sc_tr(kip + 4 * SC_KIP), kb0 = sc_tr(kip + 32 * SC_KIP), kb1 = sc_tr(kip + 36 * SC_KIP);
              const bf16x8 kt0 = (bf16x8){ka0[0], ka0[1], ka0[2], ka0[3], ka1[0], ka1[1], ka1[2], ka1[3]}, kt1 = (bf16x8){kb0[0], kb0[1], kb0[2], kb0[3], kb1[0], kb1[1], kb1[2], kb1[3]};
#pragma unroll
              for (int cs = 0; cs < SC_CS; ++cs) { f32x4 sn = Sacc[cs] * egl;
                const bf16x8 Bvs0 = *(const LAS bf16x8*)(lds + SC_VTS + cs * 2304 + r16 * 144 + q4 * 16), Bvs1 = *(const LAS bf16x8*)(lds + SC_VTS + cs * 2304 + r16 * 144 + 64 + q4 * 16);
                sn = mfma16(kt0, Bvs0, sn); sn = mfma16(kt1, Bvs1, sn);
                Sacc[cs] = sn; v2u o; o.x = pk2(sn[0], sn[1]); o.y = pk2(sn[2], sn[3]); *(LAS v2u*)(lds + SC_ST + cs * 4352 + r16 * 272 + (16 * w + q4 * 4) * 2) = o; } }
            if (!(VAR & 2)) LBAR();
            }
          }
        }
#undef SC_LOAD
        __syncthreads();
    }
}

__device__ __forceinline__ int utid(const Frame& F) { int ln; asm volatile("v_mbcnt_lo_u32_b32 %0, -1, 0\n\tv_mbcnt_hi_u32_b32 %0, -1, %0" : "=v"(ln)); return F.wave * 64 + ln; }
__device__ __forceinline__ void attn_phase_all(Frame& F, int l, int ulo, int uhi, bool conv) {
    typedef attn_body::bf16 abf;
    abf* PP = (abf*)WSP(bf16, WS_PP); abf* OD = (abf*)WSP(bf16, WS_OD);
    const int slot = (F.vcu + (F.vcu >> 3)) & 7; int cnt = 0; bool pend = conv;
    for (int i = 0;; ++i) {
        const int L = ulo + i * F.G + F.vcu; if (L >= uhi || L >= 1024) break;
        if (pend && cnt == slot) { expert_convert(F, l); __syncthreads(); pend = false; } ++cnt;
        const int hd = L >> 5, qb = L & 31, b = hd >> 3, h = (hd >> 1) & 3, m = hd & 1; abf* base = PP + (size_t)b * SEQ * PPW;
        const float q2 = __uint_as_float(F.ctl[CW_NRM + 64 * l + b * 8 + (hd & 7)]), k2 = __uint_as_float(F.ctl[CW_NRM + 64 * l + 32 + b * 8 + (hd & 7)]);
        const float dbound = 1.01f * sqrtf(q2 * k2) + 0.25f;
        if (dbound <= 40.0f) attn_body::attn_unit<8, 4, true>(qb, base + PC_DQ + (h * 2 + m) * 64, base + PC_DK + (h * 2 + m) * 64, base + PC_DV + h * 128, OD + (size_t)b * SEQ * 1024 + m * 512 + h * 128, 1024, (char*)F.ldsg, utid(F), -dbound);
        else attn_body::attn_unit<8, 4, false>(qb, base + PC_DQ + (h * 2 + m) * 64, base + PC_DK + (h * 2 + m) * 64, base + PC_DV + h * 128, OD + (size_t)b * SEQ * 1024 + m * 512 + h * 128, 1024, (char*)F.ldsg, utid(F));
    }
    float sbound;
    { int lane; asm volatile("v_mbcnt_lo_u32_b32 %0, -1, 0\n\tv_mbcnt_hi_u32_b32 %0, -1, %0" : "=v"(lane)); const float wq = fabsf(((const GAS float*)INP(9))[l * 64 + lane]), wk = fabsf(((const GAS float*)INP(10))[l * 64 + lane]); float mq = wq, mk = wk;
#pragma unroll
      for (int o = 1; o < 64; o <<= 1) { mq = fmaxf(mq, SHFL_XOR(mq, o)); mk = fmaxf(mk, SHFL_XOR(mk, o)); }
      sbound = 1.02f * attn_body::C2 * 64.0f * mq * mk + 0.25f; }
    const bool fixref = sbound <= 40.0f;
    for (int i = 0;; ++i) {
        const int L = (ulo > 1024 ? ulo : 1024) + i * F.G + F.vcu; if (L >= uhi) break;
        if (pend && cnt == slot) { expert_convert(F, l); __syncthreads(); pend = false; } ++cnt;
        const int g = (L - 1024) >> 5, qb = L & 31, b = g >> 3, h = g & 7, kv = h >> 2; abf* base = PP + (size_t)b * SEQ * PPW;
        if (fixref) attn_body::attn_unit<8, 2, true>(qb, base + PC_CQ + h * 64, base + PC_CK + kv * 64, base + PC_CV + kv * 64, base + PC_CQ + h * 64, PPW, (char*)F.ldsg, utid(F), -sbound);
        else attn_body::attn_unit<8, 2, false>(qb, base + PC_CQ + h * 64, base + PC_CK + kv * 64, base + PC_CV + kv * 64, base + PC_CQ + h * 64, PPW, (char*)F.ldsg, utid(F));
    }
    if (pend) { expert_convert(F, l); __syncthreads(); }
}

__device__ __forceinline__ void post_phase(Frame& F, int l) {
    const int lane = F.lane; const int gw = F.vcu * NWAVES + F.wave, NGW = F.G * NWAVES;
    const float linit = (l == 0) ? 0.2f : 0.35550906759096926f;
    float lam;
    { const GAS float* lv = (const GAS float*)INP(7) + l * 256; const float sa = wave_sum(lv[lane] * lv[64 + lane], lane), sb = wave_sum(lv[128 + lane] * lv[192 + lane], lane); lam = expf(sa) - expf(sb) + linit; }
    float gnw[8], dnw[8];
#pragma unroll
    for (int e = 0; e < 8; ++e) { gnw[e] = ((const GAS float*)INP(6))[l * 128 + ((8 * lane) & 127) + e]; dnw[e] = ((const GAS float*)INP(8))[l * 128 + ((8 * lane) & 127) + e] * (1.0f - linit); }
    GAS bf16* PP = WSG(bf16, WS_PP); const GAS bf16* OF = WSG(bf16, WS_OF); const GAS bf16* OB = WSG(bf16, WS_OB); const GAS bf16* OD = WSG(bf16, WS_OD);
    for (int t0 = gw; t0 < TOK; t0 += 4 * NGW) {
        v4u la[4], lb[4], lz[4], lc[4], ld[4];
#pragma unroll
        for (int q = 0; q < 4; ++q) { const int t = t0 + q * NGW < TOK ? t0 + q * NGW : t0;
            la[q] = __builtin_nontemporal_load((const GAS v4u*)(OF + (size_t)t * 512 + 8 * lane)); lb[q] = __builtin_nontemporal_load((const GAS v4u*)(OB + (size_t)t * 512 + 8 * lane)); lz[q] = __builtin_nontemporal_load((const GAS v4u*)(PP + (size_t)t * PPW + PC_Z + 8 * lane));
            lc[q] = __builtin_nontemporal_load((const GAS v4u*)(OD + (size_t)t * 1024 + 8 * lane)); ld[q] = __builtin_nontemporal_load((const GAS v4u*)(OD + (size_t)t * 1024 + 512 + 8 * lane)); }
#pragma unroll
        for (int q = 0; q < 4; ++q) { const int t = t0 + q * NGW; if (t >= TOK) break;
        GAS bf16* prow = PP + (size_t)t * PPW;
        { float a[8], bb[8], z[8], o[8]; unpack8(la[q], a); unpack8(lb[q], bb); unpack8(lz[q], z);
          float ssq = 0.f;
#pragma unroll
          for (int e = 0; e < 8; ++e) { o[e] = a[e] + bb[e]; ssq += o[e] * o[e]; }
          ssq = row16_sum(ssq);
          const float rn = __builtin_amdgcn_rsqf(ssq * (1.0f / 128.0f) + EPS);
#pragma unroll
          for (int e = 0; e < 8; ++e) o[e] = o[e] * rn * gnw[e] * (z[e] * sigm(z[e]));
          *(GAS v4u*)(prow + PC_Z + 8 * lane) = pack8(o); }
        { float a[8], bb[8], o[8]; unpack8(lc[q], a); unpack8(ld[q], bb);
          float ssq = 0.f;
#pragma unroll
          for (int e = 0; e < 8; ++e) { o[e] = a[e] - lam * bb[e]; ssq += o[e] * o[e]; }
          ssq = row16_sum(ssq);
          const float rn = __builtin_amdgcn_rsqf(ssq * (1.0f / 128.0f) + EPS);
#pragma unroll
          for (int e = 0; e < 8; ++e) o[e] = o[e] * rn * dnw[e];
          *(GAS v4u*)(prow + PC_DQ + 8 * lane) = pack8(o); }
        }
    }
}

__device__ __forceinline__ int moe_tables(Frame& F, int l) {
    LAS int* tbase = (LAS int*)(F.lds + LDS_TBASE); LAS int* tilee = (LAS int*)(F.lds + LDS_TILEE);
    if (F.wave == 0) { const int lane = F.lane; const int cnt = lane < 32 ? (int)F.ctl[CW_CNT + 64 * l + lane] : 0; const int nt = (cnt + 255) >> 8; int inc = nt;
#pragma unroll
        for (int o = 1; o < 32; o <<= 1) { const int t = SHFL_UP(inc, o); if (lane >= o) inc += t; }
        const int tb = inc - nt;
        if (lane < 32) { tbase[lane] = tb; for (int k = 0; k < nt; ++k) if (tb + k < 320) tilee[tb + k] = lane; }
        if (lane == 31) tbase[32] = inc; }
    __syncthreads();
    int ntile = tbase[32]; if (ntile > 288) ntile = 288;
    return ntile;
}
struct MoeOrder {
    const LAS int* tilee; const LAS int* rowtab; int nunit, G, c; long estride;
    __device__ __forceinline__ bool next(int i, pg8::Unit& u) const { const long L = (long)i * G + c; if (L >= nunit) return false; u.pm = (int)(L >> 2); u.pn = (int)(L & 3); u.aoff = 0; u.boff = (long)tilee[u.pm] * estride; u.ord = i; return true; }
    __device__ __forceinline__ void a_ready(const pg8::Unit&) const {}
    __device__ __forceinline__ void done(const pg8::Unit&) const {}
    __device__ __forceinline__ int row(const pg8::Unit& u, int r) const { return rowtab[u.ord * 256 + r]; }
};
__device__ __forceinline__ void moe_build(Frame& F, int l, int nunit) {
    const LAS int* tbase = (const LAS int*)(F.lds + LDS_TBASE); const LAS int* tilee = (const LAS int*)(F.lds + LDS_TILEE);
    LAS int* rowtab = (LAS int*)(F.lds + LDS_ROWTAB); LAS float* rstab = (LAS float*)(F.lds + LDS_RSTAB); LAS float* wtab = (LAS float*)(F.lds + LDS_WTAB);
    const GAS int* tokl = WSG(int, WS_TOKL); const GAS float* wl = WSG(float, WS_WL); const GAS float* rstd2 = WSG(float, WS_RSTD2);
    for (int k = F.tid; k < 5 * 256; k += NWAVES * 64) { const int i = k >> 8, r = k & 255; const long L = (long)i * F.G + F.vcu;
        int tok = 0; float rs = 0.f, w = 0.f;
        if (L < nunit) { const int pm = (int)(L >> 2), e = tilee[pm], idx = (pm - tbase[e]) * 256 + r; const int cnt = (int)F.ctl[CW_CNT + 64 * l + e];
            if (idx < cnt) { tok = tokl[e * 32768 + idx]; rs = rstd2[tok]; w = wl[e * 32768 + idx]; } }
        rowtab[k] = tok; rstab[k] = rs; wtab[k] = w; }
    __syncthreads();
}
struct BrOrder {
    pg8::StaticOrder s;
    __device__ __forceinline__ bool next(int i, pg8::Unit& u) const { if (!s.next(i, u)) return false; const int br = u.pn >> 2; u.aoff = (br == 0 ? PC_Z : (br == 1 ? PC_DQ : PC_CQ)) * 2; return true; }
    __device__ __forceinline__ void a_ready(const pg8::Unit&) const {}
    __device__ __forceinline__ void done(const pg8::Unit&) const {}
};
struct GateOrder {
    pg8::StaticOrder s;
    __device__ __forceinline__ bool next(int i, pg8::Unit& u) const { if (!s.next(i / 3, u)) return false; u.pn += 4 * (i % 3); return true; }
    __device__ __forceinline__ void a_ready(const pg8::Unit&) const {}
    __device__ __forceinline__ void done(const pg8::Unit&) const {}
};
__device__ __forceinline__ void final_phase(Frame& F) {
    const int lane = F.lane; const int gw = F.vcu * NWAVES + F.wave, NGW = F.G * NWAVES;
    const float* rs = WSP(float, WS_RSTDF); const float* fw = INP(23);
    f32x4 wv[4];
#pragma unroll
    for (int j = 0; j < 4; ++j) wv[j] = *(const f32x4*)(fw + 256 * j + 4 * lane);
    for (int t = gw; t < TOK; t += NGW) { const float r = rs[t]; f32x4* o = (f32x4*)(F.out + (size_t)t * DM) + lane;
#pragma unroll
        for (int j = 0; j < 4; ++j) o[64 * j] = o[64 * j] * r * wv[j]; }
}

__global__ void __launch_bounds__(NWAVES * 64, 2) mk_fwd(Args args) {
    extern __shared__ __attribute__((aligned(16))) unsigned char lds[];
    Frame F;
    F.lds = (LAS unsigned char*)lds; F.ldsg = lds;
    F.MISC = (volatile LAS unsigned*)(F.lds + LDSCTL_OFF);
    F.tid = threadIdx.x; F.lane = F.tid & 63; F.wave = __builtin_amdgcn_readfirstlane(F.tid >> 6); const int wave0 = F.wave;
    F.G = gridDim.x; { const int bx = blockIdx.x; F.vcu = (F.G % 8 == 0) ? (bx % 8) * (F.G / 8) + bx / 8 : bx; }
    F.ws = args.ws; F.ctl = (gu32*)(args.ws + WS_CTL); F.out = args.out;
    F.A = (const __attribute__((address_space(4))) Args*)&args;
    for (int u = F.tid; u < (LDS_BYTES - LDSCTL_OFF) / 4; u += NWAVES * 64) ((LAS unsigned*)(F.lds + LDSCTL_OFF))[u] = 0u;
    __syncthreads();
    XcdBarrier bar; bar.bar = (unsigned*)(F.ctl + CW_BAR); bar.x = 0; bar.st = nullptr;
    if (!MK_SPLIT) bar = xcd_barrier_post((unsigned*)(F.ctl + CW_BAR), F.MISC + 8);
    const int lo = args.ph_lo, hi = args.ph_hi;
#ifndef PH_EN
#define PH_EN 0x3fffu
#endif
#define EN(j) ((PH_EN >> (j)) & 1u)
#ifndef REP_MASK
#define REP_MASK 0u
#endif
#define REPN(j) (1 + (int)((REP_MASK >> (j)) & 1u))
#define IN(k) (lo <= (k) && (k) < hi)
#define SEAM(k) do { if (IN((k) + 1)) xcd_barrier(bar); } while (0)
#define FRESH() do { int l_; asm volatile("v_mbcnt_lo_u32_b32 %0, -1, 0\n\tv_mbcnt_hi_u32_b32 %0, -1, %0" : "=v"(l_)); int wv_ = wave0; asm volatile("" : "+s"(wv_)); F.lane = l_; F.wave = wv_; F.tid = wv_ * 64 + l_;     \
    unsigned char* w_ = args.ws; float* o_ = args.out; unsigned char* lg_ = lds; asm volatile("" : "+s"(w_), "+s"(o_), "+s"(lg_)); F.ldsg = lg_; F.lds = (LAS unsigned char*)lg_; F.MISC = (volatile LAS unsigned*)(F.lds + LDSCTL_OFF); F.ws = w_; F.out = o_; F.ctl = (gu32*)(w_ + WS_CTL); } while (0)

    if (IN(0)) { FRESH(); for (int rep = 0; rep < REPN(13); ++rep) { p0_prologue(F); if (rep + 1 < REPN(13)) xcd_barrier(bar); } SEAM(0); }
    for (int l = 0; l < NLAYER; ++l) {
        const int pb = 1 + 12 * l;
        const float* rstd1 = WSP(float, WS_RSTD1);
        if (IN(pb + 0) && EN(0)) { FRESH(); if (l == 0) { for (int rep = 0; rep < REPN(0); ++rep) { norm_pass<0>(F, l); if (rep + 1 < REPN(0)) xcd_barrier(bar); } } else norm_pass<2>(F, l); SEAM(pb + 0); }
        if (IN(pb + 1) && EN(1)) { FRESH();
            pg8::Gemm g{WSP(bf16, WS_XB), WSP(bf16, WS_WIN) + (size_t)l * 4352 * 1024, TOK, 4352, 1024, 1024, 1024}; pg8::StaticOrder S; S.init(TOK, 4352, F.G, (int)blockIdx.x);
            pg8::EpiInproj E{WSP(bf16, WS_RAW), WSP(bf16, WS_PP), rstd1, WSP(float, WS_COS1), WSP(float, WS_SIN1), WSP(float, WS_AX), INP(9) + l * 64, INP(10) + l * 64, QSCALE, (unsigned*)(F.ctl + CW_NRM + 64 * l)};
            for (int rep = 0; rep < REPN(1); ++rep) { pg8::gemm_phase<pg8::EpiInproj, pg8::StaticOrder, true, true>(F.lds, g, S, E, F.tid); if (rep + 1 < REPN(1)) xcd_barrier(bar); }
            SEAM(pb + 1); }
        if (IN(pb + 2) && EN(2)) { FRESH();
#ifndef X_NOCHUNK
            FRESH();
            chunk_phase<0>(F, l);
#ifdef CHUNK_VAR
            xcd_barrier(bar); FRESH(); chunk_phase<CHUNK_VAR>(F, l);
#endif
#endif
            SEAM(pb + 2); }
        if (IN(pb + 3) && EN(3)) { FRESH(); scan_phase<0>(F);
#ifdef SCAN_VAR
            xcd_barrier(bar); scan_phase<SCAN_VAR>(F);
#endif
            SEAM(pb + 3); }
        if (IN(pb + 4) && EN(4)) { FRESH(); for (int rep = 0; rep < REPN(4); ++rep) { attn_phase_all(F, l, 0, rep == 0 ? 2048 : 1024, rep == 0); if (rep + 1 < REPN(4)) xcd_barrier(bar); } SEAM(pb + 4); }
        if (IN(pb + 5) && EN(5)) { FRESH(); post_phase(F, l); SEAM(pb + 5); }
        if (IN(pb + 6) && EN(6)) { FRESH();
            pg8::Gemm g{WSP(bf16, WS_PP), WSP(bf16, WS_WBR) + (size_t)l * 3072 * 512, TOK, 3072, 512, PPW, 512}; BrOrder S; S.s.init(TOK, 3072, F.G, (int)blockIdx.x);
            pg8::EpiBrTM E{WSP(bf16, WS_YBR)};
            for (int rep = 0; rep < REPN(6); ++rep) { pg8::gemm_phase<pg8::EpiBrTM, BrOrder, true, true>(F.lds, g, S, E, F.tid); if (rep + 1 < REPN(6)) xcd_barrier(bar); }
            SEAM(pb + 6); }
        if (IN(pb + 7) && EN(7)) { FRESH();
            pg8::Gemm g{WSP(bf16, WS_XB), WSP(bf16, WS_WG) + (size_t)l * 3072 * 1024, TOK, 3072, 1024, 1024, 1024}; GateOrder S; S.s.init(TOK, 1024, F.G, (int)blockIdx.x);
            pg8::EpiGate E{WSP(bf16, WS_YBR), WSP(bf16, WS_MG), rstd1, WSP(bf16, WS_MGT)};
            for (int rep = 0; rep < REPN(7); ++rep) { pg8::gemm_phase<pg8::EpiGate, GateOrder, true, true>(F.lds, g, S, E, F.tid); if (rep + 1 < REPN(7)) xcd_barrier(bar); }
            SEAM(pb + 7); }
        if (IN(pb + 8) && EN(8)) { FRESH();
            pg8::Gemm g{WSP(bf16, WS_MG), WSP(bf16, WS_WO3) + (size_t)l * 1024 * 1024, TOK, 1024, 1024, 1024, 1024}; pg8::StaticOrder S; S.init(TOK, 1024, F.G, (int)blockIdx.x);
            pg8::EpiResidB E{WSP(bf16, WS_XB), DM};
            pg8::gemm_phase<pg8::EpiResidB, pg8::StaticOrder, true, true>(F.lds, g, S, E, F.tid);
            SEAM(pb + 8); }
        if (IN(pb + 9) && EN(9)) { FRESH(); norm_pass<1>(F, l); SEAM(pb + 9); }
        if (IN(pb + 10) && EN(10)) { FRESH();
            const int ntile = moe_tables(F, l); moe_build(F, l, ntile * 4);
            pg8::Gemm g{WSP(bf16, WS_XB), WSP(bf16, WS_W13T), ntile * 256, 1024, 1024, 1024, 1024}; MoeOrder S{(const LAS int*)(F.lds + LDS_TILEE), (const LAS int*)(F.lds + LDS_ROWTAB), ntile * 4, F.G, F.vcu, (long)1024 * 1024 * 2};
            pg8::EpiMoe1 E{WSP(bf16, WS_HH), (const LAS float*)(F.lds + LDS_RSTAB)};
            for (int rep = 0; rep < REPN(11); ++rep) { pg8::gemm_phase<pg8::EpiMoe1, MoeOrder, true, true, true>(F.lds, g, S, E, F.tid); if (rep + 1 < REPN(11)) xcd_barrier(bar); }
            SEAM(pb + 10); }
        if (IN(pb + 11) && EN(11)) { FRESH();
            if (MK_SPLIT) { const int nt_ = moe_tables(F, l); moe_build(F, l, nt_ * 4); }
            int ntile = ((const LAS int*)(F.lds + LDS_TBASE))[32]; if (ntile > 288) ntile = 288;
            pg8::Gemm g{WSP(bf16, WS_HH), WSP(bf16, WS_W2T), ntile * 256, 1024, 512, 512, 512}; MoeOrder S{(const LAS int*)(F.lds + LDS_TILEE), (const LAS int*)(F.lds + LDS_ROWTAB), ntile * 4, F.G, F.vcu, (long)1024 * 512 * 2};
            pg8::EpiMoe2 E{WSP(bf16, WS_XG), (const LAS float*)(F.lds + LDS_WTAB)};
            for (int rep = 0; rep < REPN(12); ++rep) { pg8::gemm_phase<pg8::EpiMoe2, MoeOrder, true, true>(F.lds, g, S, E, F.tid); if (rep + 1 < REPN(12)) xcd_barrier(bar); }
            SEAM(pb + 11); }
    }
#ifdef EXTRA_BARS
    for (int eb = 0; eb < EXTRA_BARS; ++eb) xcd_barrier(bar);
#endif
    if (IN(25)) { FRESH(); norm_pass<3>(F, 0); }
#undef IN
#undef SEAM
}

#ifdef DBG_STOP
#ifndef DBG_KIND
#define DBG_KIND 0
#endif
#ifndef DBG_OFF
#define DBG_OFF 0
#endif
__global__ void dbg_dump(const unsigned char* ws, float* out, int n) {
    for (int i = blockIdx.x * blockDim.x + threadIdx.x; i < n; i += gridDim.x * blockDim.x) {
        if (DBG_KIND == 1) out[i] = bf2f(((const bf16*)(ws + (size_t)DBG_OFF * MiB))[i]);
        if (DBG_KIND == 2) out[i] = ((const float*)(ws + (size_t)DBG_OFF * MiB))[i];
        if (DBG_KIND == 3) out[i] = (float)((const int*)(ws + (size_t)DBG_OFF * MiB))[i];
        if (DBG_KIND == 4) { const float v = out[i] * 65536.0f; out[i] = v - floorf(v); }
        if (DBG_KIND == 5) out[i] = (float)(((const bf16*)(ws + (size_t)DBG_OFF * MiB))[i] & 0xffu);
        if (DBG_KIND == 6) { const float v = ((const float*)(ws + (size_t)DBG_OFF * MiB))[i] * 65536.0f; out[i] = v - floorf(v); }
    }
}
#endif
extern "C" void kernel_launch(void* const* d_in, const int* in_sizes, int n_in, void* d_out, int out_size, void* d_ws, size_t ws_size, hipStream_t stream) {
    static int grid = 0;
    if (grid == 0) {
        if (n_in != 24 || out_size != TOK * DM || ws_size < WS_END) { fprintf(stderr, "kernel_launch: unexpected sizes (n_in %d out %d ws %zu)\n", n_in, out_size, ws_size); grid = -1; return; }
        int dev = 0, cus = 0, per_cu = 0;
        if (hipGetDevice(&dev) != hipSuccess || hipDeviceGetAttribute(&cus, hipDeviceAttributeMultiprocessorCount, dev) != hipSuccess) { grid = -1; return; }
        if (hipFuncSetAttribute((const void*)mk_fwd, hipFuncAttributeMaxDynamicSharedMemorySize, LDS_BYTES) != hipSuccess) { fprintf(stderr, "kernel_launch: hipFuncSetAttribute failed\n"); grid = -1; return; }
        if (hipOccupancyMaxActiveBlocksPerMultiprocessor(&per_cu, (const void*)mk_fwd, NWAVES * 64, LDS_BYTES) != hipSuccess || per_cu < 1) { fprintf(stderr, "kernel_launch: occupancy query says %d\n", per_cu); }
        (void)hipGetLastError();
        grid = cus;
    }
    if (grid < 0) return;
    if (hipMemsetAsync((char*)d_ws + WS_CTL, 0, CTL_ZERO_BYTES, stream) != hipSuccess) return;
    Args a{};
    for (int i = 0; i < 24; ++i) a.in[i] = (const float*)d_in[i];
    a.out = (float*)d_out; a.ws = (unsigned char*)d_ws;
#if MK_SPLIT
#ifdef DBG_STOP
    for (int p = 0; p <= DBG_STOP; ++p) { a.ph_lo = p; a.ph_hi = p + 1; hipLaunchKernelGGL(mk_fwd, dim3(grid), dim3(NWAVES * 64), LDS_BYTES, stream, a); }
    if (DBG_KIND != 0) hipLaunchKernelGGL(dbg_dump, dim3(2048), dim3(256), 0, stream, (const unsigned char*)d_ws, (float*)d_out, DBG_N);
#else
    for (int p = 0; p < NPH; ++p) { a.ph_lo = p; a.ph_hi = p + 1; hipLaunchKernelGGL(mk_fwd, dim3(grid), dim3(NWAVES * 64), LDS_BYTES, stream, a); }
#endif
#else
    a.ph_lo = 0; a.ph_hi = NPH;
    hipLaunchKernelGGL(mk_fwd, dim3(grid), dim3(NWAVES * 64), LDS_BYTES, stream, a);
#endif
}
```

```cpp
#include <hip/hip_runtime.h>
#include <cstdio>
#include <cstdint>
#include <utility>
#ifndef DBG_N
#define DBG_N (32768 * 1024)
#endif
namespace pg8 {
#define PG8_LAS __attribute__((address_space(3)))
typedef unsigned short bf16_t;
typedef short bf16x8 __attribute__((ext_vector_type(8)));
typedef float f32x4 __attribute__((ext_vector_type(4)));
typedef unsigned u32x4 __attribute__((ext_vector_type(4)));
constexpr int BM = 256, BK = 64, HALF = 128, HTB = HALF * BK * 2  , STAGE_BYTES = 8 * HTB, NXCD = 8, WGM = 8;

__host__ __device__ __forceinline__ int lds_byte(int r, int c) { const int st = (r >> 4) * 2 + (c >> 5), rr = r & 15, cc = c & 31, ob = rr * 64 + cc * 2; return st * 1024 + (ob ^ (((ob >> 9) & 1) << 5)); }
__host__ __device__ __forceinline__ void stage_rc(int b, int& R, int& C) { const int st = b / 1024, sb = b % 1024, swz = sb ^ (((sb >> 9) & 1) << 5); R = (st >> 1) * 16 + swz / 64; C = (st & 1) * 32 + (swz % 64) / 2; }
__host__ __device__ __forceinline__ int perm32(int rho) { const int n = rho >> 4, i = rho & 15; return 8 * (i >> 2) + 4 * n + (i & 3); }

struct Unit { int pm, pn; long aoff, boff; int ord; };
struct Gemm { const bf16_t* A; const bf16_t* Bt; int M, N, K, lda, ldb; };

struct StaticOrder {
    int nM, nN, nwg, G, c;
    __host__ __device__ void init(int M, int N, int G_, int c_) { nM = M / BM; nN = N / BM; nwg = nM * nN; G = G_; c = c_; }
    __host__ __device__ bool next(int i, Unit& u) const {
        const long L = (long)i * G + c; if (L >= nwg) return false;
        int wgid = (int)L; { const int q = nwg / NXCD, r = nwg % NXCD, xcd = wgid % NXCD, off = wgid / NXCD; wgid = (xcd < r ? xcd * (q + 1) : r * (q + 1) + (xcd - r) * q) + off; }
        const int nig = WGM * nN, gid = wgid / nig, fm = gid * WGM, gsz = (nM - fm) < WGM ? (nM - fm) : WGM;
        u.pm = fm + ((wgid % nig) % gsz); u.pn = (wgid % nig) / gsz; u.aoff = 0; u.boff = 0; u.ord = i; return true;
    }
    __device__ __forceinline__ void a_ready(const Unit&) const {}
    __device__ __forceinline__ void done(const Unit&) const {}
    __device__ __forceinline__ int row(const Unit& u, int r) const { return u.pm * BM + r; }
};


#define PG8_GAS __attribute__((address_space(1)))
typedef float f32x2c_t __attribute__((ext_vector_type(2))); typedef __bf16 bf16x2c_t __attribute__((ext_vector_type(2)));
__device__ __forceinline__ unsigned cvt_pk_bf16(float lo, float hi) { const f32x2c_t v = {lo, hi}; const bf16x2c_t b = __builtin_convertvector(v, bf16x2c_t); return __builtin_bit_cast(unsigned, b); }
__device__ __forceinline__ float bflo(unsigned w) { return __uint_as_float(w << 16); }
__device__ __forceinline__ float bfhi(unsigned w) { return __uint_as_float(w & 0xffff0000u); }
__device__ __forceinline__ float sigmoidf_(float x) { return __builtin_amdgcn_rcpf(1.0f + __expf(-x)); }

struct EpiInproj {
    static constexpr bool PERM = true, AFTER_DRAIN = false;
    bf16_t* raw; bf16_t* pp; const float* rstd; const float* cos1; const float* sin1; const float* ax; const float* qnw; const float* knw; float qscale;
    unsigned* nrm;
    __device__ __forceinline__ void operator()(const f32x4 (&acc)[2][2][4][2], const Unit& u, int wr, int wc, int fr, int fq) const {
        const int row0 = u.pm * BM + wr * 64 + fr;
        const int pt = u.pn - 6;
        float rsv[2][4];
#pragma unroll
        for (int ai = 0; ai < 2; ++ai)
#pragma unroll
            for (int m = 0; m < 4; ++m) rsv[ai][m] = ((const PG8_GAS float*)rstd)[row0 + ai * HALF + m * 16];
        const bool perm = (pt >= 2 && pt <= 5) || (pt >= 8);
        if (!perm) {
            bf16_t* base; int ldc, colt;
            if (u.pn < 6) { base = raw; ldc = 1536; colt = u.pn * 256; } else { base = pp; ldc = 2816; colt = pt * 256; }
            const int col0 = colt + wc * 32 + 8 * fq;
#pragma unroll
            for (int ai = 0; ai < 2; ++ai)
#pragma unroll
                for (int m = 0; m < 4; ++m) { const int row = row0 + ai * HALF + m * 16; const float s = rsv[ai][m]; bf16_t* rowp = base + (size_t)row * ldc + col0;
#pragma unroll
                    for (int bj = 0; bj < 2; ++bj) { const f32x4 v0 = acc[ai][bj][m][0] * s, v1 = acc[ai][bj][m][1] * s;
                        u32x4 w; w.x = cvt_pk_bf16(v0[0], v0[1]); w.y = cvt_pk_bf16(v0[2], v0[3]); w.z = cvt_pk_bf16(v1[0], v1[1]); w.w = cvt_pk_bf16(v1[2], v1[3]);
                        *(PG8_GAS u32x4*)(rowp + bj * HALF) = w; } }
            return;
        }
        const int kind = (pt <= 3) ? 0 : (pt <= 5) ? 1 : (pt <= 9) ? 2 : (wc < 2 ? 3 : 4);
        const int col0 = pt * 256 + wc * 64 + 8 * fq;
        const int lane = fq * 16 + fr;
        float nw0[8], nw1[8]; float nmax = 0.f;
        if (kind == 2 || kind == 3) { const PG8_GAS float* nwp = (const PG8_GAS float*)(kind == 2 ? qnw : knw) + 8 * fq;
#pragma unroll
            for (int j = 0; j < 8; ++j) { nw0[j] = nwp[j]; nw1[j] = nwp[32 + j]; } }
#pragma unroll
        for (int ai = 0; ai < 2; ++ai)
#pragma unroll
            for (int m = 0; m < 4; ++m) { const int row = row0 + ai * HALF + m * 16; const float s = rsv[ai][m]; const int sp = row & 8191;
                float x0[8], x1[8];
#pragma unroll
                for (int n = 0; n < 2; ++n)
#pragma unroll
                    for (int e2 = 0; e2 < 4; ++e2) { x0[4 * n + e2] = acc[ai][0][m][n][e2] * s; x1[4 * n + e2] = acc[ai][1][m][n][e2] * s; }
                if (kind <= 1) {
                    int fqo = fq; asm volatile("" : "+v"(fqo));
                    const PG8_GAS f32x4* cp = (const PG8_GAS f32x4*)(cos1 + sp * 32 + 8 * fqo); const PG8_GAS f32x4* snp = (const PG8_GAS f32x4*)(sin1 + sp * 32 + 8 * fqo);
                    const f32x4 c0 = cp[0], c1 = cp[1], s0 = snp[0], s1 = snp[1];
#pragma unroll
                    for (int j = 0; j < 8; ++j) { const float c = j < 4 ? c0[j & 3] : c1[j & 3], sn = j < 4 ? s0[j & 3] : s1[j & 3]; const float a = x0[j], b = x1[j];
                        x0[j] = a * c - b * sn; x1[j] = b * c + a * sn; if (kind == 0) { x0[j] *= qscale; x1[j] *= qscale; } }
                    float ssn = 0.f;
#pragma unroll
                    for (int j = 0; j < 8; ++j) { ssn = __builtin_fmaf(x0[j], x0[j], ssn); ssn = __builtin_fmaf(x1[j], x1[j], ssn); }
                    ssn += __int_as_float(__builtin_amdgcn_ds_bpermute((lane ^ 16) << 2, __float_as_int(ssn)));
                    ssn += __int_as_float(__builtin_amdgcn_ds_bpermute((lane ^ 32) << 2, __float_as_int(ssn)));
                    nmax = fmaxf(nmax, ssn);
                } else if (kind <= 3) {
                    float ss = 0.f;
#pragma unroll
                    for (int j = 0; j < 8; ++j) ss += x0[j] * x0[j] + x1[j] * x1[j];
                    ss += __int_as_float(__builtin_amdgcn_ds_bpermute((lane ^ 16) << 2, __float_as_int(ss)));
                    ss += __int_as_float(__builtin_amdgcn_ds_bpermute((lane ^ 32) << 2, __float_as_int(ss)));
                    const float rn = __builtin_amdgcn_rsqf(ss * (1.0f / 64.0f) + 1e-6f);
                    const PG8_GAS float* tr = (const PG8_GAS float*)ax + (sp >> 6) * 16 + 8 * (fq & 1); const PG8_GAS float* tc = (const PG8_GAS float*)ax + 4096 + (sp & 63) * 16 + 8 * (fq & 1);
                    const f32x4 cr0 = *(const PG8_GAS f32x4*)tr, cr1 = *(const PG8_GAS f32x4*)(tr + 4), sr0 = *(const PG8_GAS f32x4*)(tr + 2048), sr1 = *(const PG8_GAS f32x4*)(tr + 2052);
                    const f32x4 cc0 = *(const PG8_GAS f32x4*)tc, cc1 = *(const PG8_GAS f32x4*)(tc + 4), sc0 = *(const PG8_GAS f32x4*)(tc + 1024), sc1 = *(const PG8_GAS f32x4*)(tc + 1028);
#pragma unroll
                    for (int j = 0; j < 8; ++j) { const float y0 = x0[j] * rn * nw0[j], y1 = x1[j] * rn * nw1[j];
                        const float p0 = __int_as_float(__builtin_amdgcn_ds_bpermute((lane ^ 32) << 2, __float_as_int(y0))), p1 = __int_as_float(__builtin_amdgcn_ds_bpermute((lane ^ 32) << 2, __float_as_int(y1)));
                        const float cr = j < 4 ? cr0[j & 3] : cr1[j & 3], sr = j < 4 ? sr0[j & 3] : sr1[j & 3], cc = j < 4 ? cc0[j & 3] : cc1[j & 3], sc = j < 4 ? sc0[j & 3] : sc1[j & 3];
                        float o0 = (fq < 2) ? y0 * cr - p0 * sr : y0 * cr + p0 * sr, o1 = (fq < 2) ? y1 * cc - p1 * sc : y1 * cc + p1 * sc;
                        if (kind == 2) { o0 *= qscale; o1 *= qscale; }
                        x0[j] = o0; x1[j] = o1; }
                }
                bf16_t* rowp = pp + (size_t)row * 2816 + col0;
                u32x4 w; w.x = cvt_pk_bf16(x0[0], x0[1]); w.y = cvt_pk_bf16(x0[2], x0[3]); w.z = cvt_pk_bf16(x0[4], x0[5]); w.w = cvt_pk_bf16(x0[6], x0[7]);
                *(PG8_GAS u32x4*)rowp = w;
                w.x = cvt_pk_bf16(x1[0], x1[1]); w.y = cvt_pk_bf16(x1[2], x1[3]); w.z = cvt_pk_bf16(x1[4], x1[5]); w.w = cvt_pk_bf16(x1[6], x1[7]);
                *(PG8_GAS u32x4*)(rowp + 32) = w; }
        if (kind <= 1) {
#pragma unroll
            for (int o = 1; o < 16; o <<= 1) nmax = fmaxf(nmax, __int_as_float(__builtin_amdgcn_ds_bpermute((lane ^ o) << 2, __float_as_int(nmax))));
            if (lane == 0) __hip_atomic_fetch_max((PG8_GAS unsigned*)nrm + kind * 32 + ((u.pm * BM) >> 13) * 8 + (pt - (kind == 0 ? 2 : 4)) * 4 + wc, __float_as_uint(nmax), __ATOMIC_RELAXED, __HIP_MEMORY_SCOPE_AGENT);
        }
    }
};
struct EpiBf16Row {
    static constexpr bool PERM = true, AFTER_DRAIN = false;
    bf16_t* O; int ldc; const float* rs;
    __device__ __forceinline__ void operator()(const f32x4 (&acc)[2][2][4][2], const Unit& u, int wr, int wc, int fr, int fq) const {
        const int row0 = u.pm * BM + wr * 64 + fr; const int col0 = u.pn * BM + wc * 32 + 8 * fq;
        float rsv[2][4];
#pragma unroll
        for (int ai = 0; ai < 2; ++ai)
#pragma unroll
            for (int m = 0; m < 4; ++m) rsv[ai][m] = rs ? ((const PG8_GAS float*)rs)[row0 + ai * HALF + m * 16] : 1.0f;
#pragma unroll
        for (int ai = 0; ai < 2; ++ai)
#pragma unroll
            for (int m = 0; m < 4; ++m) { const int row = row0 + ai * HALF + m * 16; const float s = rsv[ai][m]; bf16_t* rowp = O + (size_t)row * ldc + col0;
#pragma unroll
                for (int bj = 0; bj < 2; ++bj) { const f32x4 v0 = acc[ai][bj][m][0] * s, v1 = acc[ai][bj][m][1] * s;
                    u32x4 w; w.x = cvt_pk_bf16(v0[0], v0[1]); w.y = cvt_pk_bf16(v0[2], v0[3]); w.z = cvt_pk_bf16(v1[0], v1[1]); w.w = cvt_pk_bf16(v1[2], v1[3]);
                    *(PG8_GAS u32x4*)(rowp + bj * HALF) = w; } }
    }
};
struct EpiBrTM {
    static constexpr bool PERM = true, AFTER_DRAIN = false;
    bf16_t* O;
    __device__ __forceinline__ void operator()(const f32x4 (&acc)[2][2][4][2], const Unit& u, int wr, int wc, int fr, int fq) const {
        bf16_t* tp = O + (size_t)(u.pm * 12 + u.pn) * 65536 + (size_t)(((wr * 4 + wc) * 64 + fq * 16 + fr) * 8);
#pragma unroll
        for (int ai = 0; ai < 2; ++ai)
#pragma unroll
            for (int m = 0; m < 4; ++m)
#pragma unroll
                for (int bj = 0; bj < 2; ++bj) { const f32x4 v0 = acc[ai][bj][m][0], v1 = acc[ai][bj][m][1];
                    u32x4 w; w.x = cvt_pk_bf16(v0[0], v0[1]); w.y = cvt_pk_bf16(v0[2], v0[3]); w.z = cvt_pk_bf16(v1[0], v1[1]); w.w = cvt_pk_bf16(v1[2], v1[3]);
                    *(PG8_GAS u32x4*)(tp + ((ai * 4 + m) * 2 + bj) * 4096) = w; }
    }
};
struct EpiGate {
    static constexpr bool PERM = true, AFTER_DRAIN = false;
    const bf16_t* Y; bf16_t* MG; const float* rstd; bf16_t* MT;
    __device__ __forceinline__ void operator()(const f32x4 (&acc)[2][2][4][2], const Unit& u, int wr, int wc, int fr, int fq) const {
        const int br = u.pn >> 2, cb = u.pn & 3;
        const size_t tmo = (size_t)(((wr * 4 + wc) * 64 + fq * 16 + fr) * 8); const bf16_t* yt = Y + (size_t)(u.pm * 12 + u.pn) * 65536 + tmo; bf16_t* mt = MT + (size_t)(u.pm * 4 + cb) * 65536 + tmo;
        const int row0 = u.pm * BM + wr * 64 + fr; const int ycol0 = u.pn * BM + wc * 32 + 8 * fq, mcol0 = cb * BM + wc * 32 + 8 * fq;
#pragma unroll
        for (int ai = 0; ai < 2; ++ai) {
            u32x4 yv[4][2], ov[4][2]; float sv[4];
#pragma unroll
            for (int m = 0; m < 4; ++m) { const int row = row0 + ai * HALF + m * 16; sv[m] = ((const PG8_GAS float*)rstd)[row];
#pragma unroll
                for (int bj = 0; bj < 2; ++bj) { yv[m][bj] = *(const PG8_GAS u32x4*)(yt + ((ai * 4 + m) * 2 + bj) * 4096);
                    if (br != 0) ov[m][bj] = *(const PG8_GAS u32x4*)(mt + ((ai * 4 + m) * 2 + bj) * 4096); else ov[m][bj] = (u32x4){0u, 0u, 0u, 0u}; } }
#pragma unroll
            for (int m = 0; m < 4; ++m) { const int row = row0 + ai * HALF + m * 16; const float s = sv[m];
#pragma unroll
                for (int bj = 0; bj < 2; ++bj) { const f32x4 v0 = acc[ai][bj][m][0] * s, v1 = acc[ai][bj][m][1] * s; const u32x4 y = yv[m][bj], o = ov[m][bj];
                    u32x4 w;
                    w.x = cvt_pk_bf16(sigmoidf_(v0[0]) * bflo(y.x) + bflo(o.x), sigmoidf_(v0[1]) * bfhi(y.x) + bfhi(o.x));
                    w.y = cvt_pk_bf16(sigmoidf_(v0[2]) * bflo(y.y) + bflo(o.y), sigmoidf_(v0[3]) * bfhi(y.y) + bfhi(o.y));
                    w.z = cvt_pk_bf16(sigmoidf_(v1[0]) * bflo(y.z) + bflo(o.z), sigmoidf_(v1[1]) * bfhi(y.z) + bfhi(o.z));
                    w.w = cvt_pk_bf16(sigmoidf_(v1[2]) * bflo(y.w) + bflo(o.w), sigmoidf_(v1[3]) * bfhi(y.w) + bfhi(o.w));
                    if (br == 2) *(PG8_GAS u32x4*)(MG + (size_t)row * 1024 + mcol0 + bj * HALF) = w; else *(PG8_GAS u32x4*)(mt + ((ai * 4 + m) * 2 + bj) * 4096) = w; } }
        }
    }
};
struct EpiResid {
    static constexpr bool PERM = false, AFTER_DRAIN = false;
    const float* src; float* out; int ldc;
    __device__ __forceinline__ void operator()(const f32x4 (&acc)[2][2][4][2], const Unit& u, int wr, int wc, int fr, int fq) const {
        const int col0 = u.pn * BM + wc * 32 + 4 * fq;
#pragma unroll
        for (int ai = 0; ai < 2; ++ai) { f32x4 bs[4][2][2];
#pragma unroll
            for (int m = 0; m < 4; ++m) { const size_t off = (size_t)(u.pm * BM + ai * HALF + wr * 64 + m * 16 + fr) * ldc + col0;
#pragma unroll
                for (int bj = 0; bj < 2; ++bj)
#pragma unroll
                    for (int n = 0; n < 2; ++n) bs[m][bj][n] = *(const PG8_GAS f32x4*)(src + off + bj * HALF + n * 16); }
#pragma unroll
            for (int m = 0; m < 4; ++m) { const size_t off = (size_t)(u.pm * BM + ai * HALF + wr * 64 + m * 16 + fr) * ldc + col0;
#pragma unroll
                for (int bj = 0; bj < 2; ++bj)
#pragma unroll
                    for (int n = 0; n < 2; ++n) *(PG8_GAS f32x4*)(out + off + bj * HALF + n * 16) = bs[m][bj][n] + acc[ai][bj][m][n]; } }
    }
};
struct EpiResidB {
    static constexpr bool PERM = true, AFTER_DRAIN = false;
    bf16_t* X; int ldc;
    __device__ __forceinline__ void operator()(const f32x4 (&acc)[2][2][4][2], const Unit& u, int wr, int wc, int fr, int fq) const {
        const int row0 = u.pm * BM + wr * 64 + fr; const int col0 = u.pn * BM + wc * 32 + 8 * fq;
#pragma unroll
        for (int ai = 0; ai < 2; ++ai) { u32x4 xs[4][2];
#pragma unroll
            for (int m = 0; m < 4; ++m)
#pragma unroll
                for (int bj = 0; bj < 2; ++bj) xs[m][bj] = *(const PG8_GAS u32x4*)(X + (size_t)(row0 + ai * HALF + m * 16) * ldc + col0 + bj * HALF);
#pragma unroll
            for (int m = 0; m < 4; ++m)
#pragma unroll
                for (int bj = 0; bj < 2; ++bj) { const f32x4 v0 = acc[ai][bj][m][0], v1 = acc[ai][bj][m][1]; const u32x4 a = xs[m][bj];
                    u32x4 w; w.x = cvt_pk_bf16(__uint_as_float(a.x << 16) + v0[0], __uint_as_float(a.x & 0xffff0000u) + v0[1]); w.y = cvt_pk_bf16(__uint_as_float(a.y << 16) + v0[2], __uint_as_float(a.y & 0xffff0000u) + v0[3]);
                    w.z = cvt_pk_bf16(__uint_as_float(a.z << 16) + v1[0], __uint_as_float(a.z & 0xffff0000u) + v1[1]); w.w = cvt_pk_bf16(__uint_as_float(a.w << 16) + v1[2], __uint_as_float(a.w & 0xffff0000u) + v1[3]);
                    *(PG8_GAS u32x4*)(X + (size_t)(row0 + ai * HALF + m * 16) * ldc + col0 + bj * HALF) = w; } }
    }
};
struct EpiMoe1 {
    static constexpr bool PERM = true, AFTER_DRAIN = false;
    bf16_t* H; const PG8_LAS float* rs;
    __device__ __forceinline__ void operator()(const f32x4 (&acc)[2][2][4][2], const Unit& u, int wr, int wc, int fr, int fq) const {
        const int lrow0 = wr * 64 + fr; const int col0 = u.pn * HALF + wc * 32 + 8 * fq;
#pragma unroll
        for (int ai = 0; ai < 2; ++ai)
#pragma unroll
            for (int m = 0; m < 4; ++m) { const int lrow = lrow0 + ai * HALF + m * 16; const float s = rs[u.ord * BM + lrow];
                float h[8];
#pragma unroll
                for (int n = 0; n < 2; ++n)
#pragma unroll
                    for (int e = 0; e < 4; ++e) { const float g = acc[ai][0][m][n][e] * s, uu = acc[ai][1][m][n][e] * s; h[n * 4 + e] = g * sigmoidf_(g) * uu; }
                u32x4 w; w.x = cvt_pk_bf16(h[0], h[1]); w.y = cvt_pk_bf16(h[2], h[3]); w.z = cvt_pk_bf16(h[4], h[5]); w.w = cvt_pk_bf16(h[6], h[7]);
                *(PG8_GAS u32x4*)(H + (size_t)(u.pm * BM + lrow) * 512 + col0) = w; }
    }
};
struct EpiMoe2 {
    static constexpr bool PERM = true, AFTER_DRAIN = false;
    bf16_t* O; const PG8_LAS float* ws;
    __device__ __forceinline__ void operator()(const f32x4 (&acc)[2][2][4][2], const Unit& u, int wr, int wc, int fr, int fq) const {
        const int lrow0 = wr * 64 + fr; const int col0 = u.pn * BM + wc * 32 + 8 * fq;
#pragma unroll
        for (int ai = 0; ai < 2; ++ai)
#pragma unroll
            for (int m = 0; m < 4; ++m) { const int lrow = lrow0 + ai * HALF + m * 16; const float s = ws[u.ord * BM + lrow]; bf16_t* rowp = O + (size_t)(u.pm * BM + lrow) * 1024 + col0;
#pragma unroll
                for (int bj = 0; bj < 2; ++bj) { const f32x4 v0 = acc[ai][bj][m][0] * s, v1 = acc[ai][bj][m][1] * s;
                    u32x4 w; w.x = cvt_pk_bf16(v0[0], v0[1]); w.y = cvt_pk_bf16(v0[2], v0[3]); w.z = cvt_pk_bf16(v1[0], v1[1]); w.w = cvt_pk_bf16(v1[2], v1[3]);
                    *(PG8_GAS u32x4*)(rowp + bj * HALF) = w; } }
    }
};
template <class Epi, class Sched, bool ALIGN_EPI = false, bool SP2 = false, bool GATHER = false>
__device__ __forceinline__ void gemm_phase(PG8_LAS unsigned char* lds, const Gemm g, const Sched& S, const Epi& E, const int tid_in) {
    int tid_o = tid_in; asm volatile("" : "+v"(tid_o));
    const int tid = tid_o, wid = __builtin_amdgcn_readfirstlane(tid >> 6), lane = tid & 63, wr = wid >> 2, wc = wid & 3, fr = lane & 15, fq = lane >> 4;
    const int K = g.K, nt = K / BK;
    static_assert(!GATHER || SP2, "GATHER is wired into the SP2 loop only");
    unsigned voffA[2], voffB[2]; int gR[2], gC[2];
#pragma unroll
    for (int i = 0; i < 2; ++i) { int R, C; stage_rc(tid * 16 + i * 8192, R, C); gR[i] = R; gC[i] = C; const int Rb = Epi::PERM ? ((R & ~31) + perm32(R & 31)) : R;
        voffA[i] = (unsigned)(R * g.lda + C) * 2u; voffB[i] = (unsigned)(Rb * g.ldb + C) * 2u; }
    const size_t kstep = (size_t)(BK * 2);
    const size_t hstepA = GATHER ? 0 : (size_t)HALF * g.lda * 2, hstepB = (size_t)HALF * g.ldb * 2;
    const size_t tstepA = GATHER ? 0 : 2 * hstepA, tstepB = 2 * hstepB;
    const unsigned ldsw = (unsigned)wid * 1024u;
    const int aoff = lds_byte(wr * 64 + fr, fq * 8), boff = lds_byte(wc * 32 + fr, fq * 8);
#define PG8_SA(b, h) (((b) * 2 + (h)) * HTB)
#define PG8_SB(b, h) ((4 + (b) * 2 + (h)) * HTB)
#define PG8_STAGE(bufoff, gbase, voff) do { _Pragma("unroll") for (int _i = 0; _i < 2; ++_i) \
        __builtin_amdgcn_global_load_lds((const unsigned*)((const char*)(gbase) + (voff)[_i]), (PG8_LAS unsigned*)(lds + (bufoff) + ldsw + _i * 8192), 16, 0, 0); } while (0)
#define PG8_LDA(dst, b, h) do { _Pragma("unroll") for (int m = 0; m < 4; ++m) _Pragma("unroll") for (int k = 0; k < 2; ++k) dst[m][k] = *(const PG8_LAS bf16x8*)(lds + PG8_SA(b, h) + aoff + m * 2048 + k * 1024); } while (0)
#define PG8_LDB(dst, b, h) do { _Pragma("unroll") for (int n = 0; n < 2; ++n) _Pragma("unroll") for (int k = 0; k < 2; ++k) dst[n][k] = *(const PG8_LAS bf16x8*)(lds + PG8_SB(b, h) + boff + n * 2048 + k * 1024); } while (0)
#define PG8_MMA(ai, bj, At, Bt) do { __builtin_amdgcn_s_setprio(1); _Pragma("unroll") for (int m = 0; m < 4; ++m) _Pragma("unroll") for (int n = 0; n < 2; ++n) _Pragma("unroll") for (int k = 0; k < 2; ++k) \
        acc[ai][bj][m][n] = __builtin_amdgcn_mfma_f32_16x16x32_bf16(Bt[n][k], At[m][k], acc[ai][bj][m][n], 0, 0, 0); __builtin_amdgcn_s_setprio(0); } while (0)
#define PG8_WAIT_V(n) asm volatile("s_waitcnt vmcnt(" #n ")" ::: "memory")
#define PG8_WAIT_L(n) asm volatile("s_waitcnt lgkmcnt(" #n ")" ::: "memory")
#define PG8_BAR __builtin_amdgcn_s_barrier()
#define PG8_SCHED __builtin_amdgcn_sched_barrier(0)
    Unit cur, nxt; int ui = 0;
    if (!S.next(0, cur)) return;
    f32x4 acc[2][2][4][2];
#pragma unroll
    for (int a = 0; a < 2; ++a)
#pragma unroll
        for (int b = 0; b < 2; ++b)
#pragma unroll
            for (int m = 0; m < 4; ++m)
#pragma unroll
                for (int n = 0; n < 2; ++n) acc[a][b][m][n] = (f32x4){0.f, 0.f, 0.f, 0.f};
    bf16x8 At[4][2], B0[2][2], B1[2][2];
    const char* cA = (const char*)g.A + (size_t)cur.pm * tstepA + cur.aoff; const char* cB = (const char*)g.Bt + (size_t)cur.pn * tstepB + cur.boff;
    unsigned cv0[2], cv1[2], nv0[2], nv1[2];
#define PG8_SETOFF(d0, d1, u) do { _Pragma("unroll") for (int i_ = 0; i_ < 2; ++i_) { if constexpr (GATHER) { d0[i_] = (unsigned)S.row(u, gR[i_]) * (unsigned)(g.lda * 2) + (unsigned)gC[i_] * 2u; d1[i_] = (unsigned)S.row(u, HALF + gR[i_]) * (unsigned)(g.lda * 2) + (unsigned)gC[i_] * 2u; } else { d0[i_] = voffA[i_]; d1[i_] = voffA[i_]; } } } while (0)
    PG8_SETOFF(cv0, cv1, cur); PG8_SETOFF(nv0, nv1, cur);
    S.a_ready(cur);
    if constexpr (SP2) {
        PG8_STAGE(PG8_SB(0, 0), cB, voffB); PG8_STAGE(PG8_SB(0, 1), cB + hstepB, voffB); PG8_STAGE(PG8_SA(0, 0), cA, cv0); PG8_STAGE(PG8_SA(0, 1), cA + hstepA, cv1);
        if (wr == 1) PG8_BAR;
        PG8_WAIT_V(2); PG8_BAR;
        PG8_STAGE(PG8_SB(1, 0), cB + kstep, voffB); PG8_STAGE(PG8_SA(1, 0), cA + kstep, cv0); PG8_STAGE(PG8_SB(1, 1), cB + hstepB + kstep, voffB);
        PG8_WAIT_V(6); PG8_BAR;
    } else {
        PG8_STAGE(PG8_SB(0, 0), cB, voffB); PG8_STAGE(PG8_SA(0, 0), cA, voffA); PG8_STAGE(PG8_SB(0, 1), cB + hstepB, voffB); PG8_STAGE(PG8_SA(0, 1), cA + hstepA, voffA);
        if (wr == 1) PG8_BAR;
        PG8_WAIT_V(4); PG8_BAR;
        PG8_STAGE(PG8_SB(1, 0), cB + kstep, voffB); PG8_STAGE(PG8_SA(1, 0), cA + kstep, voffA); PG8_STAGE(PG8_SB(1, 1), cB + hstepB + kstep, voffB);
        PG8_WAIT_V(6); PG8_BAR;
    }
    for (;;) {
        const bool has_next = S.next(ui + 1, nxt);
        if constexpr (GATHER) { if (has_next) PG8_SETOFF(nv0, nv1, nxt); else { _Pragma("unroll") for (int i = 0; i < 2; ++i) { nv0[i] = cv0[i]; nv1[i] = cv1[i]; } } }
        const char* nA = has_next ? (const char*)g.A + (size_t)nxt.pm * tstepA + nxt.aoff : cA; const char* nB = has_next ? (const char*)g.Bt + (size_t)nxt.pn * tstepB + nxt.boff : cB;
        for (int t = 0; t < nt; t += 2) {
            const bool last = (t == nt - 2);
            unsigned s0[2], s1[2];
#pragma unroll
            for (int i = 0; i < 2; ++i) { s0[i] = last ? nv0[i] : cv0[i]; s1[i] = last ? nv1[i] : cv1[i]; }
            const char* a1 = cA + (size_t)(t + 1) * kstep;
            const char* a2 = last ? nA : cA + (size_t)(t + 2) * kstep; const char* b2 = last ? nB : cB + (size_t)(t + 2) * kstep;
            const char* a3 = a2 + kstep; const char* b3 = b2 + kstep;
            if (last && has_next) S.a_ready(nxt);
            if constexpr (SP2) {
            PG8_LDB(B0, 0, 0); PG8_LDB(B1, 0, 1); PG8_SCHED; PG8_LDA(At, 0, 0); PG8_STAGE(PG8_SA(1, 1), a1 + hstepA, cv1);
            PG8_WAIT_V(8); PG8_WAIT_L(0); PG8_BAR; PG8_MMA(0, 0, At, B0); PG8_MMA(0, 1, At, B1); PG8_BAR; PG8_SCHED;
            PG8_LDA(At, 0, 1); PG8_STAGE(PG8_SB(0, 0), b2, voffB); PG8_STAGE(PG8_SB(0, 1), b2 + hstepB, voffB); PG8_STAGE(PG8_SA(0, 0), a2, s0);
            PG8_WAIT_V(8); PG8_WAIT_L(0); PG8_BAR; PG8_MMA(1, 0, At, B0); PG8_MMA(1, 1, At, B1); PG8_BAR; PG8_SCHED;
            PG8_LDB(B0, 1, 0); PG8_LDB(B1, 1, 1); PG8_SCHED; PG8_LDA(At, 1, 0); PG8_STAGE(PG8_SA(0, 1), a2 + hstepA, s1);
            PG8_WAIT_V(8); PG8_WAIT_L(0); PG8_BAR; PG8_MMA(0, 0, At, B0); PG8_MMA(0, 1, At, B1); PG8_BAR; PG8_SCHED;
            PG8_LDA(At, 1, 1); PG8_STAGE(PG8_SB(1, 0), b3, voffB); PG8_STAGE(PG8_SB(1, 1), b3 + hstepB, voffB); PG8_STAGE(PG8_SA(1, 0), a3, s0);
            PG8_WAIT_V(8); PG8_WAIT_L(0); PG8_BAR; PG8_MMA(1, 0, At, B0); PG8_MMA(1, 1, At, B1); PG8_BAR; PG8_SCHED;
            } else {
            PG8_LDB(B0, 0, 0); PG8_SCHED; PG8_LDA(At, 0, 0); PG8_STAGE(PG8_SA(1, 1), a1 + hstepA, voffA);
            PG8_WAIT_L(8); PG8_BAR; PG8_WAIT_L(0); PG8_MMA(0, 0, At, B0); PG8_BAR; PG8_SCHED;
            PG8_LDB(B1, 0, 1); PG8_STAGE(PG8_SB(0, 0), b2, voffB);
            PG8_BAR; PG8_WAIT_L(0); PG8_MMA(0, 1, At, B1); PG8_BAR;
            PG8_LDA(At, 0, 1); PG8_STAGE(PG8_SA(0, 0), a2, voffA);
            PG8_BAR; PG8_WAIT_L(0); PG8_MMA(1, 0, At, B0); PG8_BAR; PG8_SCHED;
            PG8_STAGE(PG8_SB(0, 1), b2 + hstepB, voffB);
            PG8_WAIT_V(6); PG8_BAR; PG8_MMA(1, 1, At, B1); PG8_BAR;
            PG8_LDB(B0, 1, 0); PG8_SCHED; PG8_LDA(At, 1, 0); PG8_STAGE(PG8_SA(0, 1), a2 + hstepA, voffA);
            PG8_WAIT_L(8); PG8_BAR; PG8_WAIT_L(0); PG8_MMA(0, 0, At, B0); PG8_BAR; PG8_SCHED;
            PG8_LDB(B1, 1, 1); PG8_STAGE(PG8_SB(1, 0), b3, voffB);
            PG8_BAR; PG8_WAIT_L(0); PG8_MMA(0, 1, At, B1); PG8_BAR;
            PG8_LDA(At, 1, 1); PG8_STAGE(PG8_SA(1, 0), a3, voffA);
            PG8_BAR; PG8_WAIT_L(0); PG8_MMA(1, 0, At, B0); PG8_BAR; PG8_SCHED;
            PG8_STAGE(PG8_SB(1, 1), b3 + hstepB, voffB);
            PG8_WAIT_V(6); PG8_BAR; PG8_MMA(1, 1, At, B1); PG8_BAR;
            }
        }
        if constexpr (ALIGN_EPI) { if (wr == 0) PG8_BAR; }
        if constexpr (!Epi::AFTER_DRAIN) { E(acc, cur, wr, wc, fr, fq); S.done(cur); }
        if (!has_next) break;
#pragma unroll
        for (int a = 0; a < 2; ++a)
#pragma unroll
            for (int b = 0; b < 2; ++b)
#pragma unroll
                for (int m = 0; m < 4; ++m)
#pragma unroll
                    for (int n = 0; n < 2; ++n) acc[a][b][m][n] = (f32x4){0.f, 0.f, 0.f, 0.f};
        cur = nxt; cA = nA; cB = nB; ++ui;
#pragma unroll
        for (int i = 0; i < 2; ++i) { cv0[i] = nv0[i]; cv1[i] = nv1[i]; }
        if constexpr (ALIGN_EPI) { if (wr == 1) PG8_BAR; }
    }
    PG8_WAIT_V(0);
    if constexpr (!ALIGN_EPI) { if (wr == 0) PG8_BAR; }
    PG8_BAR;
    if constexpr (Epi::AFTER_DRAIN) { E.fused(acc, cur, wr, wc, fr, fq, lds, wid, lane); S.done(cur); }
#undef PG8_SA
#undef PG8_SB
#undef PG8_STAGE
#undef PG8_SETOFF
#undef PG8_LDA
#undef PG8_LDB
#undef PG8_MMA
#undef PG8_WAIT_V
#undef PG8_WAIT_L
#undef PG8_BAR
#undef PG8_SCHED
}
}
#include <hip/hip_bf16.h>
#include <cmath>
namespace attn_body {
using bf16=__hip_bfloat16;
using bf16x8=__attribute__((ext_vector_type(8)))short;
using s16x4=__attribute__((ext_vector_type(4)))short;
using f32x16=__attribute__((ext_vector_type(16)))float;
using u32x4=__attribute__((ext_vector_type(4)))unsigned;
constexpr int SEQ=8192,D=64,DM=2816;
constexpr int NW=8,QBLK=32,QB=QBLK*NW,KVBLK=64,NQB=SEQ/QB;
constexpr int ATTN_PITCH=DM, ATTN_UNIT_ROWS=QB;
__device__ __forceinline__ int crow(int r,int hi){return (r&3)+8*(r>>2)+4*hi;}
#define SBAR() __builtin_amdgcn_sched_barrier(0)
__device__ __forceinline__ void cmask(f32x16&p0,f32x16&p1,int jb,int qrel,int hi){
  const float NEG=-INFINITY; int kb=64*jb+4*hi;
  #pragma unroll
  for(int r=0;r<16;++r){int kv=kb+(r&3)+8*(r>>2); if(kv>qrel)p0[r]=NEG; if(kv+32>qrel)p1[r]=NEG;}
}

constexpr int NSLOT=3, SLOTB=8192;
constexpr int LDS_K=0, LDS_V=NSLOT*SLOTB;
constexpr int LDS_BYTES=LDS_V+NSLOT*16384+NW*64*4+NW*4096;
constexpr float C2=0.125f*1.4426950408889634f;
__device__ __forceinline__ void glds16(const void*gsrc,unsigned lds_dst){unsigned keep;
  asm volatile("s_mov_b32 %0, m0\n\ts_mov_b32 m0, %2\n\ts_nop 0\n\tglobal_load_lds_dwordx4 %1, off\n\ts_mov_b32 m0, %0":"=&s"(keep):"v"(gsrc),"s"(lds_dst):"memory");}
__device__ __forceinline__ void glds16s(unsigned voff,const void*sbase,unsigned lds_dst){unsigned keep;
  asm volatile("s_mov_b32 %0, m0\n\ts_mov_b32 m0, %3\n\ts_nop 0\n\tglobal_load_lds_dwordx4 %1, %2\n\ts_mov_b32 m0, %0":"=&s"(keep):"v"(voff),"s"(sbase),"s"(lds_dst):"memory");}
__device__ __forceinline__ float max3f(float a,float b,float c){float r;asm("v_max3_f32 %0, %1, %2, %3":"=v"(r):"v"(a),"v"(b),"v"(c));return r;}
__device__ __forceinline__ float max2f(float a,float b){float r;asm("v_max_f32_e32 %0, %1, %2":"=v"(r):"v"(a),"v"(b));return r;}
__device__ __forceinline__ float fadd_s(float a,float b){float r;asm("v_add_f32_e32 %0, %1, %2":"=v"(r):"v"(a),"v"(b));return r;}
__device__ __forceinline__ float fsub_s(float a,float b){float r;asm("v_sub_f32_e32 %0, %1, %2":"=v"(r):"v"(a),"v"(b));return r;}
typedef float f32x2_t __attribute__((ext_vector_type(2))); typedef __bf16 bf16x2_t __attribute__((ext_vector_type(2)));
__device__ __forceinline__ unsigned cvtpk_s(float lo,float hi){f32x2_t v={lo,hi};bf16x2_t b=__builtin_convertvector(v,bf16x2_t);return __builtin_bit_cast(unsigned,b);}
#define WAIT_BAR(N) asm volatile("s_waitcnt vmcnt(" #N ") lgkmcnt(0)\n\ts_barrier":::"memory")

typedef __attribute__((address_space(3))) const char* lds_cptr;
__device__ __forceinline__ void qkt(f32x16&p0,f32x16&p1,lds_cptr Kslot,const bf16x8*qr,const f32x16&negm,int r32,int hi){
  const lds_cptr kb=Kslot+hi*1024+r32*16;
  #pragma unroll
  for(int d0=0;d0<4;++d0){
    const bf16x8 b0=*(const __attribute__((address_space(3))) bf16x8*)(kb+d0*2048);
    const bf16x8 b1=*(const __attribute__((address_space(3))) bf16x8*)(kb+d0*2048+512);
    if(d0==0){p0=__builtin_amdgcn_mfma_f32_32x32x16_bf16(b0,qr[0],negm,0,0,0);p1=__builtin_amdgcn_mfma_f32_32x32x16_bf16(b1,qr[0],negm,0,0,0);}
    else{p0=__builtin_amdgcn_mfma_f32_32x32x16_bf16(b0,qr[d0],p0,0,0,0);p1=__builtin_amdgcn_mfma_f32_32x32x16_bf16(b1,qr[d0],p1,0,0,0);}}
}
typedef short v4i16_t __attribute__((ext_vector_type(4)));
__device__ __forceinline__ void kload8(bf16x8*kf,lds_cptr kp){
  kf[0]=*(const __attribute__((address_space(3))) bf16x8*)(kp);      kf[1]=*(const __attribute__((address_space(3))) bf16x8*)(kp+512);
  kf[2]=*(const __attribute__((address_space(3))) bf16x8*)(kp+2048); kf[3]=*(const __attribute__((address_space(3))) bf16x8*)(kp+2560);
  kf[4]=*(const __attribute__((address_space(3))) bf16x8*)(kp+4096); kf[5]=*(const __attribute__((address_space(3))) bf16x8*)(kp+4608);
  kf[6]=*(const __attribute__((address_space(3))) bf16x8*)(kp+6144); kf[7]=*(const __attribute__((address_space(3))) bf16x8*)(kp+6656);
}
__device__ __forceinline__ void kload2(bf16x8*kf,lds_cptr kp,int j){ kf[2*j]=*(const __attribute__((address_space(3))) bf16x8*)(kp+j*2048); kf[2*j+1]=*(const __attribute__((address_space(3))) bf16x8*)(kp+j*2048+512); }
__device__ __forceinline__ s16x4 vtr(lds_cptr p){ return __builtin_bit_cast(s16x4,__builtin_amdgcn_ds_read_tr16_b64_v4i16((__attribute__((address_space(3))) v4i16_t*)p)); }
__device__ __forceinline__ float rowmax(const f32x16&p0,const f32x16&p1){
  float a=max3f(p0[0],p0[1],p1[0]),b=max3f(p0[2],p0[3],p1[1]);a=max3f(a,p1[2],p1[3]);
  #pragma unroll
  for(int r=4;r<16;r+=4){a=max3f(a,p0[r],p0[r+1]);b=max3f(b,p0[r+2],p0[r+3]);a=max3f(a,p1[r],p1[r+1]);b=max3f(b,p1[r+2],p1[r+3]);}
  const float m=max2f(a,b);
  auto rr=__builtin_amdgcn_permlane32_swap(__float_as_uint(m),__float_as_uint(m),false,false);
  return max2f(__uint_as_float(rr[0]),__uint_as_float(rr[1]));
}
template<int NDB> __device__ __forceinline__ void pv(f32x16*o,int vb,bf16x8 pa0,bf16x8 pa1,bf16x8 pa2,bf16x8 pa3){
  #pragma unroll
  for(int d0=0;d0<NDB;++d0){s16x4 lo[4],hi[4];
    #pragma unroll
    for(int ks=0;ks<4;++ks){
      asm volatile("ds_read_b64_tr_b16 %0,%1 offset:%c2":"=&v"(lo[ks]):"v"(vb),"i"(d0*4096+ks*1024):"memory");
      asm volatile("ds_read_b64_tr_b16 %0,%1 offset:%c2":"=&v"(hi[ks]):"v"(vb),"i"(d0*4096+ks*1024+512):"memory");}
    asm volatile("s_waitcnt lgkmcnt(0)":::"memory");SBAR();
    #define PK(k) (bf16x8){lo[k][0],lo[k][1],lo[k][2],lo[k][3],hi[k][0],hi[k][1],hi[k][2],hi[k][3]}
    o[d0]=__builtin_amdgcn_mfma_f32_32x32x16_bf16(pa0,PK(0),o[d0],0,0,0);
    o[d0]=__builtin_amdgcn_mfma_f32_32x32x16_bf16(pa1,PK(1),o[d0],0,0,0);
    o[d0]=__builtin_amdgcn_mfma_f32_32x32x16_bf16(pa2,PK(2),o[d0],0,0,0);
    o[d0]=__builtin_amdgcn_mfma_f32_32x32x16_bf16(pa3,PK(3),o[d0],0,0,0);
    #undef PK
  }
}

#ifndef ATTN_STORE16
#define ATTN_STORE16(p,v) (*(__attribute__((address_space(1))) u32x4*)(p)=(v))
#endif
template<int THRL,int NDB,bool FIXREF=false> __device__ __forceinline__ void attn_unit(int qb,const bf16*Qb,const bf16*__restrict__ Kb,const bf16*__restrict__ Vb,bf16*Ob,int opitch,char*shm,const int tid_in,const float negref=0.f){
  int tid_o=tid_in; asm volatile("":"+v"(tid_o));
  const int tid=tid_o,lane=tid&63,r32=lane&31,hi=lane>>5; const int wid=__builtin_amdgcn_readfirstlane(tid>>6);
  constexpr int VSLOTB=NDB*4096, LDS_WS=LDS_V+NSLOT*VSLOTB, LDS_OST=LDS_WS+NW*64*4;
  const int q0=qb*QB;
  const bf16*Qw=Qb+(long)(q0+wid*QBLK)*DM;
  const bf16*Kh=Kb,*Vh=Vb;
  const unsigned lds0=(unsigned)(uintptr_t)shm;
  __attribute__((address_space(3))) float*wsf=(__attribute__((address_space(3))) float*)((lds_cptr)shm+LDS_WS)+wid*64;
  const unsigned ksrc=(unsigned)((lane*DM+wid*8)*2);
  const unsigned vsrc=(unsigned)(((16*(wid&3)+(lane>>2))*DM+(wid>>2)*32+(lane&3)*8)*2);
  const unsigned kdst=lds0+LDS_K+wid*1024, vdst=lds0+LDS_V+wid*1024;
  #define DMA_K(t,slot) glds16s(ksrc,(const char*)Kh+(long)(t)*(KVBLK*DM*2),(unsigned)__builtin_amdgcn_readfirstlane(kdst+(slot)))
  #define DMA_V(t,slot) do{ glds16s(vsrc,(const char*)Vh+(long)(t)*(KVBLK*DM*2),(unsigned)__builtin_amdgcn_readfirstlane(vdst+(slot)*(VSLOTB/SLOTB))); if(NDB==4) glds16s(vsrc,(const char*)Vh+(long)(t)*(KVBLK*DM*2)+128,(unsigned)__builtin_amdgcn_readfirstlane(vdst+(slot)*(VSLOTB/SLOTB)+8192)); }while(0)
  const int vb0=(int)(lds0+LDS_V)+((lane>>4)&1)*32+(lane&3)*8+(4*hi+((lane&15)>>2))*64;
  const lds_cptr Kbase=(lds_cptr)shm+LDS_K; bf16x8 kf[8];
  const lds_cptr shm3=(lds_cptr)shm; const lds_cptr kp0=shm3+LDS_K+hi*1024+r32*16; const lds_cptr vp0=shm3+LDS_V+((lane>>4)&1)*32+(lane&3)*8+(4*hi+((lane&15)>>2))*64;
  constexpr int NT=SEQ/KVBLK;
  DMA_K(0,0);DMA_V(0,0);DMA_K(1,SLOTB);
  bf16x8 qr[4];
  #pragma unroll
  for(int d0=0;d0<4;++d0)qr[d0]=*(const __attribute__((address_space(1))) bf16x8*)(&Qw[(long)r32*DM+d0*16+hi*8]);
  float mhat=0.f,l_reg=0.f;f32x16 o[NDB];_Pragma("unroll") for(int d_=0;d_<NDB;++d_)o[d_]=f32x16{};f32x16 negm=f32x16{}; if(FIXREF){_Pragma("unroll") for(int r=0;r<16;++r)negm[r]=negref;} asm volatile("":"+v"(negm));
  #define CMASK(P0,P1,t) do{}while(0)
  bool resc=false;
  #define START(P0,P1) do{ resc=false; if(!FIXREF){ const float rm=rowmax(P0,P1); \
    { const float dl=rm; mhat=fadd_s(mhat,dl); \
      _Pragma("unroll") for(int r=0;r<16;++r){P0[r]=fsub_s(P0[r],dl);P1[r]=fsub_s(P1[r],dl);} \
      _Pragma("unroll") for(int r=0;r<16;++r)negm[r]=-mhat; asm volatile("":"+v"(negm)); } } \
    _Pragma("unroll") for(int r=0;r<16;++r)P0[r]=__builtin_amdgcn_exp2f(P0[r]); }while(0)
  #define RESC() do{ if(!FIXREF&&resc){ asm volatile("s_waitcnt lgkmcnt(0)":::"memory"); \
      _Pragma("unroll") for(int d_=0;d_<NDB;++d_) _Pragma("unroll") for(int r=0;r<16;++r)o[d_][r]*=wsf[crow(r,hi)]; } }while(0)
  f32x16 pA0,pA1,pB0,pB1;
  #define WAIT_KV() do{ if(NDB==4){WAIT_BAR(3);}else{WAIT_BAR(2);} }while(0)
  #define WAIT_V() do{ if(NDB==4){WAIT_BAR(2);}else{WAIT_BAR(1);} }while(0)
  int sl_prev=0,sl_cur=0,sl_next=SLOTB;
  #define ROT() do{sl_prev=sl_cur;sl_cur=sl_next;sl_next=(sl_next==(NSLOT-1)*SLOTB)?0:sl_next+SLOTB;}while(0)
  DMA_K(2,2*SLOTB);
  WAIT_BAR(3);
  qkt(pA0,pA1,Kbase,qr,negm,r32,hi);asm volatile("s_nop 15\n\ts_nop 7":"+v"(pA0),"+v"(pA1));CMASK(pA0,pA1,0);
  START(pA0,pA1);
  _Pragma("unroll") for(int r=0;r<16;++r)pA1[r]=__builtin_amdgcn_exp2f(pA1[r]);
  WAIT_BAR(0);
  DMA_K(3,0);DMA_V(1,SLOTB);
  ROT();
  kload8(kf,kp0+sl_cur);
  WAIT_KV();
  s16x4 vlo[8],vhi[8]; u32x4 pw0,pw1,pw2,pw3;
  #define PKW(P,B) cvtpk_s(P[B],P[B+1])
  #define PAF(k) __builtin_bit_cast(bf16x8,pw##k)
  #define VFR(i) (bf16x8){vlo[i][0],vlo[i][1],vlo[i][2],vlo[i][3],vhi[i][0],vhi[i][1],vhi[i][2],vhi[i][3]}
  #define PIN(x) asm volatile("":"+v"(x))
  #define MX3(a,b,c) __builtin_fmaxf(__builtin_fmaxf((a),(b)),(c))
  #define GAPA(MF,A0,A1,A2,A3,W0,W1,PW) do{ MF; sacc+=A0; sacc+=A1; sacc+=A2; sacc+=A3; PIN(sacc); W0; W1; PIN(PW); SBAR(); }while(0)
  #define EX(v) __builtin_amdgcn_exp2f(v)
  #define GAPB(MF,X,B) do{ MF; X[B]=EX(X[B]); X[B+1]=EX(X[B+1]); X[B+2]=EX(X[B+2]); X[B+3]=EX(X[B+3]); PIN(X); SBAR(); }while(0)
  #define GAPB2(MF,X,B) do{ MF; X[B]=EX(X[B]); X[B+1]=EX(X[B+1]); PIN(X); SBAR(); }while(0)
  #define VRDX(s,ks,db) do{ vlo[s]=vtr(vp_+((db)*4096+(ks)*1024)); vhi[s]=vtr(vp_+((db)*4096+(ks)*1024+512)); }while(0)
  #define VRDA(i) do{ if(NDB==2){VRD(i);} else if(((i)&3)<2){ VRDX(2*((i)&3)+((i)>>2),(i)&3,(i)>>2); } }while(0)
  #define VRD(i) do{ vlo[i]=vtr(vp_+(((i)>>2)*4096+((i)&3)*1024)); vhi[i]=vtr(vp_+(((i)>>2)*4096+((i)&3)*1024+512)); }while(0)
  #define KRD(G,j) do{ if(G){ kload2(kf,kp0+sl_next,j); SBAR(); } }while(0)
  #define STEP(C0,C1,P0,P1,t,GK,GV,GL) do{ SBAR(); \
    const lds_cptr vp_=vp0+sl_prev*(VSLOTB/SLOTB); \
    VRDA(0); SBAR(); float sacc=(P0[0]+P0[1]); \
    GAPA(C0=__builtin_amdgcn_mfma_f32_32x32x16_bf16(kf[0],qr[0],negm,0,0,0), P0[2],P0[3],P0[4],P0[5],     pw0[0]=PKW(P0,0), pw0[1]=PKW(P0,2), pw0); \
    VRDA(4); SBAR(); GAPA(C1=__builtin_amdgcn_mfma_f32_32x32x16_bf16(kf[1],qr[0],negm,0,0,0), P0[6],P0[7],P0[8],P0[9],     pw0[2]=PKW(P0,4), pw0[3]=PKW(P0,6), pw0); \
    VRDA(1); SBAR(); GAPA(C0=__builtin_amdgcn_mfma_f32_32x32x16_bf16(kf[2],qr[1],C0,0,0,0),   P0[10],P0[11],P0[12],P0[13], pw1[0]=PKW(P0,8), pw1[1]=PKW(P0,10), pw1); \
    VRDA(5); SBAR(); GAPA(C1=__builtin_amdgcn_mfma_f32_32x32x16_bf16(kf[3],qr[1],C1,0,0,0),   P0[14],P0[15],P1[0],P1[1],   pw1[2]=PKW(P0,12),pw1[3]=PKW(P0,14), pw1); \
    VRDA(2); SBAR(); GAPA(C0=__builtin_amdgcn_mfma_f32_32x32x16_bf16(kf[4],qr[2],C0,0,0,0),   P1[2],P1[3],P1[4],P1[5],     pw2[0]=PKW(P1,0), pw2[1]=PKW(P1,2), pw2); \
    VRDA(6); SBAR(); GAPA(C1=__builtin_amdgcn_mfma_f32_32x32x16_bf16(kf[5],qr[2],C1,0,0,0),   P1[6],P1[7],P1[8],P1[9],     pw2[2]=PKW(P1,4), pw2[3]=PKW(P1,6), pw2); \
    VRDA(3); SBAR(); GAPA(C0=__builtin_amdgcn_mfma_f32_32x32x16_bf16(kf[6],qr[3],C0,0,0,0),   P1[10],P1[11],P1[12],P1[13], pw3[0]=PKW(P1,8), pw3[1]=PKW(P1,10), pw3); \
    VRDA(7); SBAR(); GAPA(C1=__builtin_amdgcn_mfma_f32_32x32x16_bf16(kf[7],qr[3],C1,0,0,0),   P1[14],P1[15],0.f,0.f,       pw3[2]=PKW(P1,12),pw3[3]=PKW(P1,14), pw3); \
    l_reg+=sacc; \
    if(GK){DMA_K((t)+3,sl_cur);} if(GV){DMA_V((t)+1,sl_next);} \
    CMASK(C0,C1,t); \
    if(!FIXREF){ float a=MX3(C0[0],C0[1],C1[0]),b=MX3(C0[2],C0[3],C1[1]); a=MX3(a,C1[2],C1[3]); \
      _Pragma("unroll") for(int r=4;r<16;r+=4){a=MX3(a,C0[r],C0[r+1]);b=MX3(b,C0[r+2],C0[r+3]);a=MX3(a,C1[r],C1[r+1]);b=MX3(b,C1[r+2],C1[r+3]);} \
      float rm=__builtin_fmaxf(a,b); { auto rr=__builtin_amdgcn_permlane32_swap(__float_as_uint(rm),__float_as_uint(rm),false,false); rm=__builtin_fmaxf(__uint_as_float(rr[0]),__uint_as_float(rr[1])); } \
      resc=false; \
      if(__builtin_expect(__any(rm>(float)THRL),0)){ const float dl=__builtin_fmaxf(rm,0.f); mhat+=dl; \
        _Pragma("unroll") for(int r=0;r<16;++r){C0[r]-=dl;C1[r]-=dl;} \
        _Pragma("unroll") for(int r=0;r<16;++r)negm[r]=-mhat; asm volatile("":"+v"(negm)); \
        const float f=__builtin_amdgcn_exp2f(-dl); l_reg*=f; if(hi==0)wsf[r32]=f; resc=true; } } \
    SBAR(); \
    if(NDB==2){ \
    GAPB(o[0]=__builtin_amdgcn_mfma_f32_32x32x16_bf16(PAF(0),VFR(0),o[0],0,0,0), C0,0); \
    GAPB(o[1]=__builtin_amdgcn_mfma_f32_32x32x16_bf16(PAF(0),VFR(4),o[1],0,0,0), C0,4); \
    KRD(GL,0); GAPB(o[0]=__builtin_amdgcn_mfma_f32_32x32x16_bf16(PAF(1),VFR(1),o[0],0,0,0), C0,8); \
    KRD(GL,1); GAPB(o[1]=__builtin_amdgcn_mfma_f32_32x32x16_bf16(PAF(1),VFR(5),o[1],0,0,0), C0,12); \
    KRD(GL,2); GAPB(o[0]=__builtin_amdgcn_mfma_f32_32x32x16_bf16(PAF(2),VFR(2),o[0],0,0,0), C1,0); \
    KRD(GL,3); GAPB(o[1]=__builtin_amdgcn_mfma_f32_32x32x16_bf16(PAF(2),VFR(6),o[1],0,0,0), C1,4); \
    GAPB(o[0]=__builtin_amdgcn_mfma_f32_32x32x16_bf16(PAF(3),VFR(3),o[0],0,0,0), C1,8); \
    GAPB(o[1]=__builtin_amdgcn_mfma_f32_32x32x16_bf16(PAF(3),VFR(7),o[1],0,0,0), C1,12); \
    } else { \
    GAPB2(o[0]=__builtin_amdgcn_mfma_f32_32x32x16_bf16(PAF(0),VFR(0),o[0],0,0,0), C0,0); VRDX(0,2,0); SBAR(); \
    GAPB2(o[1]=__builtin_amdgcn_mfma_f32_32x32x16_bf16(PAF(0),VFR(1),o[1],0,0,0), C0,2); VRDX(1,2,1); SBAR(); \
    GAPB2(o[0]=__builtin_amdgcn_mfma_f32_32x32x16_bf16(PAF(1),VFR(2),o[0],0,0,0), C0,4); VRDX(2,3,0); SBAR(); \
    GAPB2(o[1]=__builtin_amdgcn_mfma_f32_32x32x16_bf16(PAF(1),VFR(3),o[1],0,0,0), C0,6); VRDX(3,3,1); SBAR(); \
    GAPB2(o[0]=__builtin_amdgcn_mfma_f32_32x32x16_bf16(PAF(2),VFR(0),o[0],0,0,0), C0,8); VRDX(0,0,2); SBAR(); \
    GAPB2(o[1]=__builtin_amdgcn_mfma_f32_32x32x16_bf16(PAF(2),VFR(1),o[1],0,0,0), C0,10); VRDX(1,0,3); SBAR(); \
    GAPB2(o[0]=__builtin_amdgcn_mfma_f32_32x32x16_bf16(PAF(3),VFR(2),o[0],0,0,0), C0,12); VRDX(2,1,2); SBAR(); \
    GAPB2(o[1]=__builtin_amdgcn_mfma_f32_32x32x16_bf16(PAF(3),VFR(3),o[1],0,0,0), C0,14); VRDX(3,1,3); SBAR(); \
    GAPB2(o[2]=__builtin_amdgcn_mfma_f32_32x32x16_bf16(PAF(0),VFR(0),o[2],0,0,0), C1,0); VRDX(0,2,2); SBAR(); \
    GAPB2(o[3]=__builtin_amdgcn_mfma_f32_32x32x16_bf16(PAF(0),VFR(1),o[3],0,0,0), C1,2); VRDX(1,2,3); SBAR(); \
    GAPB2(o[2]=__builtin_amdgcn_mfma_f32_32x32x16_bf16(PAF(1),VFR(2),o[2],0,0,0), C1,4); VRDX(2,3,2); SBAR(); \
    GAPB2(o[3]=__builtin_amdgcn_mfma_f32_32x32x16_bf16(PAF(1),VFR(3),o[3],0,0,0), C1,6); VRDX(3,3,3); SBAR(); \
    KRD(GL,0); GAPB2(o[2]=__builtin_amdgcn_mfma_f32_32x32x16_bf16(PAF(2),VFR(0),o[2],0,0,0), C1,8); \
    KRD(GL,1); GAPB2(o[3]=__builtin_amdgcn_mfma_f32_32x32x16_bf16(PAF(2),VFR(1),o[3],0,0,0), C1,10); \
    KRD(GL,2); GAPB2(o[2]=__builtin_amdgcn_mfma_f32_32x32x16_bf16(PAF(3),VFR(2),o[2],0,0,0), C1,12); \
    KRD(GL,3); GAPB2(o[3]=__builtin_amdgcn_mfma_f32_32x32x16_bf16(PAF(3),VFR(3),o[3],0,0,0), C1,14); \
    } \
    }while(0)
  int t=1;
  #undef CMASK
  #define CMASK(P0,P1,t) do{}while(0)
  for(;t+5<NT;t+=2){
    STEP(pB0,pB1,pA0,pA1,t,true,true,true);     WAIT_KV(); RESC(); ROT();
    STEP(pA0,pA1,pB0,pB1,t+1,true,true,true);   WAIT_KV(); RESC(); ROT();
  }
  #undef CMASK
  #define CMASK(P0,P1,t) do{}while(0)
  #define ENDW(tt) do{ if((tt)+3<NT){WAIT_KV();} else if((tt)+2<NT){WAIT_V();} else {WAIT_BAR(0);} }while(0)
  for(;t+1<NT;t+=2){
    STEP(pB0,pB1,pA0,pA1,t,(t+3<NT),(t+1<NT),(t+1<NT));       ENDW(t);   RESC(); ROT();
    STEP(pA0,pA1,pB0,pB1,t+1,(t+4<NT),(t+2<NT),(t+2<NT));     ENDW(t+1); RESC(); ROT();
  }
  STEP(pB0,pB1,pA0,pA1,NT-1,false,false,false); RESC();
  { float sacc=pB0[0]+pB0[1]; _Pragma("unroll") for(int r=2;r<16;++r)sacc+=pB0[r]; _Pragma("unroll") for(int r=0;r<16;++r)sacc+=pB1[r]; l_reg+=sacc;
    pw0=(u32x4){PKW(pB0,0),PKW(pB0,2),PKW(pB0,4),PKW(pB0,6)};pw1=(u32x4){PKW(pB0,8),PKW(pB0,10),PKW(pB0,12),PKW(pB0,14)};pw2=(u32x4){PKW(pB1,0),PKW(pB1,2),PKW(pB1,4),PKW(pB1,6)};pw3=(u32x4){PKW(pB1,8),PKW(pB1,10),PKW(pB1,12),PKW(pB1,14)};
    SBAR(); pv<NDB>(o,vb0+sl_cur*(VSLOTB/SLOTB),PAF(0),PAF(1),PAF(2),PAF(3)); }
  #undef PKW
  #undef PAF
  #undef VFR
  #undef PIN
  #undef MX3
  #undef GAPA
  #undef GAPB
  #undef EX
  #undef VRD
  #undef VRDX
  #undef VRDA
  #undef GAPB2
  #undef KRD
  #undef STEP
  #undef ENDW
  {auto rr=__builtin_amdgcn_permlane32_swap(__float_as_uint(l_reg),__float_as_uint(l_reg),false,false);l_reg=__uint_as_float(rr[0])+__uint_as_float(rr[1]);}
  if(hi==0)wsf[32+r32]=l_reg;asm volatile("s_waitcnt lgkmcnt(0)":::"memory");
  float rli[16];
  #pragma unroll
  for(int r=0;r<16;++r)rli[r]=__builtin_amdgcn_rcpf(wsf[32+crow(r,hi)]);
  bf16*Ow=Ob+(long)(q0+wid*QBLK)*opitch;
  _Pragma("unroll") for(int hf=0;hf<NDB/2;++hf){ __attribute__((address_space(3))) unsigned short*stg=(__attribute__((address_space(3))) unsigned short*)((lds_cptr)shm+LDS_OST)+wid*2048;
    #pragma unroll
    for(int r=0;r<16;++r){const int orow=crow(r,hi);
      #pragma unroll
      for(int d0=0;d0<2;++d0)stg[orow*64+d0*32+r32]=(unsigned short)(cvtpk_s(o[2*hf+d0][r]*rli[r],0.f)&0xffffu);}
    asm volatile("s_waitcnt lgkmcnt(0)":::"memory");
    #pragma unroll
    for(int i=0;i<4;++i){const int row=i*8+(lane>>3),ch=lane&7; const u32x4 v=*(const __attribute__((address_space(3))) u32x4*)(stg+row*64+ch*8); ATTN_STORE16(Ow+(long)row*opitch+hf*64+ch*8,v);}
    asm volatile("s_waitcnt lgkmcnt(0)":::"memory"); }
  asm volatile("s_waitcnt lgkmcnt(0)\n\ts_barrier":::"memory");
  #undef DMA_K
  #undef DMA_V
  #undef CMASK
  #undef START
  #undef RESC
  #undef ROT
  #undef WAIT_KV
  #undef WAIT_V
}
constexpr int ATTN_LDS_BYTES=LDS_BYTES;
#undef SBAR
#undef WAIT_BAR
}

#ifndef MK_SPLIT
#define MK_SPLIT 0
#endif
constexpr int NWAVES = 8;
constexpr int DM = 1024, NBATCH = 4, SEQ = 8192, TOK = NBATCH * SEQ, NLAYER = 2, INC = 7440;
constexpr float EPS = 1e-6f;
constexpr float QSCALE = 0.125f * 1.4426950408889634f;
constexpr int NPH = 26;
constexpr size_t MiB = 1u << 20;
constexpr size_t WS_CTL = 0, CTL_ZERO_BYTES = 1 * MiB;
constexpr size_t WS_COS1 = 1 * MiB, WS_SIN1 = 2 * MiB;
constexpr size_t WS_AX = 3 * MiB;
constexpr size_t WS_WBA = 3 * MiB + 64 * 1024;
constexpr size_t WS_WRT = 3 * MiB + 256 * 1024;
constexpr size_t WS_RSTD1 = 4 * MiB, WS_RSTD2 = 4 * MiB + 128 * 1024, WS_RSTDF = 4 * MiB + 256 * 1024;
constexpr size_t WS_BA = 4 * MiB + 512 * 1024;
constexpr size_t WS_TOKL = 7 * MiB;
constexpr size_t WS_WL = 11 * MiB;
constexpr size_t WS_TSLOT = 15 * MiB;
constexpr size_t WS_WROW = 15 * MiB + 256 * 1024;
constexpr size_t WS_RROW = 15 * MiB + 576 * 1024;
constexpr size_t WS_WIN = 16 * MiB;
constexpr size_t WS_WG = 33 * MiB;
constexpr size_t WS_WBR = 45 * MiB;
constexpr size_t WS_WO3 = 51 * MiB;
constexpr size_t WS_XB = 55 * MiB;
constexpr size_t WS_MM = 520 * MiB, WS_INTRA = 552 * MiB;
constexpr size_t WS_PP = 119 * MiB;
constexpr size_t WS_RAW = 295 * MiB;
constexpr size_t WS_OF = 295 * MiB, WS_OB = 327 * MiB;
constexpr size_t WS_KN = 391 * MiB, WS_KT = 423 * MiB, WS_QN = 455 * MiB, WS_VC = 487 * MiB;
constexpr size_t WS_GC = 519 * MiB;
constexpr size_t WS_OD = 391 * MiB;
constexpr size_t WS_YBR = 295 * MiB;
constexpr size_t WS_MGT = 183 * MiB;
constexpr size_t WS_MG = 119 * MiB;
constexpr size_t WS_W13T = 487 * MiB, WS_W2T = 551 * MiB;
constexpr size_t WS_XG = 215 * MiB;
constexpr size_t WS_HH = 359 * MiB;
constexpr size_t WS_END = 584 * MiB;
constexpr int PPW = 2816, PC_Z = 0, PC_DQ = 512, PC_DK = 1024, PC_DV = 1536, PC_CQ = 2048, PC_CK = 2560, PC_CV = 2688;
constexpr int CW_BAR = 4096, CW_CNT = 8192, CW_NRM = 8448;
constexpr int RING_BYTES = 131072, LDSCTL_OFF = 145408, LDS_TBASE = LDSCTL_OFF + 256, LDS_TILEE = LDSCTL_OFF + 512;
constexpr int LDS_ROWTAB = LDSCTL_OFF + 2048, LDS_RSTAB = LDS_ROWTAB + 5120, LDS_WTAB = LDS_RSTAB + 5120, LDS_BYTES = LDS_WTAB + 5120;
static_assert(LDS_BYTES <= 163840, "LDS");

#define GAS __attribute__((address_space(1)))
#define LAS __attribute__((address_space(3)))
typedef unsigned short bf16;
typedef unsigned v4u __attribute__((ext_vector_type(4)));
typedef unsigned v2u __attribute__((ext_vector_type(2)));
typedef float f32x4 __attribute__((ext_vector_type(4)));
typedef short bf16x8 __attribute__((ext_vector_type(8)));
typedef GAS unsigned gu32;
#define RLX_AGENT __ATOMIC_RELAXED, __HIP_MEMORY_SCOPE_AGENT
#define LDS_WAIT() asm volatile("s_waitcnt lgkmcnt(0)" ::: "memory")
#define LBAR() do { asm volatile("s_waitcnt lgkmcnt(0)" ::: "memory"); __builtin_amdgcn_s_barrier(); asm volatile("" ::: "memory"); } while (0)
__device__ __forceinline__ unsigned pk2(float lo, float hi) { return pg8::cvt_pk_bf16(lo, hi); }
__device__ __forceinline__ float bflo(unsigned w) { return __uint_as_float(w << 16); }
__device__ __forceinline__ float bfhi(unsigned w) { return __uint_as_float(w & 0xffff0000u); }
__device__ __forceinline__ float bf2f(bf16 v) { return __uint_as_float((unsigned)v << 16); }
__device__ __forceinline__ float lshfl(float v, int src) { return __int_as_float(__builtin_amdgcn_ds_bpermute(src << 2, __float_as_int(v))); }
__device__ __forceinline__ int lshfl(int v, int src) { return __builtin_amdgcn_ds_bpermute(src << 2, v); }
#define SHFL_XOR(v, m) lshfl((v), lane ^ (m))
#define SHFL_UP(v, o) lshfl((v), (lane - (o)) & 63)
#define SHFL(v, s) lshfl((v), (s))
__device__ __forceinline__ float wave_sum(float v, int) {
    v += __int_as_float(__builtin_amdgcn_update_dpp(0, __float_as_int(v), 0xB1, 0xf, 0xf, false));
    v += __int_as_float(__builtin_amdgcn_update_dpp(0, __float_as_int(v), 0x4E, 0xf, 0xf, false));
    v += __int_as_float(__builtin_amdgcn_update_dpp(0, __float_as_int(v), 0x141, 0xf, 0xf, false));
    v += __int_as_float(__builtin_amdgcn_update_dpp(0, __float_as_int(v), 0x140, 0xf, 0xf, false));
    v += __int_as_float(__builtin_amdgcn_update_dpp(0, __float_as_int(v), 0x142, 0xa, 0xf, false));
    v += __int_as_float(__builtin_amdgcn_update_dpp(0, __float_as_int(v), 0x143, 0xc, 0xf, false));
    return __int_as_float(__builtin_amdgcn_readlane(__float_as_int(v), 63));
}
__device__ __forceinline__ float row16_sum(float v) {
    v += __int_as_float(__builtin_amdgcn_update_dpp(0, __float_as_int(v), 0xB1, 0xf, 0xf, false));
    v += __int_as_float(__builtin_amdgcn_update_dpp(0, __float_as_int(v), 0x4E, 0xf, 0xf, false));
    v += __int_as_float(__builtin_amdgcn_update_dpp(0, __float_as_int(v), 0x141, 0xf, 0xf, false));
    v += __int_as_float(__builtin_amdgcn_update_dpp(0, __float_as_int(v), 0x140, 0xf, 0xf, false));
    return v;
}
__device__ __forceinline__ float sigm(float x) { return __builtin_amdgcn_rcpf(1.0f + __expf(-x)); }
__device__ __forceinline__ f32x4 mfma16(bf16x8 a, bf16x8 b, f32x4 c) { return __builtin_amdgcn_mfma_f32_16x16x32_bf16(a, b, c, 0, 0, 0); }
#define XB_TMO      128
#define XB_XCNT(j)  (256  + 64 * (j))
#define XB_XSUB(j)  (1280 + 64 * (j))
#define XB_XGEN(j)  (2304 + 64 * (j))
#define XB_TOP      3328
#define XB_TOPGEN   3392
#define XCD_BAR_WORDS 3456
#define XB_SPIN_CAP (1u << 18)

__device__ __forceinline__ unsigned xb_ld(unsigned* p)              { return __hip_atomic_load(p, __ATOMIC_RELAXED, __HIP_MEMORY_SCOPE_AGENT); }
__device__ __forceinline__ unsigned xb_add(unsigned* p, unsigned v) { asm volatile("" : "+v"(v));
    return __hip_atomic_fetch_add(p, v, __ATOMIC_RELAXED, __HIP_MEMORY_SCOPE_AGENT); }
__device__ __forceinline__ unsigned xb_xcc_id() { return (unsigned)__builtin_amdgcn_s_getreg((3 << 11) | 20) & 0xFu; }
#define XB_SPIN(cond, bar) do { unsigned _sp = 0; while (cond) { __builtin_amdgcn_s_sleep(1); \
    if ((++_sp & 255u) == 0u) { if (xb_ld(&(bar)[XB_TMO])) break; if (_sp > XB_SPIN_CAP) { atomicAdd(&(bar)[XB_TMO], 1u); break; } } } } while (0)

struct XcdBarrier {
    unsigned* bar; unsigned x;
    volatile LAS unsigned* st;
};

__device__ __forceinline__ XcdBarrier xcd_barrier_post(unsigned* bar, volatile LAS unsigned* st) {
    XcdBarrier b; b.bar = bar; b.x = xb_xcc_id(); b.st = st;
    if (threadIdx.x == 0) (void)xb_add(&bar[XB_XCNT(b.x)], 1u);
    return b;
}
__device__ __forceinline__ void xcd_barrier_complete(unsigned* bar, unsigned x, unsigned& nloc, unsigned& nx) {
    const unsigned G = gridDim.x * gridDim.y * gridDim.z;
    unsigned sum, cnt, mine, sp = 0u;
    for (;;) {
        sum = 0u; cnt = 0u; mine = 0u;
#pragma unroll
        for (unsigned j = 0; j < 16; ++j) { const unsigned c = xb_ld(&bar[XB_XCNT(j)]); sum += c; cnt += (c > 0u) ? 1u : 0u; mine = (j == x) ? c : mine; }
        if (sum == G) break;
        __builtin_amdgcn_s_sleep(1);
        if ((++sp & 255u) == 0u) { if (xb_ld(&bar[XB_TMO])) break; if (sp > XB_SPIN_CAP) { atomicAdd(&bar[XB_TMO], 1u); break; } }
    }
    nloc = mine > 0u ? mine : 1u; nx = cnt > 0u ? cnt : 1u;
}

__device__ __forceinline__ void xcd_barrier(const XcdBarrier& b) {
    asm volatile("s_waitcnt vmcnt(0)" ::: "memory");
    __syncthreads();
    if (threadIdx.x == 0) {
        unsigned* bar = b.bar;
        __builtin_amdgcn_s_waitcnt(0);
        unsigned nloc = b.st[0], nx = b.st[1];
        if (nloc == 0u) { xcd_barrier_complete(bar, b.x, nloc, nx); b.st[0] = nloc; b.st[1] = nx; }
        const unsigned old = xb_add(&bar[XB_XSUB(b.x)], 1u);
        const unsigned gen = old / nloc;
        if (old + 1u == (gen + 1u) * nloc) {
            __builtin_amdgcn_fence(__ATOMIC_RELEASE, "agent");
            asm volatile("s_waitcnt vmcnt(0)" ::: "memory");
            const unsigned og = xb_add(&bar[XB_TOP], 1u);
            const unsigned tg = og / nx;
            if (og + 1u == (tg + 1u) * nx) xb_add(&bar[XB_TOPGEN], 1u);
            else XB_SPIN(xb_ld(&bar[XB_TOPGEN]) == tg, bar);
            __builtin_amdgcn_fence(__ATOMIC_ACQUIRE, "agent");
            xb_add(&bar[XB_XGEN(b.x)], 1u);
            asm volatile("s_waitcnt vmcnt(0)" ::: "memory");
        } else {
            XB_SPIN(xb_ld(&bar[XB_XGEN(b.x)]) == gen, bar);
            __builtin_amdgcn_fence(__ATOMIC_ACQUIRE, "agent");
            asm volatile("s_waitcnt vmcnt(0)" ::: "memory");
        }
    }
    __syncthreads();
}

struct Args { const float* in[24]; float* out; unsigned char* ws; int ph_lo, ph_hi; };
struct Frame {
    LAS unsigned char* lds; unsigned char* ldsg;
    volatile LAS unsigned* MISC;
    gu32* ctl;
    int tid, lane, wave, vcu, G;
    const __attribute__((address_space(4))) Args* A; float* out; unsigned char* ws;
};
#define INP(k) (F.A->in[k])
#define WSP(T, off) ((T*)(F.ws + (off)))
#define WSG(T, off) ((GAS T*)(F.ws + (off)))

__device__ __forceinline__ void tr_item(const float* W, int ldw, int srccol0, int k0, bf16* WT, int ldt, int dstrow0, int dstk0, const float* ksc, LAS float* scr, int lane) {
    f32x4 v[8];
#pragma unroll
    for (int i = 0; i < 8; ++i) v[i] = __builtin_nontemporal_load((const f32x4*)(W + (size_t)(k0 + 8 * i + (lane >> 3)) * ldw + srccol0 + 4 * (lane & 7)));
#pragma unroll
    for (int i = 0; i < 8; ++i) { const int kk = 8 * i + (lane >> 3); const float sc = ksc ? ksc[k0 + kk] : 1.0f; LAS float* d = scr + kk * 33 + 4 * (lane & 7);
        d[0] = v[i][0] * sc; d[1] = v[i][1] * sc; d[2] = v[i][2] * sc; d[3] = v[i][3] * sc; }
    LDS_WAIT(); asm volatile("" ::: "memory");
    const int c = lane & 7;
#pragma unroll
    for (int j = 0; j < 4; ++j) { const int n = (lane >> 3) + 8 * j; const LAS float* s = scr + (8 * c) * 33 + n;
        v4u o; o.x = pk2(s[0 * 33], s[1 * 33]); o.y = pk2(s[2 * 33], s[3 * 33]); o.z = pk2(s[4 * 33], s[5 * 33]); o.w = pk2(s[6 * 33], s[7 * 33]);
        *(GAS v4u*)(WT + (size_t)(dstrow0 + n) * ldt + dstk0 + 8 * c) = o; }
    LDS_WAIT(); asm volatile("" ::: "memory");
}
__device__ __forceinline__ void sincos_d(double x, double& s, double& c) {
    const double q = rint(x * 0.6366197723675814); double r = fma(-q, 1.5707963267948966, x); r = fma(-q, 6.123233995736766e-17, r);
    const double r2 = r * r;
    double sp = -7.647163731819816e-13; sp = fma(sp, r2, 1.6059043836821613e-10); sp = fma(sp, r2, -2.505210838544172e-08); sp = fma(sp, r2, 2.7557319223985893e-06); sp = fma(sp, r2, -1.984126984126984e-04); sp = fma(sp, r2, 8.333333333333333e-03); sp = fma(sp, r2, -1.6666666666666666e-01);
    const double sr = fma(sp * r2, r, r);
    double cp = 4.779477332387385e-14; cp = fma(cp, r2, -1.1470745597729725e-11); cp = fma(cp, r2, 2.08767569878681e-09); cp = fma(cp, r2, -2.755731922398589e-07); cp = fma(cp, r2, 2.48015873015873e-05); cp = fma(cp, r2, -1.388888888888889e-03); cp = fma(cp, r2, 4.1666666666666664e-02); cp = fma(cp, r2, -0.5);
    const double cr = fma(cp, r2, 1.0);
    const int qi = ((int)q) & 3;
    s = (qi == 0) ? sr : (qi == 1) ? cr : (qi == 2) ? -sr : -cr;
    c = (qi == 0) ? cr : (qi == 1) ? -sr : (qi == 2) ? -cr : sr;
}
__device__ __forceinline__ void p0_prologue(Frame& F) {
    LAS float* scr = (LAS float*)(F.lds + F.wave * 16384);
    const int gw = F.vcu * NWAVES + F.wave, NGW = F.G * NWAVES;
    constexpr int I_A = 136 * 16, I_B = 96 * 16, I_C = 3 * 256, I_D = 512, I_L = I_A + I_B + I_C + I_D;
    for (int it0 = gw; it0 < NLAYER * I_L; it0 += NGW) {
        const int l = it0 / I_L; int r = it0 % I_L;
        const float* anw = INP(1) + l * DM;
        if (r < I_A) { const int db = r / 16, kb = r % 16, d0 = 32 * db; const int pt_ = (d0 >> 8) - 6, rho = d0 & 255;
            const int lc = ((pt_ >= 2 && pt_ <= 5) || pt_ >= 8) ? (d0 & ~255) + ((rho >> 5) & 3) * 64 + (rho >> 7) * 32 : d0;
            tr_item(INP(2) + (size_t)l * DM * INC, INC, lc < 2048 ? lc : lc + 16, 64 * kb, WSP(bf16, WS_WIN) + (size_t)l * 4352 * 1024, 1024, d0, 64 * kb, anw, scr, F.lane); continue; } r -= I_A;
        if (r < I_B) { const int db = r / 16, kb = r % 16, d0 = 32 * db; tr_item(INP(2) + (size_t)l * DM * INC, INC, 4368 + d0, 64 * kb, WSP(bf16, WS_WG) + (size_t)l * 3072 * 1024, 1024, d0, 64 * kb, anw, scr, F.lane); continue; } r -= I_B;
        if (r < I_C) { const int i = r / 256, rr = r % 256, db = rr / 8, kb = rr % 8; tr_item((i == 0 ? INP(11) : (i == 1 ? INP(12) : INP(13))) + (size_t)l * 512 * 1024, 1024, 32 * db, 64 * kb, WSP(bf16, WS_WBR) + (size_t)l * 3072 * 512, 512, i * 1024 + 32 * db, 64 * kb, nullptr, scr, F.lane); continue; } r -= I_C;
        { const int db = r / 16, kb = r % 16; tr_item(INP(14) + (size_t)l * 1024 * 1024, 1024, 32 * db, 64 * kb, WSP(bf16, WS_WO3) + (size_t)l * 1024 * 1024, 1024, 32 * db, 64 * kb, nullptr, scr, F.lane); }
    }
    const int gt = (F.vcu * NWAVES + F.wave) * 64 + F.lane, NGT = F.G * NWAVES * 64;
    float* wba = WSP(float, WS_WBA); float* wrt = WSP(float, WS_WRT);
    for (int i = gt; i < NLAYER * 16 * 1024; i += NGT) { const int l = i / (16 * 1024), j = (i / 1024) % 16, k = i % 1024; wba[i] = INP(1)[l * DM + k] * INP(2)[((size_t)l * DM + k) * INC + 2048 + j]; }
    for (int i = gt; i < NLAYER * 48 * 1024; i += NGT) { const int l = i / (48 * 1024), j = (i / 1024) % 48, k = i % 1024; const float nw = INP(15)[l * DM + k];
        float v = 0.f; if (j < 4) v = nw * INP(16)[((size_t)l * DM + k) * 4 + j]; else if (j < 36) v = nw * INP(18)[((size_t)l * DM + k) * 32 + (j - 4)]; wrt[i] = v; }
    float* c1 = WSP(float, WS_COS1); float* s1 = WSP(float, WS_SIN1);
    for (int i = gt; i < SEQ * 32; i += NGT) { const int s = i >> 5, f = i & 31; const double inv = exp(-((double)f / 32.0) * 9.210340371976184); double sn, cs; sincos_d((double)s * inv, sn, cs); c1[i] = (float)cs; s1[i] = (float)sn; }
    float* ax = WSP(float, WS_AX);
    for (int i = gt; i < 192 * 16; i += NGT) { const int p = i >> 4, f = i & 15; const double inv = exp(-((double)f / 16.0) * 9.210340371976184); const int pos = p < 128 ? p : p - 128; double sn, cs; sincos_d((double)pos * inv, sn, cs);
        if (p < 128) { ax[p * 16 + f] = (float)cs; ax[2048 + p * 16 + f] = (float)sn; } else { ax[4096 + (p - 128) * 16 + f] = (float)cs; ax[5120 + (p - 128) * 16 + f] = (float)sn; } }
}
struct TrDesc { const float* src; bf16* dst; int ldw, ldt, k0; bool scale; };
__device__ __forceinline__ TrDesc expert_item(Frame& F, int l, int it) {
    const int e = it / 768, r = it % 768, kind = r / 256, rr = r % 256; TrDesc d;
    if (kind < 2) { const int cb = rr / 16, kb = rr % 16, c0 = 32 * cb;
        d.src = (kind == 0 ? INP(20) : INP(21)) + ((size_t)l * 32 + e) * 1024 * 512 + (size_t)(64 * kb) * 512 + c0; d.ldw = 512;
        d.dst = WSP(bf16, WS_W13T) + (size_t)e * 1024 * 1024 + (size_t)((c0 / 128) * 256 + (c0 % 128) + kind * 128) * 1024 + 64 * kb; d.ldt = 1024; d.k0 = 64 * kb; d.scale = true; }
    else { const int cb = rr / 8, kb = rr % 8;
        d.src = INP(22) + ((size_t)l * 32 + e) * 512 * 1024 + (size_t)(64 * kb) * 1024 + 32 * cb; d.ldw = 1024;
        d.dst = WSP(bf16, WS_W2T) + (size_t)e * 1024 * 512 + (size_t)(32 * cb) * 512 + 64 * kb; d.ldt = 512; d.k0 = 64 * kb; d.scale = false; }
    return d;
}
template <class V> __device__ __forceinline__ void st16s_hidden(unsigned voff, const void* sbase, const V v) { asm volatile("global_store_dwordx4 %0, %1, %2\n\ts_nop 1" :: "v"(voff), "v"(v), "s"(sbase) : "memory"); }
template <class T, class V> __device__ __forceinline__ void st16_hidden(GAS T* p, const V v) { asm volatile("global_store_dwordx4 %0, %1, off\n\ts_nop 1" :: "v"(p), "v"(v) : "memory"); }
__device__ __forceinline__ void expert_convert(Frame& F, int l) {
    int lane; asm volatile("v_mbcnt_lo_u32_b32 %0, -1, 0\n\tv_mbcnt_hi_u32_b32 %0, -1, %0" : "=v"(lane));
    const int gw = F.vcu * NWAVES + F.wave, NGW = F.G * NWAVES, NIT = 32 * 768;
    LAS float* scr = (LAS float*)(F.lds + F.wave * 16896); LAS float* fnl = scr + 64 * 33;
    { const GAS float* fnw = (const GAS float*)INP(15) + l * DM;
#pragma unroll
      for (int i = 0; i < 4; ++i) *(LAS f32x4*)(fnl + 4 * (i * 64 + lane)) = *(const GAS f32x4*)(fnw + 4 * (i * 64 + lane)); }
    LDS_WAIT(); asm volatile("" ::: "memory");
    constexpr int EC_D = 4;
    int its[EC_D]; f32x4 v[EC_D][8];
#define EC_ISSUE(s, IT) do { its[s] = (IT); const bool ok_ = its[s] < NIT; TrDesc di_ = expert_item(F, l, ok_ ? its[s] : gw); if (!ok_) { di_.src = INP(15); di_.ldw = 0; } \
        const unsigned vo_ = (unsigned)(((lane >> 3) * di_.ldw + 4 * (lane & 7)) * 4);     \
        _Pragma("unroll") for (int i = 0; i < 8; ++i) v[s][i] = __builtin_nontemporal_load((const GAS f32x4*)((const GAS char*)(di_.src + (size_t)(8 * i) * di_.ldw) + vo_)); } while (0)
#pragma unroll
    for (int s = 0; s < EC_D; ++s) EC_ISSUE(s, gw + s * NGW);
    for (int it = gw; it < NIT; it += EC_D * NGW) {
#pragma unroll
        for (int s = 0; s < EC_D; ++s) {
            if (its[s] < NIT) { const TrDesc dd = expert_item(F, l, its[s]); const unsigned vd = (unsigned)(((lane >> 3) * dd.ldt + 8 * (lane & 7)) * 2);
#pragma unroll
                for (int i = 0; i < 8; ++i) { const int kk = 8 * i + (lane >> 3); const float sc = dd.scale ? fnl[dd.k0 + kk] : 1.0f; LAS float* q = scr + kk * 33 + 4 * (lane & 7);
                    q[0] = v[s][i][0] * sc; q[1] = v[s][i][1] * sc; q[2] = v[s][i][2] * sc; q[3] = v[s][i][3] * sc; }
                LDS_WAIT(); asm volatile("" ::: "memory");
                const int c = lane & 7;
#pragma unroll
                for (int j = 0; j < 4; ++j) { const int n = (lane >> 3) + 8 * j; const LAS float* sp = scr + (8 * c) * 33 + n;
                    v4u o; o.x = pk2(sp[0 * 33], sp[1 * 33]); o.y = pk2(sp[2 * 33], sp[3 * 33]); o.z = pk2(sp[4 * 33], sp[5 * 33]); o.w = pk2(sp[6 * 33], sp[7 * 33]);
                    st16s_hidden(vd, dd.dst + (size_t)(8 * j) * dd.ldt, o); }
                LDS_WAIT(); asm volatile("" ::: "memory");
            }
            EC_ISSUE(s, it + (s + EC_D) * NGW);
        }
    }
#undef EC_ISSUE
    asm volatile("s_waitcnt vmcnt(0)" ::: "memory");
}

template <int MODE> __device__ __forceinline__ void norm_pass(Frame& F, int l) {
    const int lane = F.lane, r16 = lane & 15, q4 = lane >> 4;
    const int gw = F.vcu * NWAVES + F.wave, NGW = F.G * NWAVES;
    constexpr int NCT = (MODE == 1) ? 3 : (MODE == 3 ? 0 : 1);
    const GAS float* Wt = (MODE == 1) ? WSG(float, WS_WRT) + (size_t)l * 48 * 1024 : WSG(float, WS_WBA) + (size_t)l * 16 * 1024;
    GAS float* rstd_out = WSG(float, MODE == 1 ? WS_RSTD2 : (MODE == 3 ? WS_RSTDF : WS_RSTD1));
    GAS bf16* XB = WSG(bf16, WS_XB);
    const GAS bf16* YB = WSG(bf16, WS_XG);
    int tb = 0;
    if (MODE >= 2) {
        const int lp = (MODE == 2) ? l - 1 : NLAYER - 1;
        const int cnt = lane < 32 ? (int)F.ctl[CW_CNT + 64 * lp + lane] : 0; const int nt = (cnt + 255) >> 8; int inc = nt;
#pragma unroll
        for (int o = 1; o < 32; o <<= 1) { const int t = SHFL_UP(inc, o); if (lane >= o) inc += t; }
        tb = inc - nt;
    }
    LAS float* scr = (LAS float*)(F.lds + F.wave * 16384 + 12288);
    for (int tile = gw; tile < TOK / 16; tile += NGW) {
        const int row = tile * 16 + r16;
        const GAS float* src = (const GAS float*)INP(0) + (size_t)row * DM + 16 * q4;
        GAS float* dst = (GAS float*)F.out + (size_t)row * DM + 16 * q4;
        const GAS bf16* xb = XB + (size_t)row * DM + 16 * q4;
        size_t y1 = 0, y2 = 0;
        if (MODE >= 2) { const GAS int* ts = WSG(int, WS_TSLOT) + row * 2; const int s1 = ts[0], s2 = ts[1];
            const int b1 = SHFL(tb, s1 >> 15), b2 = SHFL(tb, s2 >> 15);
            y1 = ((size_t)b1 * 256 + (s1 & 32767)) * DM + 16 * q4; y2 = ((size_t)b2 * 256 + (s2 & 32767)) * DM + 16 * q4; }
        f32x4 acc[NCT > 0 ? NCT : 1];
#pragma unroll
        for (int c = 0; c < (NCT > 0 ? NCT : 1); ++c) acc[c] = (f32x4){0.f, 0.f, 0.f, 0.f};
        float ss = 0.f;
        f32x4 vv[2][2][4]; v4u xa[2][2][2]; v4u ya[2][2][4];
#define NP_LOAD(B, KB) do { _Pragma("unroll") for (int gq = 0; gq < 2; ++gq) { const int kb_ = (KB) + 64 * gq; \
            if (MODE == 0) { _Pragma("unroll") for (int i = 0; i < 4; ++i) vv[B][gq][i] = __builtin_nontemporal_load((const GAS f32x4*)(src + kb_ + 4 * i)); } \
            else { xa[B][gq][0] = *(const GAS v4u*)(xb + kb_); xa[B][gq][1] = *(const GAS v4u*)(xb + kb_ + 8); } \
            if (MODE >= 2) { ya[B][gq][0] = __builtin_nontemporal_load((const GAS v4u*)(YB + y1 + kb_)); ya[B][gq][1] = __builtin_nontemporal_load((const GAS v4u*)(YB + y1 + kb_ + 8)); \
                             ya[B][gq][2] = __builtin_nontemporal_load((const GAS v4u*)(YB + y2 + kb_)); ya[B][gq][3] = __builtin_nontemporal_load((const GAS v4u*)(YB + y2 + kb_ + 8)); } } } while (0)
#define NP_TRIP(B, KB0, PF) do { const int kb0 = (KB0); \
            f32x4 wv[2][NCT > 0 ? NCT : 1][4]; \
            _Pragma("unroll") for (int gq = 0; gq < 2; ++gq) _Pragma("unroll") for (int c = 0; c < NCT; ++c) _Pragma("unroll") for (int i = 0; i < 4; ++i) \
                wv[gq][c][i] = *(const GAS f32x4*)(Wt + (size_t)(c * 16 + r16) * DM + kb0 + 64 * gq + 16 * q4 + 4 * i); \
            __builtin_amdgcn_sched_barrier(0); \
            if (PF) NP_LOAD((B) ^ 1, kb0 + 128); \
            __builtin_amdgcn_sched_barrier(0);     \
            _Pragma("unroll") for (int gq = 0; gq < 2; ++gq) { const int kb = kb0 + 64 * gq; \
                f32x4 v[4]; \
                if (MODE == 0) { _Pragma("unroll") for (int i = 0; i < 4; ++i) v[i] = vv[B][gq][i]; } \
                else { const v4u x0 = xa[B][gq][0], x1 = xa[B][gq][1]; \
                    v[0] = (f32x4){bflo(x0.x), bfhi(x0.x), bflo(x0.y), bfhi(x0.y)}; v[1] = (f32x4){bflo(x0.z), bfhi(x0.z), bflo(x0.w), bfhi(x0.w)}; \
                    v[2] = (f32x4){bflo(x1.x), bfhi(x1.x), bflo(x1.y), bfhi(x1.y)}; v[3] = (f32x4){bflo(x1.z), bfhi(x1.z), bflo(x1.w), bfhi(x1.w)}; } \
                if (MODE >= 2) { \
                    const v4u a0 = ya[B][gq][0], a1 = ya[B][gq][1], b0 = ya[B][gq][2], b1 = ya[B][gq][3]; \
                    v[0] += (f32x4){bflo(a0.x) + bflo(b0.x), bfhi(a0.x) + bfhi(b0.x), bflo(a0.y) + bflo(b0.y), bfhi(a0.y) + bfhi(b0.y)}; \
                    v[1] += (f32x4){bflo(a0.z) + bflo(b0.z), bfhi(a0.z) + bfhi(b0.z), bflo(a0.w) + bflo(b0.w), bfhi(a0.w) + bfhi(b0.w)}; \
                    v[2] += (f32x4){bflo(a1.x) + bflo(b1.x), bfhi(a1.x) + bfhi(b1.x), bflo(a1.y) + bflo(b1.y), bfhi(a1.y) + bfhi(b1.y)}; \
                    v[3] += (f32x4){bflo(a1.z) + bflo(b1.z), bfhi(a1.z) + bfhi(b1.z), bflo(a1.w) + bflo(b1.w), bfhi(a1.w) + bfhi(b1.w)}; \
                } \
                _Pragma("unroll") for (int i = 0; i < 4; ++i) ss += (v[i][0] * v[i][0] + v[i][1] * v[i][1]) + (v[i][2] * v[i][2] + v[i][3] * v[i][3]); \
                if (MODE == 0 || MODE == 2) { \
                    v4u o0, o1; o0.x = pk2(v[0][0], v[0][1]); o0.y = pk2(v[0][2], v[0][3]); o0.z = pk2(v[1][0], v[1][1]); o0.w = pk2(v[1][2], v[1][3]); \
                    o1.x = pk2(v[2][0], v[2][1]); o1.y = pk2(v[2][2], v[2][3]); o1.z = pk2(v[3][0], v[3][1]); o1.w = pk2(v[3][2], v[3][3]); \
                    GAS bf16* xo = XB + (size_t)row * DM + 16 * q4 + kb; st16_hidden(xo, o0); st16_hidden(xo + 8, o1); \
                } \
                _Pragma("unroll") for (int c = 0; c < NCT; ++c) _Pragma("unroll") for (int i = 0; i < 4; ++i) _Pragma("unroll") for (int e = 0; e < 4; ++e) \
                    acc[c] = __builtin_amdgcn_mfma_f32_16x16x4f32(v[i][e], wv[gq][c][i][e], acc[c], 0, 0, 0); \
            } } while (0)
        NP_LOAD(0, 0);
#pragma unroll 1
        for (int kbq = 0; kbq < DM - 256; kbq += 256) { NP_TRIP(0, kbq, true); NP_TRIP(1, kbq + 128, true); }
        NP_TRIP(0, DM - 256, true); NP_TRIP(1, DM - 128, false);
#undef NP_LOAD
#undef NP_TRIP
        ss += SHFL_XOR(ss, 16); ss += SHFL_XOR(ss, 32);
        const float rstd = 1.0f / sqrtf(ss * (1.0f / DM) + EPS);
        if (q4 == 0) rstd_out[row] = rstd;
        if (MODE == 3) {
            const GAS float* fw = (const GAS float*)INP(23) + 16 * q4;
#pragma unroll 2
            for (int kb = 0; kb < DM; kb += 64) {
                const v4u x0 = *(const GAS v4u*)(xb + kb), x1 = *(const GAS v4u*)(xb + kb + 8);
                const v4u a0 = *(const GAS v4u*)(YB + y1 + kb), a1 = *(const GAS v4u*)(YB + y1 + kb + 8), b0 = *(const GAS v4u*)(YB + y2 + kb), b1 = *(const GAS v4u*)(YB + y2 + kb + 8);
                f32x4 wv[4];
#pragma unroll
                for (int i = 0; i < 4; ++i) wv[i] = *(const GAS f32x4*)(fw + kb + 4 * i);
                f32x4 v[4];
                v[0] = (f32x4){bflo(x0.x), bfhi(x0.x), bflo(x0.y), bfhi(x0.y)}; v[1] = (f32x4){bflo(x0.z), bfhi(x0.z), bflo(x0.w), bfhi(x0.w)};
                v[2] = (f32x4){bflo(x1.x), bfhi(x1.x), bflo(x1.y), bfhi(x1.y)}; v[3] = (f32x4){bflo(x1.z), bfhi(x1.z), bflo(x1.w), bfhi(x1.w)};
                v[0] += (f32x4){bflo(a0.x) + bflo(b0.x), bfhi(a0.x) + bfhi(b0.x), bflo(a0.y) + bflo(b0.y), bfhi(a0.y) + bfhi(b0.y)};
                v[1] += (f32x4){bflo(a0.z) + bflo(b0.z), bfhi(a0.z) + bfhi(b0.z), bflo(a0.w) + bflo(b0.w), bfhi(a0.w) + bfhi(b0.w)};
                v[2] += (f32x4){bflo(a1.x) + bflo(b1.x), bfhi(a1.x) + bfhi(b1.x), bflo(a1.y) + bflo(b1.y), bfhi(a1.y) + bfhi(b1.y)};
                v[3] += (f32x4){bflo(a1.z) + bflo(b1.z), bfhi(a1.z) + bfhi(b1.z), bflo(a1.w) + bflo(b1.w), bfhi(a1.w) + bfhi(b1.w)};
#pragma unroll
                for (int i = 0; i < 4; ++i) st16_hidden(dst + kb + 4 * i, v[i] * rstd * wv[i]);
            }
        }
        float rr[4];
#pragma unroll
        for (int g = 0; g < 4; ++g) rr[g] = SHFL(rstd, q4 * 4 + g);
        if (MODE == 0 || MODE == 2) { GAS float* ba = WSG(float, WS_BA);
#pragma unroll
            for (int g = 0; g < 4; ++g) ba[(size_t)(tile * 16 + q4 * 4 + g) * 16 + r16] = acc[0][g] * rr[g]; }
        if (MODE == 1) {
#pragma unroll
            for (int c = 0; c < NCT; ++c) { const int col = c * 16 + r16; float bias = 0.f; if (col < 4) bias = ((const GAS float*)INP(17))[l * 4 + col]; else if (col < 36) bias = ((const GAS float*)INP(19))[l * 32 + col - 4];
#pragma unroll
                for (int g = 0; g < 4; ++g) scr[(q4 * 4 + g) * 48 + col] = acc[c][g] * rr[g] + bias; }
            LDS_WAIT(); asm volatile("" ::: "memory");
            if (lane < 16) {
                const LAS float* lg = scr + lane * 48; const int t = tile * 16 + lane;
                int gi = 0; float gm = lg[0];
#pragma unroll
                for (int j = 1; j < 4; ++j) if (lg[j] > gm) { gm = lg[j]; gi = j; }
                float gs = 0.f;
#pragma unroll
                for (int j = 0; j < 4; ++j) gs += __expf(lg[j] - gm);
                const float gp = 1.0f / gs;
                const LAS float* el = lg + 4 + gi * 8;
                int i1 = 0; float m1 = el[0];
#pragma unroll
                for (int j = 1; j < 8; ++j) if (el[j] > m1) { m1 = el[j]; i1 = j; }
                int i2 = -1; float m2 = -3.0e38f;
#pragma unroll
                for (int j = 0; j < 8; ++j) if (j != i1 && el[j] > m2) { m2 = el[j]; i2 = j; }
                const float p2 = __expf(m2 - m1), w1 = gp / (1.0f + p2), w2 = gp * p2 / (1.0f + p2);
                const int E1 = gi * 8 + i1, E2 = gi * 8 + i2;
                GAS unsigned* cnt = (GAS unsigned*)(F.ctl + CW_CNT + 64 * l);
                const int p1 = (int)__hip_atomic_fetch_add(cnt + E1, 1u, __ATOMIC_RELAXED, __HIP_MEMORY_SCOPE_AGENT), pp2 = (int)__hip_atomic_fetch_add(cnt + E2, 1u, __ATOMIC_RELAXED, __HIP_MEMORY_SCOPE_AGENT);
                GAS int* tokl = WSG(int, WS_TOKL); GAS float* wl = WSG(float, WS_WL); GAS int* ts = WSG(int, WS_TSLOT);
                tokl[E1 * 32768 + p1] = t; wl[E1 * 32768 + p1] = w1; ts[t * 2] = (E1 << 15) | p1;
                tokl[E2 * 32768 + pp2] = t; wl[E2 * 32768 + pp2] = w2; ts[t * 2 + 1] = (E2 << 15) | pp2;
            }
            LDS_WAIT(); asm volatile("" ::: "memory");
        }
    }
}

__device__ __forceinline__ void unpack8(const v4u w, float (&x)[8]) { x[0] = bflo(w.x); x[1] = bfhi(w.x); x[2] = bflo(w.y); x[3] = bfhi(w.y); x[4] = bflo(w.z); x[5] = bfhi(w.z); x[6] = bflo(w.w); x[7] = bfhi(w.w); }
__device__ __forceinline__ v4u pack8(const float (&x)[8]) { v4u w; w.x = pk2(x[0], x[1]); w.y = pk2(x[2], x[3]); w.z = pk2(x[4], x[5]); w.w = pk2(x[6], x[7]); return w; }
__device__ __forceinline__ void rope_pass(Frame& F, int l) {
    const int lane = F.lane, jl = lane & 7;
    const int gw = F.vcu * NWAVES + F.wave, NGW = F.G * NWAVES;
    const float* c1 = WSP(float, WS_COS1); const float* s1 = WSP(float, WS_SIN1); const float* ax = WSP(float, WS_AX);
    bf16* PP = WSP(bf16, WS_PP);
    float qnw[8], knw[8];
#pragma unroll
    for (int e = 0; e < 8; ++e) { qnw[e] = INP(9)[l * 64 + 8 * jl + e]; knw[e] = INP(10)[l * 64 + 8 * jl + e]; }
    for (int t = gw; t < TOK; t += NGW) {
        const int s = t & (SEQ - 1); bf16* prow = PP + (size_t)t * PPW;
        float cs[8], sn[8];
        { const f32x4 ca = *(const f32x4*)(c1 + s * 32 + 8 * (jl & 3)), cb = *(const f32x4*)(c1 + s * 32 + 8 * (jl & 3) + 4), sa = *(const f32x4*)(s1 + s * 32 + 8 * (jl & 3)), sb = *(const f32x4*)(s1 + s * 32 + 8 * (jl & 3) + 4);
#pragma unroll
          for (int e = 0; e < 4; ++e) { cs[e] = ca[e]; cs[4 + e] = cb[e]; sn[e] = sa[e]; sn[4 + e] = sb[e]; } }
#pragma unroll
        for (int which = 0; which < 2; ++which) {
            bf16* p = prow + (which == 0 ? PC_DQ : PC_DK) + 8 * lane; float x[8], o[8]; unpack8(*(const v4u*)p, x);
#pragma unroll
            for (int e = 0; e < 8; ++e) { const float pv = SHFL_XOR(x[e], 4); o[e] = (jl < 4) ? x[e] * cs[e] - pv * sn[e] : x[e] * cs[e] + pv * sn[e]; if (which == 0) o[e] *= QSCALE; }
            *(v4u*)p = pack8(o);
        }
        float ac[8], as[8];
        { const float* tbc = (jl < 4) ? ax + (s >> 6) * 16 : ax + 4096 + (s & 63) * 16; const float* tbs = (jl < 4) ? ax + 2048 + (s >> 6) * 16 : ax + 5120 + (s & 63) * 16;
          const f32x4 ca = *(const f32x4*)(tbc + 8 * (jl & 1)), cb = *(const f32x4*)(tbc + 8 * (jl & 1) + 4), sa = *(const f32x4*)(tbs + 8 * (jl & 1)), sb = *(const f32x4*)(tbs + 8 * (jl & 1) + 4);
#pragma unroll
          for (int e = 0; e < 4; ++e) { ac[e] = ca[e]; ac[4 + e] = cb[e]; as[e] = sa[e]; as[4 + e] = sb[e]; } }
#pragma unroll
        for (int which = 0; which < 2; ++which) {
            bf16* p = prow + (which == 0 ? PC_CQ + 8 * lane : PC_CK + 8 * (lane & 15)); float x[8], o[8]; unpack8(*(const v4u*)p, x);
            float ssq = 0.f;
#pragma unroll
            for (int e = 0; e < 8; ++e) ssq += x[e] * x[e];
            ssq += SHFL_XOR(ssq, 1); ssq += SHFL_XOR(ssq, 2); ssq += SHFL_XOR(ssq, 4);
            const float rn = 1.0f / sqrtf(ssq * (1.0f / 64.0f) + EPS);
#pragma unroll
            for (int e = 0; e < 8; ++e) x[e] = x[e] * rn * (which == 0 ? qnw[e] : knw[e]);
#pragma unroll
            for (int e = 0; e < 8; ++e) { const float pv = SHFL_XOR(x[e], 2); o[e] = ((jl & 3) < 2) ? x[e] * ac[e] - pv * as[e] : x[e] * ac[e] + pv * as[e]; if (which == 0) o[e] *= QSCALE; }
            if (which == 0 || lane < 16) *(v4u*)p = pack8(o);
        }
    }
}

__host__ __device__ __forceinline__ constexpr int frag_off(int row, int col, int C) { return (((row >> 4) * (C / 32) + (col >> 5)) * 64 + ((col >> 3) & 3) * 16 + (row & 15)) * 8 + (col & 7); }
constexpr int CK_KS = 0, CK_QS = 17408, CK_L0 = 34816, CK_L1 = 52224, CK_BET = 69632, CK_GCS = 70144, CK_BYTES = 70656;
constexpr int SOLVE_PF = 8;
constexpr int solve_ns() { int s = 0; for (int i = 0; i < 63; ++i) s += 16 - (i + 1) / 4; return s; }
constexpr int SOLVE_NS = solve_ns();
constexpr int solve_si(int s) { int i = 0; for (; i < 63; ++i) { const int n = 16 - (i + 1) / 4; if (s < n) break; s -= n; } return i; }
constexpr int solve_sq(int s) { int i = 0; for (; i < 63; ++i) { const int n = 16 - (i + 1) / 4; if (s < n) break; s -= n; } return (i + 1) / 4 + s; }
template <int S> __device__ __forceinline__ void solve_slot(float (&m)[64], f32x4 (&ring)[SOLVE_PF], const LAS float* Lm) {
    constexpr int i = solve_si(S), lq = solve_sq(S);
    const f32x4 Lv = ring[S % SOLVE_PF];
    if constexpr (S + SOLVE_PF < SOLVE_NS) { constexpr int i2 = solve_si(S + SOLVE_PF), q2 = solve_sq(S + SOLVE_PF); ring[S % SOLVE_PF] = *(const LAS f32x4*)(Lm + i2 * 68 + 4 * q2); }
#pragma unroll
    for (int e = 0; e < 4; ++e) if (4 * lq + e > i) m[4 * lq + e] -= Lv[e] * m[i];
    __builtin_amdgcn_sched_barrier(0);
}
template <int... Is> __device__ __forceinline__ void solve_run(float (&m)[64], f32x4 (&ring)[SOLVE_PF], const LAS float* Lm, std::integer_sequence<int, Is...>) { (solve_slot<Is>(m, ring, Lm), ...); }
__device__ __forceinline__ void chunk_solve(Frame& F, LAS unsigned char* ldsc, int d, int cid, int j) {
    const LAS float* Lm = (const LAS float*)(ldsc + (d == 0 ? CK_L0 : CK_L1));
    const LAS float* bet = (const LAS float*)(ldsc + CK_BET);
    const float bj = bet[d * 64 + (d == 0 ? j : 63 - j)];
    float m[64];
#pragma unroll
    for (int i = 0; i < 64; ++i) m[i] = 0.f;
    { int jj = j; asm volatile("" : "+v"(jj));
#pragma unroll
      for (int i = 0; i < 64; ++i) m[i] = (i == jj) ? bj : 0.f; }
    f32x4 ring[SOLVE_PF];
#pragma unroll
    for (int k = 0; k < SOLVE_PF; ++k) ring[k] = *(const LAS f32x4*)(Lm + solve_si(k) * 68 + 4 * solve_sq(k));
    solve_run(m, ring, Lm, std::make_integer_sequence<int, SOLVE_NS>{});
    LAS unsigned short* Mi = (LAS unsigned short*)(ldsc + (d == 0 ? CK_L0 : CK_L1));
    if (d == 0) {
        LAS unsigned short* mp = Mi + j;
#pragma unroll
        for (int i = 0; i < 64; ++i) mp[i * 72] = (unsigned short)(pk2(m[i], 0.f) & 0xffffu);
    } else {
        LAS unsigned short* mp = Mi + (63 - j);
#pragma unroll
        for (int i = 0; i < 64; ++i) mp[(63 - i) * 72] = (unsigned short)(pk2(m[i], 0.f) & 0xffffu);
    }
    LDS_WAIT(); asm volatile("" ::: "memory");
    GAS bf16* mt = WSG(bf16, WS_MM) + ((size_t)d * 2048 + cid) * 4096;
#pragma unroll
    for (int t = 0; t < 8; ++t) { const int row = (t >> 1) * 16 + (j & 15), col0 = (t & 1) * 32 + (j >> 4) * 8;
        const v4u v = *(const LAS v4u*)(Mi + row * 72 + col0); *(GAS v4u*)(mt + (t * 64 + j) * 8) = v; }
}
template <int PV> __device__ __forceinline__ void chunk_phase(Frame& F, int l) {
    const int w = F.wave, hb = w >> 2, ww = w & 3;
    const GAS float* convw = (const GAS float*)(INP(3) + l * 5 * 1536); const GAS float* alog = (const GAS float*)(INP(4) + l * 8); const GAS float* dtb = (const GAS float*)(INP(5) + l * 8);
    const GAS bf16* RAW = WSG(bf16, WS_RAW); const GAS float* BA = WSG(float, WS_BA);
    LAS unsigned char* lds = F.lds + hb * CK_BYTES;
    LAS float* bet = (LAS float*)(lds + CK_BET); LAS float* gcs = (LAS float*)(lds + CK_GCS);
    for (int pu = blockIdx.x; pu < 1024; pu += F.G) {
        const int cid = 2 * pu + hb;
        const int c = cid & 127, bh = cid >> 7, h = bh & 3, b = bh >> 2;
        const int t0 = b * SEQ + c * 64;
        int lane = F.lane; asm volatile("" : "+v"(lane));
        const int r16 = lane & 15, q4 = lane >> 4;
        { const int rb0 = 16 * ww;
          unsigned rw[3][20]; float cw0[3][5], cw1[3][5];
#pragma unroll
          for (int p = 0; p < 3; ++p) { const int col = p * 512 + h * 128 + 2 * lane;
#pragma unroll
            for (int tp = 0; tp < 5; ++tp) { cw0[p][tp] = convw[tp * 1536 + col]; cw1[p][tp] = convw[tp * 1536 + col + 1]; }
#pragma unroll
            for (int jr = 0; jr < 20; ++jr) { const int s = c * 64 + rb0 + jr - 2; unsigned u = 0u; if (s >= 0 && s < SEQ) u = *(const GAS unsigned*)(RAW + (size_t)(b * SEQ + s) * 1536 + col); rw[p][jr] = u; } }
#pragma unroll
          for (int p = 0; p < 3; ++p) {
            GAS bf16* gdst = WSG(bf16, WS_VC) + (size_t)cid * 8192 + ((rb0 >> 2) * 128 + 2 * lane) * 4;
            unsigned vq[4];
#pragma unroll
            for (int jr = 0; jr < 16; ++jr) {
                float a0 = 0.f, a1 = 0.f;
#pragma unroll
                for (int tp = 0; tp < 5; ++tp) { a0 += cw0[p][tp] * bflo(rw[p][jr + tp]); a1 += cw1[p][tp] * bfhi(rw[p][jr + tp]); }
                a0 = a0 * sigm(a0); a1 = a1 * sigm(a1);
                if (p < 2) { const float ssq = wave_sum(a0 * a0 + a1 * a1, lane); float rn = __builtin_amdgcn_rsqf(ssq + EPS); if (p == 0) rn *= 0.08838834764831845f; a0 *= rn; a1 *= rn; }
                const unsigned pk = pk2(a0, a1); const int row = rb0 + jr;
                if (p == 2) { vq[jr & 3] = pk;
                    if ((jr & 3) == 3) { v4u o; o.x = (vq[0] & 0xffffu) | (vq[1] << 16); o.y = (vq[2] & 0xffffu) | (vq[3] << 16); o.z = (vq[0] >> 16) | (vq[1] & 0xffff0000u); o.w = (vq[2] >> 16) | (vq[3] & 0xffff0000u);
                        *(GAS v4u*)(gdst + (jr >> 2) * 512) = o; } }
                if (p == 0) *(LAS unsigned*)(lds + CK_QS + row * 272 + 4 * lane) = pk;
                if (p == 1) *(LAS unsigned*)(lds + CK_KS + row * 272 + 4 * lane) = pk;
            }
          } }
        if (ww < 2) { const int d = ww, tn = d == 0 ? lane : 63 - lane; const size_t tok = (size_t)(t0 + tn);
            const float braw = BA[tok * 16 + d * 4 + h], araw = BA[tok * 16 + 8 + d * 4 + h];
            const float x = araw + dtb[d * 4 + h]; const float sp = fmaxf(x, 0.f) + log1pf(__expf(-fabsf(x)));
            float gc = -__expf(alog[d * 4 + h]) * sp;
#pragma unroll
            for (int o = 1; o < 64; o <<= 1) { const float tv = SHFL_UP(gc, o); if (lane >= o) gc += tv; }
            bet[d * 64 + tn] = sigm(braw); gcs[d * 64 + tn] = gc;
            WSG(float, WS_GC)[((size_t)d * 2048 + cid) * 64 + tn] = gc; }
        LBAR();
        { GAS bf16* KNt = WSG(bf16, WS_KN) + (size_t)cid * 8192; GAS bf16* QNt = WSG(bf16, WS_QN) + (size_t)cid * 8192;
#pragma unroll
          for (int it = 0; it < 4; ++it) { const int lo = (it * 16 + r16) * 272 + (ww * 32 + q4 * 8) * 2, P = (it * 4 + ww) * 64 + lane;
              const v4u kq = *(const LAS v4u*)(lds + CK_KS + lo), qq = *(const LAS v4u*)(lds + CK_QS + lo);
              *(GAS v4u*)(KNt + P * 8) = kq; *(GAS v4u*)(QNt + P * 8) = qq; } }
        { const int ti = ww;
          GAS bf16* I0 = WSG(bf16, WS_INTRA) + ((size_t)0 * 2048 + cid) * 4096; GAS bf16* I1 = WSG(bf16, WS_INTRA) + ((size_t)1 * 2048 + cid) * 4096;
          LAS float* L0 = (LAS float*)(lds + CK_L0); LAS float* L1 = (LAS float*)(lds + CK_L1);
          const int iq = ti * 16 + r16; const float gq0 = gcs[iq], gq1 = gcs[64 + iq];
#pragma unroll 1
          for (int tj = 0; tj < 4; ++tj) {
            f32x4 aK = (f32x4){0.f, 0.f, 0.f, 0.f}, aQ = (f32x4){0.f, 0.f, 0.f, 0.f};
#pragma unroll
            for (int kk = 0; kk < 4; ++kk) { const bf16x8 fk = *(const LAS bf16x8*)(lds + CK_KS + (ti * 16 + r16) * 272 + kk * 64 + q4 * 16), fq = *(const LAS bf16x8*)(lds + CK_QS + (ti * 16 + r16) * 272 + kk * 64 + q4 * 16),
                                                            fb = *(const LAS bf16x8*)(lds + CK_KS + (tj * 16 + r16) * 272 + kk * 64 + q4 * 16);
                aK = mfma16(fk, fb, aK); aQ = mfma16(fb, fq, aQ); }
            const int jn = tj * 16 + r16; const float g0j = gcs[jn], g1j = gcs[64 + jn];
#pragma unroll
            for (int r = 0; r < 4; ++r) { const int in = ti * 16 + q4 * 4 + r;
                const float e0 = __expf(fminf(gcs[in] - g0j, 0.f)), e1 = __expf(fminf(gcs[64 + in] - g1j, 0.f));
                L0[jn * 68 + in] = (in > jn) ? bet[in] * aK[r] * e0 : 0.f;
                L1[(63 - jn) * 68 + (63 - in)] = (in < jn) ? bet[64 + in] * aK[r] * e1 : 0.f; }
            float v0[4], v1[4];
#pragma unroll
            for (int r = 0; r < 4; ++r) { const int jq = tj * 16 + q4 * 4 + r;
                const float e0 = __expf(fminf(gq0 - gcs[jq], 0.f)), e1 = __expf(fminf(gq1 - gcs[64 + jq], 0.f));
                v0[r] = (iq >= jq) ? aQ[r] * e0 : 0.f; v1[r] = (iq <= jq) ? aQ[r] * e1 : 0.f; }
            const int ib = frag_off(iq, tj * 16 + q4 * 4, 64);
            v2u o0, o1; o0.x = pk2(v0[0], v0[1]); o0.y = pk2(v0[2], v0[3]); o1.x = pk2(v1[0], v1[1]); o1.y = pk2(v1[2], v1[3]);
            *(GAS v2u*)(I0 + ib) = o0; *(GAS v2u*)(I1 + ib) = o1;
          } }
        LBAR();
        const int role = (ww + 2 * hb) & 3;
        if (role < 2) { if (!(PV & 1)) chunk_solve(F, lds, role, cid, lane); }
        LBAR();
    }
}

typedef short s16x4 __attribute__((ext_vector_type(4)));
__device__ __forceinline__ s16x4 sc_tr(const LAS unsigned char* p) { return __builtin_bit_cast(s16x4, __builtin_amdgcn_ds_read_tr16_b64_v4i16((LAS s16x4*)p)); }
#ifndef SC_NST
#define SC_NST 6
#endif
#ifndef SCAN_CS
#define SCAN_CS 1
#endif
static_assert(SCAN_CS == 1, "the token-quad v layout is wired for 16-column slices");
constexpr int SC_CS = SCAN_CS, SC_NITEM = 32 * (8 / SC_CS), SC_STRIDE = 256 / SC_NITEM, SC_ST = 0, SC_RT = SC_CS * 4352, SC_VT = SC_RT + SC_CS * 2304, SC_VTS = SC_VT + SC_CS * 2304, SC_LDS = SC_VTS + SC_CS * 2304, SC_KI = SC_LDS, SC_KIP = 288;
template <int VAR> __device__ __forceinline__ void scan_phase(Frame& F) {
    const int lane = F.lane, w = F.wave, wl = w & 3, r16 = lane & 15, q4 = lane >> 4;
    LAS unsigned char* lds = F.lds;
    const GAS bf16* KN = WSG(bf16, WS_KN); const GAS bf16* KT = WSG(bf16, WS_KT); const GAS bf16* QN = WSG(bf16, WS_QN); const GAS bf16* VC = WSG(bf16, WS_VC);
    const GAS bf16* MMp = WSG(bf16, WS_MM); const GAS bf16* INp = WSG(bf16, WS_INTRA); const GAS float* GC = WSG(float, WS_GC);
    if ((F.vcu % SC_STRIDE) != 0) return;
    for (int item = F.vcu / SC_STRIDE; item < SC_NITEM; item += F.G / SC_STRIDE) {
        const int chain = item / (8 / SC_CS), d = chain >> 4, b = (chain >> 2) & 3, h = chain & 3, dv0 = (item % (8 / SC_CS)) * (16 * SC_CS);
        for (int i = F.tid; i < SC_LDS / 4; i += NWAVES * 64) ((LAS unsigned*)lds)[i] = 0u;
        f32x4 Sacc[SC_CS];
#pragma unroll
        for (int cs = 0; cs < SC_CS; ++cs) Sacc[cs] = (f32x4){0.f, 0.f, 0.f, 0.f};
        GAS bf16* Og = WSG(bf16, d == 0 ? WS_OF : WS_OB);
        __syncthreads();
        constexpr int NST = SC_NST;
        bf16x8 sA4[NST][4], sA2[NST][2]; f32x4 sgc[NST]; float sgl[NST]; v2u svq[NST];
#define SC_LOAD(st, n) do { const int c_ = d == 0 ? (n) : 127 - (n); const size_t cid_ = (size_t)(b * 4 + h) * 128 + c_; const size_t dc_ = (size_t)d * 2048 + cid_; \
        const GAS bf16* a4_ = (w < 4 ? KN : QN) + cid_ * 8192 + (wl * 4 * 64 + lane) * 8; \
        const GAS bf16* a2_ = (w < 4 ? MMp : INp) + dc_ * 4096 + (wl * 2 * 64 + lane) * 8; \
        _Pragma("unroll") for (int kk = 0; kk < 4; ++kk) sA4[st][kk] = *(const GAS bf16x8*)(a4_ + kk * 512); \
        _Pragma("unroll") for (int kk = 0; kk < 2; ++kk) sA2[st][kk] = *(const GAS bf16x8*)(a2_ + kk * 512); \
        sgc[st] = *(const GAS f32x4*)(GC + dc_ * 64 + 16 * wl + q4 * 4); sgl[st] = GC[dc_ * 64 + (d == 0 ? 63 : 0)]; \
        svq[st] = *(const GAS v2u*)(VC + cid_ * 8192 + ((4 * wl + q4) * 128 + dv0 + r16) * 4); } while (0)
#pragma unroll
        for (int st0 = 0; st0 < NST - 1; ++st0) SC_LOAD(st0, st0);
        for (int n0 = 0; n0 < 128; n0 += NST) {
#pragma unroll
          for (int j = 0; j < NST; ++j) {
            const int n = n0 + j; if (n >= 128) break;
            {
            const f32x4 gcv = sgc[j]; const float gl = sgl[j];
            const int c = d == 0 ? n : 127 - n; const int t0 = b * SEQ + c * 64;
            if (w < 4) {
#pragma unroll
                for (int kk = 0; kk < 4; ++kk) *(LAS bf16x8*)(lds + SC_KI + (16 * wl + r16) * SC_KIP + (kk * 32 + 8 * q4) * 2) = sA4[j][kk]; }
            f32x4 ks[SC_CS];
#pragma unroll
            for (int cs = 0; cs < SC_CS; ++cs) { bf16x8 Bs[4];
#pragma unroll
              for (int kk = 0; kk < 4; ++kk) Bs[kk] = *(const LAS bf16x8*)(lds + SC_ST + cs * 4352 + r16 * 272 + kk * 64 + q4 * 16);
              f32x4 a = (f32x4){0.f, 0.f, 0.f, 0.f};
#pragma unroll
              for (int kk = 0; kk < 4; ++kk) a = mfma16(sA4[j][kk], Bs[kk], a);
              ks[cs] = a; }
            __builtin_amdgcn_sched_barrier(0);
            if (!(VAR & 4)) { const int np = n + NST - 1 < 128 ? n + NST - 1 : 127; SC_LOAD((j + NST - 1) % NST, np); }
            __builtin_amdgcn_sched_barrier(0);
            float eg[4];
#pragma unroll
            for (int r = 0; r < 4; ++r) eg[r] = __expf(gcv[r]);
            if (w < 4) {
#pragma unroll
                for (int cs = 0; cs < SC_CS; ++cs) { float rv[4];
#pragma unroll
                    for (int r = 0; r < 4; ++r) { const unsigned u = (r < 2) ? svq[j].x : svq[j].y; const float vv = (r & 1) ? __uint_as_float(u & 0xffff0000u) : __uint_as_float(u << 16); rv[r] = vv - eg[r] * ks[cs][r]; }
                    v2u o; o.x = pk2(rv[0], rv[1]); o.y = pk2(rv[2], rv[3]); *(LAS v2u*)(lds + SC_RT + cs * 2304 + r16 * 144 + (16 * wl + q4 * 4) * 2) = o; } }
            if (!(VAR & 2)) LBAR();
            if (w < 4) { float es[4];
#pragma unroll
                for (int r = 0; r < 4; ++r) es[r] = __expf(gl - gcv[r]);
#pragma unroll
                for (int cs = 0; cs < SC_CS; ++cs) { f32x4 vn = (f32x4){0.f, 0.f, 0.f, 0.f};
                    const bf16x8 Br0 = *(const LAS bf16x8*)(lds + SC_RT + cs * 2304 + r16 * 144 + q4 * 16), Br1 = *(const LAS bf16x8*)(lds + SC_RT + cs * 2304 + r16 * 144 + 64 + q4 * 16);
                    vn = mfma16(sA2[j][0], Br0, vn); vn = mfma16(sA2[j][1], Br1, vn);
                    v2u o; o.x = pk2(vn[0], vn[1]); o.y = pk2(vn[2], vn[3]); *(LAS v2u*)(lds + SC_VT + cs * 2304 + r16 * 144 + (16 * wl + q4 * 4) * 2) = o;
                    o.x = pk2(vn[0] * es[0], vn[1] * es[1]); o.y = pk2(vn[2] * es[2], vn[3] * es[3]); *(LAS v2u*)(lds + SC_VTS + cs * 2304 + r16 * 144 + (16 * wl + q4 * 4) * 2) = o; } }
            if (!(VAR & 2)) LBAR();
            if (w >= 4) { f32x4 o[SC_CS];
#pragma unroll
                for (int cs = 0; cs < SC_CS; ++cs) { f32x4 a;
#pragma unroll
                    for (int r = 0; r < 4; ++r) a[r] = eg[r] * ks[cs][r];
                    const bf16x8 Bv0 = *(const LAS bf16x8*)(lds + SC_VT + cs * 2304 + r16 * 144 + q4 * 16), Bv1 = *(const LAS bf16x8*)(lds + SC_VT + cs * 2304 + r16 * 144 + 64 + q4 * 16);
                    a = mfma16(sA2[j][0], Bv0, a); a = mfma16(sA2[j][1], Bv1, a); o[cs] = a; }
                if (!(VAR & 1)) {
#pragma unroll
                    for (int r = 0; r < 4; ++r) { GAS bf16* op = Og + (size_t)(t0 + 16 * wl + q4 * 4 + r) * 512 + h * 128 + dv0 + SC_CS * r16;
                        if (SC_CS == 4) { v2u ov; ov.x = pk2(o[0][r], o[1][r]); ov.y = pk2(o[SC_CS - 2][r], o[SC_CS - 1][r]); asm volatile("global_store_dwordx2 %0, %1, off" :: "v"(op), "v"(ov) : "memory"); }
                        else if (SC_CS == 2) { const unsigned ov = pk2(o[0][r], o[SC_CS - 1][r]); asm volatile("global_store_dword %0, %1, off" :: "v"(op), "v"(ov) : "memory"); }
                        else { const unsigned ov = pk2(o[0][r], 0.f); asm volatile("global_store_short %0, %1, off" :: "v"(op), "v"(ov) : "memory"); } } } }
            { const float egl = __expf(gl);
              const LAS unsigned char* kip = lds + SC_KI + (8 * q4 + (r16 >> 2)) * SC_KIP + (16 * w + 4 * (r16 & 3)) * 2;
              const s16x4 ka0 = sc_tr(kip), ka1 = sc_tr(kip + 4 * SC_KIP), kb0 = sc_tr(kip + 32 * SC_KIP), kb1 = sc_tr(kip + 36 * SC_KIP);
              const bf16x8 kt0 = (bf16x8){ka0[0], ka0[1], ka0[2], ka0[3], ka1[0], ka1[1], ka1[2], ka1[3]}, kt1 = (bf16x8){kb0[0], kb0[1], kb0[2], kb0[3], kb1[0], kb1[1], kb1[2], kb1[3]};
#pragma unroll
              for (int cs = 0; cs < SC_CS; ++cs) { f32x4 sn = Sacc[cs] * egl;
                const bf16x8 Bvs0 = *(const LAS bf16x8*)(lds + SC_VTS + cs * 2304 + r16 * 144 + q4 * 16), Bvs1 = *(const LAS bf16x8*)(lds + SC_VTS + cs * 2304 + r16 * 144 + 64 + q4 * 16);
                sn = mfma16(kt0, Bvs0, sn); sn = mfma16(kt1, Bvs1, sn);
                Sacc[cs] = sn; v2u o; o.x = pk2(sn[0], sn[1]); o.y = pk2(sn[2], sn[3]); *(LAS v2u*)(lds + SC_ST + cs * 4352 + r16 * 272 + (16 * w + q4 * 4) * 2) = o; } }
            if (!(VAR & 2)) LBAR();
            }
          }
        }
#undef SC_LOAD
        __syncthreads();
    }
}

__device__ __forceinline__ int utid(const Frame& F) { int ln; asm volatile("v_mbcnt_lo_u32_b32 %0, -1, 0\n\tv_mbcnt_hi_u32_b32 %0, -1, %0" : "=v"(ln)); return F.wave * 64 + ln; }
__device__ __forceinline__ void attn_phase_all(Frame& F, int l, int ulo, int uhi, bool conv) {
    typedef attn_body::bf16 abf;
    abf* PP = (abf*)WSP(bf16, WS_PP); abf* OD = (abf*)WSP(bf16, WS_OD);
    const int slot = (F.vcu + (F.vcu >> 3)) & 7; int cnt = 0; bool pend = conv;
    for (int i = 0;; ++i) {
        const int L = ulo + i * F.G + F.vcu; if (L >= uhi || L >= 1024) break;
        if (pend && cnt == slot) { expert_convert(F, l); __syncthreads(); pend = false; } ++cnt;
        const int hd = L >> 5, qb = L & 31, b = hd >> 3, h = (hd >> 1) & 3, m = hd & 1; abf* base = PP + (size_t)b * SEQ * PPW;
        const float q2 = __uint_as_float(F.ctl[CW_NRM + 64 * l + b * 8 + (hd & 7)]), k2 = __uint_as_float(F.ctl[CW_NRM + 64 * l + 32 + b * 8 + (hd & 7)]);
        const float dbound = 1.01f * sqrtf(q2 * k2) + 0.25f;
        if (dbound <= 40.0f) attn_body::attn_unit<8, 4, true>(qb, base + PC_DQ + (h * 2 + m) * 64, base + PC_DK + (h * 2 + m) * 64, base + PC_DV + h * 128, OD + (size_t)b * SEQ * 1024 + m * 512 + h * 128, 1024, (char*)F.ldsg, utid(F), -dbound);
        else attn_body::attn_unit<8, 4, false>(qb, base + PC_DQ + (h * 2 + m) * 64, base + PC_DK + (h * 2 + m) * 64, base + PC_DV + h * 128, OD + (size_t)b * SEQ * 1024 + m * 512 + h * 128, 1024, (char*)F.ldsg, utid(F));
    }
    float sbound;
    { int lane; asm volatile("v_mbcnt_lo_u32_b32 %0, -1, 0\n\tv_mbcnt_hi_u32_b32 %0, -1, %0" : "=v"(lane)); const float wq = fabsf(((const GAS float*)INP(9))[l * 64 + lane]), wk = fabsf(((const GAS float*)INP(10))[l * 64 + lane]); float mq = wq, mk = wk;
#pragma unroll
      for (int o = 1; o < 64; o <<= 1) { mq = fmaxf(mq, SHFL_XOR(mq, o)); mk = fmaxf(mk, SHFL_XOR(mk, o)); }
      sbound = 1.02f * attn_body::C2 * 64.0f * mq * mk + 0.25f; }
    const bool fixref = sbound <= 40.0f;
    for (int i = 0;; ++i) {
        const int L = (ulo > 1024 ? ulo : 1024) + i * F.G + F.vcu; if (L >= uhi) break;
        if (pend && cnt == slot) { expert_convert(F, l); __syncthreads(); pend = false; } ++cnt;
        const int g = (L - 1024) >> 5, qb = L & 31, b = g >> 3, h = g & 7, kv = h >> 2; abf* base = PP + (size_t)b * SEQ * PPW;
        if (fixref) attn_body::attn_unit<8, 2, true>(qb, base + PC_CQ + h * 64, base + PC_CK + kv * 64, base + PC_CV + kv * 64, base + PC_CQ + h * 64, PPW, (char*)F.ldsg, utid(F), -sbound);
        else attn_body::attn_unit<8, 2, false>(qb, base + PC_CQ + h * 64, base + PC_CK + kv * 64, base + PC_CV + kv * 64, base + PC_CQ + h * 64, PPW, (char*)F.ldsg, utid(F));
    }
    if (pend) { expert_convert(F, l); __syncthreads(); }
}

__device__ __forceinline__ void post_phase(Frame& F, int l) {
    const int lane = F.lane; const int gw = F.vcu * NWAVES + F.wave, NGW = F.G * NWAVES;
    const float linit = (l == 0) ? 0.2f : 0.35550906759096926f;
    float lam;
    { const GAS float* lv = (const GAS float*)INP(7) + l * 256; const float sa = wave_sum(lv[lane] * lv[64 + lane], lane), sb = wave_sum(lv[128 + lane] * lv[192 + lane], lane); lam = expf(sa) - expf(sb) + linit; }
    float gnw[8], dnw[8];
#pragma unroll
    for (int e = 0; e < 8; ++e) { gnw[e] = ((const GAS float*)INP(6))[l * 128 + ((8 * lane) & 127) + e]; dnw[e] = ((const GAS float*)INP(8))[l * 128 + ((8 * lane) & 127) + e] * (1.0f - linit); }
    GAS bf16* PP = WSG(bf16, WS_PP); const GAS bf16* OF = WSG(bf16, WS_OF); const GAS bf16* OB = WSG(bf16, WS_OB); const GAS bf16* OD = WSG(bf16, WS_OD);
    v4u la[2][4], lb[2][4], lz[2][4], lc[2][4], ld[2][4];
#define PO_LOAD(B, T0) do { _Pragma("unroll") for (int q = 0; q < 4; ++q) { const int t = (T0) + q * NGW < TOK ? (T0) + q * NGW : gw; \
            la[B][q] = __builtin_nontemporal_load((const GAS v4u*)(OF + (size_t)t * 512 + 8 * lane)); lb[B][q] = __builtin_nontemporal_load((const GAS v4u*)(OB + (size_t)t * 512 + 8 * lane)); lz[B][q] = __builtin_nontemporal_load((const GAS v4u*)(PP + (size_t)t * PPW + PC_Z + 8 * lane)); \
            lc[B][q] = __builtin_nontemporal_load((const GAS v4u*)(OD + (size_t)t * 1024 + 8 * lane)); ld[B][q] = __builtin_nontemporal_load((const GAS v4u*)(OD + (size_t)t * 1024 + 512 + 8 * lane)); } } while (0)
#define PO_TRIP(B, T0) do { PO_LOAD((B) ^ 1, (T0) + 4 * NGW); __builtin_amdgcn_sched_barrier(0); \
        _Pragma("unroll") for (int q = 0; q < 4; ++q) { const int t = (T0) + q * NGW; if (t < TOK) { \
        GAS bf16* prow = PP + (size_t)t * PPW; \
        { float a[8], bb[8], z[8], o[8]; unpack8(la[B][q], a); unpack8(lb[B][q], bb); unpack8(lz[B][q], z); \
          float ssq = 0.f; \
          _Pragma("unroll") for (int e = 0; e < 8; ++e) { o[e] = a[e] + bb[e]; ssq += o[e] * o[e]; } \
          ssq = row16_sum(ssq); \
          const float rn = __builtin_amdgcn_rsqf(ssq * (1.0f / 128.0f) + EPS); \
          _Pragma("unroll") for (int e = 0; e < 8; ++e) o[e] = o[e] * rn * gnw[e] * (z[e] * sigm(z[e])); \
          st16_hidden(prow + PC_Z + 8 * lane, pack8(o)); } \
        { float a[8], bb[8], o[8]; unpack8(lc[B][q], a); unpack8(ld[B][q], bb); \
          float ssq = 0.f; \
          _Pragma("unroll") for (int e = 0; e < 8; ++e) { o[e] = a[e] - lam * bb[e]; ssq += o[e] * o[e]; } \
          ssq = row16_sum(ssq); \
          const float rn = __builtin_amdgcn_rsqf(ssq * (1.0f / 128.0f) + EPS); \
          _Pragma("unroll") for (int e = 0; e < 8; ++e) o[e] = o[e] * rn * dnw[e]; \
          st16_hidden(prow + PC_DQ + 8 * lane, pack8(o)); } \
        } } } while (0)
    PO_LOAD(0, gw);
    for (int t0 = gw; t0 < TOK; t0 += 8 * NGW) { PO_TRIP(0, t0); if (t0 + 4 * NGW < TOK) PO_TRIP(1, t0 + 4 * NGW); else break; }
#undef PO_LOAD
#undef PO_TRIP
    asm volatile("s_waitcnt vmcnt(0)" ::: "memory");
}

__device__ __forceinline__ int moe_tables(Frame& F, int l) {
    LAS int* tbase = (LAS int*)(F.lds + LDS_TBASE); LAS int* tilee = (LAS int*)(F.lds + LDS_TILEE);
    if (F.wave == 0) { const int lane = F.lane; const int cnt = lane < 32 ? (int)F.ctl[CW_CNT + 64 * l + lane] : 0; const int nt = (cnt + 255) >> 8; int inc = nt;
#pragma unroll
        for (int o = 1; o < 32; o <<= 1) { const int t = SHFL_UP(inc, o); if (lane >= o) inc += t; }
        const int tb = inc - nt;
        if (lane < 32) { tbase[lane] = tb; for (int k = 0; k < nt; ++k) if (tb + k < 320) tilee[tb + k] = lane; }
        if (lane == 31) tbase[32] = inc; }
    __syncthreads();
    int ntile = tbase[32]; if (ntile > 288) ntile = 288;
    return ntile;
}
struct MoeOrder {
    const LAS int* tilee; const LAS int* rowtab; int nunit, G, c; long estride;
    __device__ __forceinline__ bool next(int i, pg8::Unit& u) const { const long L = (long)i * G + c; if (L >= nunit) return false; u.pm = (int)(L >> 2); u.pn = (int)(L & 3); u.aoff = 0; u.boff = (long)tilee[u.pm] * estride; u.ord = i; return true; }
    __device__ __forceinline__ void a_ready(const pg8::Unit&) const {}
    __device__ __forceinline__ void done(const pg8::Unit&) const {}
    __device__ __forceinline__ int row(const pg8::Unit& u, int r) const { return rowtab[u.ord * 256 + r]; }
};
__device__ __forceinline__ void moe_build(Frame& F, int l, int nunit) {
    const LAS int* tbase = (const LAS int*)(F.lds + LDS_TBASE); const LAS int* tilee = (const LAS int*)(F.lds + LDS_TILEE);
    LAS int* rowtab = (LAS int*)(F.lds + LDS_ROWTAB); LAS float* rstab = (LAS float*)(F.lds + LDS_RSTAB); LAS float* wtab = (LAS float*)(F.lds + LDS_WTAB);
    const GAS int* tokl = WSG(int, WS_TOKL); const GAS float* wl = WSG(float, WS_WL); const GAS float* rstd2 = WSG(float, WS_RSTD2);
    for (int k = F.tid; k < 5 * 256; k += NWAVES * 64) { const int i = k >> 8, r = k & 255; const long L = (long)i * F.G + F.vcu;
        int tok = 0; float rs = 0.f, w = 0.f;
        if (L < nunit) { const int pm = (int)(L >> 2), e = tilee[pm], idx = (pm - tbase[e]) * 256 + r; const int cnt = (int)F.ctl[CW_CNT + 64 * l + e];
            if (idx < cnt) { tok = tokl[e * 32768 + idx]; rs = rstd2[tok]; w = wl[e * 32768 + idx]; } }
        rowtab[k] = tok; rstab[k] = rs; wtab[k] = w; }
    __syncthreads();
}
struct BrOrder {
    pg8::StaticOrder s;
    __device__ __forceinline__ bool next(int i, pg8::Unit& u) const { if (!s.next(i, u)) return false; const int br = u.pn >> 2; u.aoff = (br == 0 ? PC_Z : (br == 1 ? PC_DQ : PC_CQ)) * 2; return true; }
    __device__ __forceinline__ void a_ready(const pg8::Unit&) const {}
    __device__ __forceinline__ void done(const pg8::Unit&) const {}
};
struct GateOrder {
    pg8::StaticOrder s;
    __device__ __forceinline__ bool next(int i, pg8::Unit& u) const { if (!s.next(i / 3, u)) return false; u.pn += 4 * (i % 3); return true; }
    __device__ __forceinline__ void a_ready(const pg8::Unit&) const {}
    __device__ __forceinline__ void done(const pg8::Unit&) const {}
};
__device__ __forceinline__ void final_phase(Frame& F) {
    const int lane = F.lane; const int gw = F.vcu * NWAVES + F.wave, NGW = F.G * NWAVES;
    const float* rs = WSP(float, WS_RSTDF); const float* fw = INP(23);
    f32x4 wv[4];
#pragma unroll
    for (int j = 0; j < 4; ++j) wv[j] = *(const f32x4*)(fw + 256 * j + 4 * lane);
    for (int t = gw; t < TOK; t += NGW) { const float r = rs[t]; f32x4* o = (f32x4*)(F.out + (size_t)t * DM) + lane;
#pragma unroll
        for (int j = 0; j < 4; ++j) o[64 * j] = o[64 * j] * r * wv[j]; }
}

__global__ void __launch_bounds__(NWAVES * 64, 2) mk_fwd(Args args) {
    extern __shared__ __attribute__((aligned(16))) unsigned char lds[];
    Frame F;
    F.lds = (LAS unsigned char*)lds; F.ldsg = lds;
    F.MISC = (volatile LAS unsigned*)(F.lds + LDSCTL_OFF);
    F.tid = threadIdx.x; F.lane = F.tid & 63; F.wave = __builtin_amdgcn_readfirstlane(F.tid >> 6); const int wave0 = F.wave;
    F.G = gridDim.x; { const int bx = blockIdx.x; F.vcu = (F.G % 8 == 0) ? (bx % 8) * (F.G / 8) + bx / 8 : bx; }
    F.ws = args.ws; F.ctl = (gu32*)(args.ws + WS_CTL); F.out = args.out;
    F.A = (const __attribute__((address_space(4))) Args*)&args;
    for (int u = F.tid; u < (LDS_BYTES - LDSCTL_OFF) / 4; u += NWAVES * 64) ((LAS unsigned*)(F.lds + LDSCTL_OFF))[u] = 0u;
    __syncthreads();
    XcdBarrier bar; bar.bar = (unsigned*)(F.ctl + CW_BAR); bar.x = 0; bar.st = nullptr;
    if (!MK_SPLIT) bar = xcd_barrier_post((unsigned*)(F.ctl + CW_BAR), F.MISC + 8);
    const int lo = args.ph_lo, hi = args.ph_hi;
#ifndef PH_EN
#define PH_EN 0x3fffu
#endif
#define EN(j) ((PH_EN >> (j)) & 1u)
#ifndef REP_MASK
#define REP_MASK 0u
#endif
#define REPN(j) (1 + (int)((REP_MASK >> (j)) & 1u))
#define IN(k) (lo <= (k) && (k) < hi)
#define SEAM(k) do { if (IN((k) + 1)) xcd_barrier(bar); } while (0)
#define FRESH() do { int l_; asm volatile("v_mbcnt_lo_u32_b32 %0, -1, 0\n\tv_mbcnt_hi_u32_b32 %0, -1, %0" : "=v"(l_)); int wv_ = wave0; asm volatile("" : "+s"(wv_)); F.lane = l_; F.wave = wv_; F.tid = wv_ * 64 + l_;     \
    unsigned char* w_ = args.ws; float* o_ = args.out; unsigned char* lg_ = lds; asm volatile("" : "+s"(w_), "+s"(o_), "+s"(lg_)); F.ldsg = lg_; F.lds = (LAS unsigned char*)lg_; F.MISC = (volatile LAS unsigned*)(F.lds + LDSCTL_OFF); F.ws = w_; F.out = o_; F.ctl = (gu32*)(w_ + WS_CTL); } while (0)

    if (IN(0)) { FRESH(); for (int rep = 0; rep < REPN(13); ++rep) { p0_prologue(F); if (rep + 1 < REPN(13)) xcd_barrier(bar); } SEAM(0); }
    for (int l = 0; l < NLAYER; ++l) {
        const int pb = 1 + 12 * l;
        const float* rstd1 = WSP(float, WS_RSTD1);
        if (IN(pb + 0) && EN(0)) { FRESH(); if (l == 0) { for (int rep = 0; rep < REPN(0); ++rep) { norm_pass<0>(F, l); if (rep + 1 < REPN(0)) xcd_barrier(bar); } } else norm_pass<2>(F, l); SEAM(pb + 0); }
        if (IN(pb + 1) && EN(1)) { FRESH();
            pg8::Gemm g{WSP(bf16, WS_XB), WSP(bf16, WS_WIN) + (size_t)l * 4352 * 1024, TOK, 4352, 1024, 1024, 1024}; pg8::StaticOrder S; S.init(TOK, 4352, F.G, (int)blockIdx.x);
            pg8::EpiInproj E{WSP(bf16, WS_RAW), WSP(bf16, WS_PP), rstd1, WSP(float, WS_COS1), WSP(float, WS_SIN1), WSP(float, WS_AX), INP(9) + l * 64, INP(10) + l * 64, QSCALE, (unsigned*)(F.ctl + CW_NRM + 64 * l)};
            for (int rep = 0; rep < REPN(1); ++rep) { pg8::gemm_phase<pg8::EpiInproj, pg8::StaticOrder, true, true>(F.lds, g, S, E, F.tid); if (rep + 1 < REPN(1)) xcd_barrier(bar); }
            SEAM(pb + 1); }
        if (IN(pb + 2) && EN(2)) { FRESH();
#ifndef X_NOCHUNK
            FRESH();
            chunk_phase<0>(F, l);
#ifdef CHUNK_VAR
            xcd_barrier(bar); FRESH(); chunk_phase<CHUNK_VAR>(F, l);
#endif
#endif
            SEAM(pb + 2); }
        if (IN(pb + 3) && EN(3)) { FRESH(); scan_phase<0>(F);
#ifdef SCAN_VAR
            xcd_barrier(bar); scan_phase<SCAN_VAR>(F);
#endif
            SEAM(pb + 3); }
        if (IN(pb + 4) && EN(4)) { FRESH(); for (int rep = 0; rep < REPN(4); ++rep) { attn_phase_all(F, l, 0, rep == 0 ? 2048 : 1024, rep == 0); if (rep + 1 < REPN(4)) xcd_barrier(bar); } SEAM(pb + 4); }
        if (IN(pb + 5) && EN(5)) { FRESH(); post_phase(F, l); SEAM(pb + 5); }
        if (IN(pb + 6) && EN(6)) { FRESH();
            pg8::Gemm g{WSP(bf16, WS_PP), WSP(bf16, WS_WBR) + (size_t)l * 3072 * 512, TOK, 3072, 512, PPW, 512}; BrOrder S; S.s.init(TOK, 3072, F.G, (int)blockIdx.x);
            pg8::EpiBrTM E{WSP(bf16, WS_YBR)};
            for (int rep = 0; rep < REPN(6); ++rep) { pg8::gemm_phase<pg8::EpiBrTM, BrOrder, true, true>(F.lds, g, S, E, F.tid); if (rep + 1 < REPN(6)) xcd_barrier(bar); }
            SEAM(pb + 6); }
        if (IN(pb + 7) && EN(7)) { FRESH();
            pg8::Gemm g{WSP(bf16, WS_XB), WSP(bf16, WS_WG) + (size_t)l * 3072 * 1024, TOK, 3072, 1024, 1024, 1024}; GateOrder S; S.s.init(TOK, 1024, F.G, (int)blockIdx.x);
            pg8::EpiGate E{WSP(bf16, WS_YBR), WSP(bf16, WS_MG), rstd1, WSP(bf16, WS_MGT)};
            for (int rep = 0; rep < REPN(7); ++rep) { pg8::gemm_phase<pg8::EpiGate, GateOrder, true, true>(F.lds, g, S, E, F.tid); if (rep + 1 < REPN(7)) xcd_barrier(bar); }
            SEAM(pb + 7); }
        if (IN(pb + 8) && EN(8)) { FRESH();
            pg8::Gemm g{WSP(bf16, WS_MG), WSP(bf16, WS_WO3) + (size_t)l * 1024 * 1024, TOK, 1024, 1024, 1024, 1024}; pg8::StaticOrder S; S.init(TOK, 1024, F.G, (int)blockIdx.x);
            pg8::EpiResidB E{WSP(bf16, WS_XB), DM};
            pg8::gemm_phase<pg8::EpiResidB, pg8::StaticOrder, true, true>(F.lds, g, S, E, F.tid);
            SEAM(pb + 8); }
        if (IN(pb + 9) && EN(9)) { FRESH(); norm_pass<1>(F, l); SEAM(pb + 9); }
        if (IN(pb + 10) && EN(10)) { FRESH();
            const int ntile = moe_tables(F, l); moe_build(F, l, ntile * 4);
            pg8::Gemm g{WSP(bf16, WS_XB), WSP(bf16, WS_W13T), ntile * 256, 1024, 1024, 1024, 1024}; MoeOrder S{(const LAS int*)(F.lds + LDS_TILEE), (const LAS int*)(F.lds + LDS_ROWTAB), ntile * 4, F.G, F.vcu, (long)1024 * 1024 * 2};
            pg8::EpiMoe1 E{WSP(bf16, WS_HH), (const LAS float*)(F.lds + LDS_RSTAB)};
            for (int rep = 0; rep < REPN(11); ++rep) { pg8::gemm_phase<pg8::EpiMoe1, MoeOrder, true, true, true>(F.lds, g, S, E, F.tid); if (rep + 1 < REPN(11)) xcd_barrier(bar); }
            SEAM(pb + 10); }
        if (IN(pb + 11) && EN(11)) { FRESH();
            if (MK_SPLIT) { const int nt_ = moe_tables(F, l); moe_build(F, l, nt_ * 4); }
            int ntile = ((const LAS int*)(F.lds + LDS_TBASE))[32]; if (ntile > 288) ntile = 288;
            pg8::Gemm g{WSP(bf16, WS_HH), WSP(bf16, WS_W2T), ntile * 256, 1024, 512, 512, 512}; MoeOrder S{(const LAS int*)(F.lds + LDS_TILEE), (const LAS int*)(F.lds + LDS_ROWTAB), ntile * 4, F.G, F.vcu, (long)1024 * 512 * 2};
            pg8::EpiMoe2 E{WSP(bf16, WS_XG), (const LAS float*)(F.lds + LDS_WTAB)};
            for (int rep = 0; rep < REPN(12); ++rep) { pg8::gemm_phase<pg8::EpiMoe2, MoeOrder, true, true>(F.lds, g, S, E, F.tid); if (rep + 1 < REPN(12)) xcd_barrier(bar); }
            SEAM(pb + 11); }
    }
#ifdef EXTRA_BARS
    for (int eb = 0; eb < EXTRA_BARS; ++eb) xcd_barrier(bar);
#endif
    if (IN(25)) { FRESH(); norm_pass<3>(F, 0); }
#undef IN
#undef SEAM
}

#ifdef DBG_STOP
#ifndef DBG_KIND
#define DBG_KIND 0
#endif
#ifndef DBG_OFF
#define DBG_OFF 0
#endif
__global__ void dbg_dump(const unsigned char* ws, float* out, int n) {
    for (int i = blockIdx.x * blockDim.x + threadIdx.x; i < n; i += gridDim.x * blockDim.x) {
        if (DBG_KIND == 1) out[i] = bf2f(((const bf16*)(ws + (size_t)DBG_OFF * MiB))[i]);
        if (DBG_KIND == 2) out[i] = ((const float*)(ws + (size_t)DBG_OFF * MiB))[i];
        if (DBG_KIND == 3) out[i] = (float)((const int*)(ws + (size_t)DBG_OFF * MiB))[i];
        if (DBG_KIND == 4) { const float v = out[i] * 65536.0f; out[i] = v - floorf(v); }
        if (DBG_KIND == 5) out[i] = (float)(((const bf16*)(ws + (size_t)DBG_OFF * MiB))[i] & 0xffu);
        if (DBG_KIND == 6) { const float v = ((const float*)(ws + (size_t)DBG_OFF * MiB))[i] * 65536.0f; out[i] = v - floorf(v); }
    }
}
#endif
extern "C" void kernel_launch(void* const* d_in, const int* in_sizes, int n_in, void* d_out, int out_size, void* d_ws, size_t ws_size, hipStream_t stream) {
    static int grid = 0;
    if (grid == 0) {
        if (n_in != 24 || out_size != TOK * DM || ws_size < WS_END) { fprintf(stderr, "kernel_launch: unexpected sizes (n_in %d out %d ws %zu)\n", n_in, out_size, ws_size); grid = -1; return; }
        int dev = 0, cus = 0, per_cu = 0;
        if (hipGetDevice(&dev) != hipSuccess || hipDeviceGetAttribute(&cus, hipDeviceAttributeMultiprocessorCount, dev) != hipSuccess) { grid = -1; return; }
        if (hipFuncSetAttribute((const void*)mk_fwd, hipFuncAttributeMaxDynamicSharedMemorySize, LDS_BYTES) != hipSuccess) { fprintf(stderr, "kernel_launch: hipFuncSetAttribute failed\n"); grid = -1; return; }
        if (hipOccupancyMaxActiveBlocksPerMultiprocessor(&per_cu, (const void*)mk_fwd, NWAVES * 64, LDS_BYTES) != hipSuccess || per_cu < 1) { fprintf(stderr, "kernel_launch: occupancy query says %d\n", per_cu); }
        (void)hipGetLastError();
        grid = cus;
    }
    if (grid < 0) return;
    if (hipMemsetAsync((char*)d_ws + WS_CTL, 0, CTL_ZERO_BYTES, stream) != hipSuccess) return;
    Args a{};
    for (int i = 0; i < 24; ++i) a.in[i] = (const float*)d_in[i];
    a.out = (float*)d_out; a.ws = (unsigned char*)d_ws;
#if MK_SPLIT
#ifdef DBG_STOP
    for (int p = 0; p <= DBG_STOP; ++p) { a.ph_lo = p; a.ph_hi = p + 1; hipLaunchKernelGGL(mk_fwd, dim3(grid), dim3(NWAVES * 64), LDS_BYTES, stream, a); }
    if (DBG_KIND != 0) hipLaunchKernelGGL(dbg_dump, dim3(2048), dim3(256), 0, stream, (const unsigned char*)d_ws, (float*)d_out, DBG_N);
#else
    for (int p = 0; p < NPH; ++p) { a.ph_lo = p; a.ph_hi = p + 1; hipLaunchKernelGGL(mk_fwd, dim3(grid), dim3(NWAVES * 64), LDS_BYTES, stream, a); }
#endif
#else
    a.ph_lo = 0; a.ph_hi = NPH;
    hipLaunchKernelGGL(mk_fwd, dim3(grid), dim3(NWAVES * 64), LDS_BYTES, stream, a);
#endif
}
```

```cpp
#include <hip/hip_runtime.h>
#include <cstdio>
#include <cstdint>
#include <utility>
#ifndef DBG_N
#define DBG_N (32768 * 1024)
#endif
namespace pg8 {
#define PG8_LAS __attribute__((address_space(3)))
typedef unsigned short bf16_t;
typedef short bf16x8 __attribute__((ext_vector_type(8)));
typedef float f32x4 __attribute__((ext_vector_type(4)));
typedef unsigned u32x4 __attribute__((ext_vector_type(4)));
constexpr int BM = 256, BK = 64, HALF = 128, HTB = HALF * BK * 2  , STAGE_BYTES = 8 * HTB, NXCD = 8, WGM = 8;

__host__ __device__ __forceinline__ int lds_byte(int r, int c) { const int st = (r >> 4) * 2 + (c >> 5), rr = r & 15, cc = c & 31, ob = rr * 64 + cc * 2; return st * 1024 + (ob ^ (((ob >> 9) & 1) << 5)); }
__host__ __device__ __forceinline__ void stage_rc(int b, int& R, int& C) { const int st = b / 1024, sb = b % 1024, swz = sb ^ (((sb >> 9) & 1) << 5); R = (st >> 1) * 16 + swz / 64; C = (st & 1) * 32 + (swz % 64) / 2; }
__host__ __device__ __forceinline__ int perm32(int rho) { const int n = rho >> 4, i = rho & 15; return 8 * (i >> 2) + 4 * n + (i & 3); }

struct Unit { int pm, pn; long aoff, boff; int ord; };
struct Gemm { const bf16_t* A; const bf16_t* Bt; int M, N, K, lda, ldb; };

struct StaticOrder {
    int nM, nN, nwg, G, c;
    __host__ __device__ void init(int M, int N, int G_, int c_) { nM = M / BM; nN = N / BM; nwg = nM * nN; G = G_; c = c_; }
    __host__ __device__ bool next(int i, Unit& u) const {
        const long L = (long)i * G + c; if (L >= nwg) return false;
        int wgid = (int)L; { const int q = nwg / NXCD, r = nwg % NXCD, xcd = wgid % NXCD, off = wgid / NXCD; wgid = (xcd < r ? xcd * (q + 1) : r * (q + 1) + (xcd - r) * q) + off; }
        const int nig = WGM * nN, gid = wgid / nig, fm = gid * WGM, gsz = (nM - fm) < WGM ? (nM - fm) : WGM;
        u.pm = fm + ((wgid % nig) % gsz); u.pn = (wgid % nig) / gsz; u.aoff = 0; u.boff = 0; u.ord = i; return true;
    }
    __device__ __forceinline__ void a_ready(const Unit&) const {}
    __device__ __forceinline__ void done(const Unit&) const {}
    __device__ __forceinline__ int row(const Unit& u, int r) const { return u.pm * BM + r; }
};


#define PG8_GAS __attribute__((address_space(1)))
typedef float f32x2c_t __attribute__((ext_vector_type(2))); typedef __bf16 bf16x2c_t __attribute__((ext_vector_type(2)));
__device__ __forceinline__ unsigned cvt_pk_bf16(float lo, float hi) { const f32x2c_t v = {lo, hi}; const bf16x2c_t b = __builtin_convertvector(v, bf16x2c_t); return __builtin_bit_cast(unsigned, b); }
__device__ __forceinline__ float bflo(unsigned w) { return __uint_as_float(w << 16); }
__device__ __forceinline__ float bfhi(unsigned w) { return __uint_as_float(w & 0xffff0000u); }
__device__ __forceinline__ float sigmoidf_(float x) { return __builtin_amdgcn_rcpf(1.0f + __expf(-x)); }

struct EpiInproj {
    static constexpr bool PERM = true, AFTER_DRAIN = false;
    bf16_t* raw; bf16_t* pp; const float* rstd; const float* cos1; const float* sin1; const float* ax; const float* qnw; const float* knw; float qscale;
    unsigned* nrm;
    __device__ __forceinline__ void operator()(const f32x4 (&acc)[2][2][4][2], const Unit& u, int wr, int wc, int fr, int fq) const {
        const int row0 = u.pm * BM + wr * 64 + fr;
        const int pt = u.pn - 6;
        float rsv[2][4];
#pragma unroll
        for (int ai = 0; ai < 2; ++ai)
#pragma unroll
            for (int m = 0; m < 4; ++m) rsv[ai][m] = ((const PG8_GAS float*)rstd)[row0 + ai * HALF + m * 16];
        const bool perm = (pt >= 2 && pt <= 5) || (pt >= 8);
        if (!perm) {
            bf16_t* base; int ldc, colt;
            if (u.pn < 6) { base = raw; ldc = 1536; colt = u.pn * 256; } else { base = pp; ldc = 2816; colt = pt * 256; }
            const int col0 = colt + wc * 32 + 8 * fq;
#pragma unroll
            for (int ai = 0; ai < 2; ++ai)
#pragma unroll
                for (int m = 0; m < 4; ++m) { const int row = row0 + ai * HALF + m * 16; const float s = rsv[ai][m]; bf16_t* rowp = base + (size_t)row * ldc + col0;
#pragma unroll
                    for (int bj = 0; bj < 2; ++bj) { const f32x4 v0 = acc[ai][bj][m][0] * s, v1 = acc[ai][bj][m][1] * s;
                        u32x4 w; w.x = cvt_pk_bf16(v0[0], v0[1]); w.y = cvt_pk_bf16(v0[2], v0[3]); w.z = cvt_pk_bf16(v1[0], v1[1]); w.w = cvt_pk_bf16(v1[2], v1[3]);
                        *(PG8_GAS u32x4*)(rowp + bj * HALF) = w; } }
            return;
        }
        const int kind = (pt <= 3) ? 0 : (pt <= 5) ? 1 : (pt <= 9) ? 2 : (wc < 2 ? 3 : 4);
        const int col0 = pt * 256 + wc * 64 + 8 * fq;
        const int lane = fq * 16 + fr;
        float nw0[8], nw1[8]; float nmax = 0.f;
        if (kind == 2 || kind == 3) { const PG8_GAS float* nwp = (const PG8_GAS float*)(kind == 2 ? qnw : knw) + 8 * fq;
#pragma unroll
            for (int j = 0; j < 8; ++j) { nw0[j] = nwp[j]; nw1[j] = nwp[32 + j]; } }
#pragma unroll
        for (int ai = 0; ai < 2; ++ai)
#pragma unroll
            for (int m = 0; m < 4; ++m) { const int row = row0 + ai * HALF + m * 16; const float s = rsv[ai][m]; const int sp = row & 8191;
                float x0[8], x1[8];
#pragma unroll
                for (int n = 0; n < 2; ++n)
#pragma unroll
                    for (int e2 = 0; e2 < 4; ++e2) { x0[4 * n + e2] = acc[ai][0][m][n][e2] * s; x1[4 * n + e2] = acc[ai][1][m][n][e2] * s; }
                if (kind <= 1) {
                    int fqo = fq; asm volatile("" : "+v"(fqo));
                    const PG8_GAS f32x4* cp = (const PG8_GAS f32x4*)(cos1 + sp * 32 + 8 * fqo); const PG8_GAS f32x4* snp = (const PG8_GAS f32x4*)(sin1 + sp * 32 + 8 * fqo);
                    const f32x4 c0 = cp[0], c1 = cp[1], s0 = snp[0], s1 = snp[1];
#pragma unroll
                    for (int j = 0; j < 8; ++j) { const float c = j < 4 ? c0[j & 3] : c1[j & 3], sn = j < 4 ? s0[j & 3] : s1[j & 3]; const float a = x0[j], b = x1[j];
                        x0[j] = a * c - b * sn; x1[j] = b * c + a * sn; if (kind == 0) { x0[j] *= qscale; x1[j] *= qscale; } }
                    float ssn = 0.f;
#pragma unroll
                    for (int j = 0; j < 8; ++j) { ssn = __builtin_fmaf(x0[j], x0[j], ssn); ssn = __builtin_fmaf(x1[j], x1[j], ssn); }
                    ssn += __int_as_float(__builtin_amdgcn_ds_bpermute((lane ^ 16) << 2, __float_as_int(ssn)));
                    ssn += __int_as_float(__builtin_amdgcn_ds_bpermute((lane ^ 32) << 2, __float_as_int(ssn)));
                    nmax = fmaxf(nmax, ssn);
                } else if (kind <= 3) {
                    float ss = 0.f;
#pragma unroll
                    for (int j = 0; j < 8; ++j) ss += x0[j] * x0[j] + x1[j] * x1[j];
                    ss += __int_as_float(__builtin_amdgcn_ds_bpermute((lane ^ 16) << 2, __float_as_int(ss)));
                    ss += __int_as_float(__builtin_amdgcn_ds_bpermute((lane ^ 32) << 2, __float_as_int(ss)));
                    const float rn = __builtin_amdgcn_rsqf(ss * (1.0f / 64.0f) + 1e-6f);
                    const PG8_GAS float* tr = (const PG8_GAS float*)ax + (sp >> 6) * 16 + 8 * (fq & 1); const PG8_GAS float* tc = (const PG8_GAS float*)ax + 4096 + (sp & 63) * 16 + 8 * (fq & 1);
                    const f32x4 cr0 = *(const PG8_GAS f32x4*)tr, cr1 = *(const PG8_GAS f32x4*)(tr + 4), sr0 = *(const PG8_GAS f32x4*)(tr + 2048), sr1 = *(const PG8_GAS f32x4*)(tr + 2052);
                    const f32x4 cc0 = *(const PG8_GAS f32x4*)tc, cc1 = *(const PG8_GAS f32x4*)(tc + 4), sc0 = *(const PG8_GAS f32x4*)(tc + 1024), sc1 = *(const PG8_GAS f32x4*)(tc + 1028);
#pragma unroll
                    for (int j = 0; j < 8; ++j) { const float y0 = x0[j] * rn * nw0[j], y1 = x1[j] * rn * nw1[j];
                        const float p0 = __int_as_float(__builtin_amdgcn_ds_bpermute((lane ^ 32) << 2, __float_as_int(y0))), p1 = __int_as_float(__builtin_amdgcn_ds_bpermute((lane ^ 32) << 2, __float_as_int(y1)));
                        const float cr = j < 4 ? cr0[j & 3] : cr1[j & 3], sr = j < 4 ? sr0[j & 3] : sr1[j & 3], cc = j < 4 ? cc0[j & 3] : cc1[j & 3], sc = j < 4 ? sc0[j & 3] : sc1[j & 3];
                        float o0 = (fq < 2) ? y0 * cr - p0 * sr : y0 * cr + p0 * sr, o1 = (fq < 2) ? y1 * cc - p1 * sc : y1 * cc + p1 * sc;
                        if (kind == 2) { o0 *= qscale; o1 *= qscale; }
                        x0[j] = o0; x1[j] = o1; }
                }
                bf16_t* rowp = pp + (size_t)row * 2816 + col0;
                u32x4 w; w.x = cvt_pk_bf16(x0[0], x0[1]); w.y = cvt_pk_bf16(x0[2], x0[3]); w.z = cvt_pk_bf16(x0[4], x0[5]); w.w = cvt_pk_bf16(x0[6], x0[7]);
                *(PG8_GAS u32x4*)rowp = w;
                w.x = cvt_pk_bf16(x1[0], x1[1]); w.y = cvt_pk_bf16(x1[2], x1[3]); w.z = cvt_pk_bf16(x1[4], x1[5]); w.w = cvt_pk_bf16(x1[6], x1[7]);
                *(PG8_GAS u32x4*)(rowp + 32) = w; }
        if (kind <= 1) {
#pragma unroll
            for (int o = 1; o < 16; o <<= 1) nmax = fmaxf(nmax, __int_as_float(__builtin_amdgcn_ds_bpermute((lane ^ o) << 2, __float_as_int(nmax))));
            if (lane == 0) __hip_atomic_fetch_max((PG8_GAS unsigned*)nrm + kind * 32 + ((u.pm * BM) >> 13) * 8 + (pt - (kind == 0 ? 2 : 4)) * 4 + wc, __float_as_uint(nmax), __ATOMIC_RELAXED, __HIP_MEMORY_SCOPE_AGENT);
        }
    }
};
struct EpiBf16Row {
    static constexpr bool PERM = true, AFTER_DRAIN = false;
    bf16_t* O; int ldc; const float* rs;
    __device__ __forceinline__ void operator()(const f32x4 (&acc)[2][2][4][2], const Unit& u, int wr, int wc, int fr, int fq) const {
        const int row0 = u.pm * BM + wr * 64 + fr; const int col0 = u.pn * BM + wc * 32 + 8 * fq;
        float rsv[2][4];
#pragma unroll
        for (int ai = 0; ai < 2; ++ai)
#pragma unroll
            for (int m = 0; m < 4; ++m) rsv[ai][m] = rs ? ((const PG8_GAS float*)rs)[row0 + ai * HALF + m * 16] : 1.0f;
#pragma unroll
        for (int ai = 0; ai < 2; ++ai)
#pragma unroll
            for (int m = 0; m < 4; ++m) { const int row = row0 + ai * HALF + m * 16; const float s = rsv[ai][m]; bf16_t* rowp = O + (size_t)row * ldc + col0;
#pragma unroll
                for (int bj = 0; bj < 2; ++bj) { const f32x4 v0 = acc[ai][bj][m][0] * s, v1 = acc[ai][bj][m][1] * s;
                    u32x4 w; w.x = cvt_pk_bf16(v0[0], v0[1]); w.y = cvt_pk_bf16(v0[2], v0[3]); w.z = cvt_pk_bf16(v1[0], v1[1]); w.w = cvt_pk_bf16(v1[2], v1[3]);
                    *(PG8_GAS u32x4*)(rowp + bj * HALF) = w; } }
    }
};
struct EpiBrTM {
    static constexpr bool PERM = true, AFTER_DRAIN = false;
    bf16_t* O;
    __device__ __forceinline__ void operator()(const f32x4 (&acc)[2][2][4][2], const Unit& u, int wr, int wc, int fr, int fq) const {
        bf16_t* tp = O + (size_t)(u.pm * 12 + u.pn) * 65536 + (size_t)(((wr * 4 + wc) * 64 + fq * 16 + fr) * 8);
#pragma unroll
        for (int ai = 0; ai < 2; ++ai)
#pragma unroll
            for (int m = 0; m < 4; ++m)
#pragma unroll
                for (int bj = 0; bj < 2; ++bj) { const f32x4 v0 = acc[ai][bj][m][0], v1 = acc[ai][bj][m][1];
                    u32x4 w; w.x = cvt_pk_bf16(v0[0], v0[1]); w.y = cvt_pk_bf16(v0[2], v0[3]); w.z = cvt_pk_bf16(v1[0], v1[1]); w.w = cvt_pk_bf16(v1[2], v1[3]);
                    *(PG8_GAS u32x4*)(tp + ((ai * 4 + m) * 2 + bj) * 4096) = w; }
    }
};
struct EpiGate {
    static constexpr bool PERM = true, AFTER_DRAIN = false;
    const bf16_t* Y; bf16_t* MG; const float* rstd; bf16_t* MT;
    __device__ __forceinline__ void operator()(const f32x4 (&acc)[2][2][4][2], const Unit& u, int wr, int wc, int fr, int fq) const {
        const int br = u.pn >> 2, cb = u.pn & 3;
        const size_t tmo = (size_t)(((wr * 4 + wc) * 64 + fq * 16 + fr) * 8); const bf16_t* yt = Y + (size_t)(u.pm * 12 + u.pn) * 65536 + tmo; bf16_t* mt = MT + (size_t)(u.pm * 4 + cb) * 65536 + tmo;
        const int row0 = u.pm * BM + wr * 64 + fr; const int ycol0 = u.pn * BM + wc * 32 + 8 * fq, mcol0 = cb * BM + wc * 32 + 8 * fq;
#pragma unroll
        for (int ai = 0; ai < 2; ++ai) {
            u32x4 yv[4][2], ov[4][2]; float sv[4];
#pragma unroll
            for (int m = 0; m < 4; ++m) { const int row = row0 + ai * HALF + m * 16; sv[m] = ((const PG8_GAS float*)rstd)[row];
#pragma unroll
                for (int bj = 0; bj < 2; ++bj) { yv[m][bj] = *(const PG8_GAS u32x4*)(yt + ((ai * 4 + m) * 2 + bj) * 4096);
                    if (br != 0) ov[m][bj] = *(const PG8_GAS u32x4*)(mt + ((ai * 4 + m) * 2 + bj) * 4096); else ov[m][bj] = (u32x4){0u, 0u, 0u, 0u}; } }
#pragma unroll
            for (int m = 0; m < 4; ++m) { const int row = row0 + ai * HALF + m * 16; const float s = sv[m];
#pragma unroll
                for (int bj = 0; bj < 2; ++bj) { const f32x4 v0 = acc[ai][bj][m][0] * s, v1 = acc[ai][bj][m][1] * s; const u32x4 y = yv[m][bj], o = ov[m][bj];
                    u32x4 w;
                    w.x = cvt_pk_bf16(sigmoidf_(v0[0]) * bflo(y.x) + bflo(o.x), sigmoidf_(v0[1]) * bfhi(y.x) + bfhi(o.x));
                    w.y = cvt_pk_bf16(sigmoidf_(v0[2]) * bflo(y.y) + bflo(o.y), sigmoidf_(v0[3]) * bfhi(y.y) + bfhi(o.y));
                    w.z = cvt_pk_bf16(sigmoidf_(v1[0]) * bflo(y.z) + bflo(o.z), sigmoidf_(v1[1]) * bfhi(y.z) + bfhi(o.z));
                    w.w = cvt_pk_bf16(sigmoidf_(v1[2]) * bflo(y.w) + bflo(o.w), sigmoidf_(v1[3]) * bfhi(y.w) + bfhi(o.w));
                    if (br == 2) *(PG8_GAS u32x4*)((PG8_GAS char*)MG + (size_t)u.pm * 524288 + (size_t)((cb * 4 + bj * 2 + (wc >> 1)) * 32768 + ai * 16384 + lds_byte(wr * 64 + m * 16 + fr, (wc & 1) * 32 + 8 * fq))) = w;     else *(PG8_GAS u32x4*)(mt + ((ai * 4 + m) * 2 + bj) * 4096) = w; } }
        }
    }
};
struct EpiResid {
    static constexpr bool PERM = false, AFTER_DRAIN = false;
    const float* src; float* out; int ldc;
    __device__ __forceinline__ void operator()(const f32x4 (&acc)[2][2][4][2], const Unit& u, int wr, int wc, int fr, int fq) const {
        const int col0 = u.pn * BM + wc * 32 + 4 * fq;
#pragma unroll
        for (int ai = 0; ai < 2; ++ai) { f32x4 bs[4][2][2];
#pragma unroll
            for (int m = 0; m < 4; ++m) { const size_t off = (size_t)(u.pm * BM + ai * HALF + wr * 64 + m * 16 + fr) * ldc + col0;
#pragma unroll
                for (int bj = 0; bj < 2; ++bj)
#pragma unroll
                    for (int n = 0; n < 2; ++n) bs[m][bj][n] = *(const PG8_GAS f32x4*)(src + off + bj * HALF + n * 16); }
#pragma unroll
            for (int m = 0; m < 4; ++m) { const size_t off = (size_t)(u.pm * BM + ai * HALF + wr * 64 + m * 16 + fr) * ldc + col0;
#pragma unroll
                for (int bj = 0; bj < 2; ++bj)
#pragma unroll
                    for (int n = 0; n < 2; ++n) *(PG8_GAS f32x4*)(out + off + bj * HALF + n * 16) = bs[m][bj][n] + acc[ai][bj][m][n]; } }
    }
};
struct EpiResidB {
    static constexpr bool PERM = true, AFTER_DRAIN = false;
    bf16_t* X; int ldc;
    __device__ __forceinline__ void operator()(const f32x4 (&acc)[2][2][4][2], const Unit& u, int wr, int wc, int fr, int fq) const {
        const int row0 = u.pm * BM + wr * 64 + fr; const int col0 = u.pn * BM + wc * 32 + 8 * fq;
#pragma unroll
        for (int ai = 0; ai < 2; ++ai) { u32x4 xs[4][2];
#pragma unroll
            for (int m = 0; m < 4; ++m)
#pragma unroll
                for (int bj = 0; bj < 2; ++bj) xs[m][bj] = *(const PG8_GAS u32x4*)(X + (size_t)(row0 + ai * HALF + m * 16) * ldc + col0 + bj * HALF);
#pragma unroll
            for (int m = 0; m < 4; ++m)
#pragma unroll
                for (int bj = 0; bj < 2; ++bj) { const f32x4 v0 = acc[ai][bj][m][0], v1 = acc[ai][bj][m][1]; const u32x4 a = xs[m][bj];
                    u32x4 w; w.x = cvt_pk_bf16(__uint_as_float(a.x << 16) + v0[0], __uint_as_float(a.x & 0xffff0000u) + v0[1]); w.y = cvt_pk_bf16(__uint_as_float(a.y << 16) + v0[2], __uint_as_float(a.y & 0xffff0000u) + v0[3]);
                    w.z = cvt_pk_bf16(__uint_as_float(a.z << 16) + v1[0], __uint_as_float(a.z & 0xffff0000u) + v1[1]); w.w = cvt_pk_bf16(__uint_as_float(a.w << 16) + v1[2], __uint_as_float(a.w & 0xffff0000u) + v1[3]);
                    *(PG8_GAS u32x4*)(X + (size_t)(row0 + ai * HALF + m * 16) * ldc + col0 + bj * HALF) = w; } }
    }
};
struct EpiMoe1 {
    static constexpr bool PERM = true, AFTER_DRAIN = false;
    bf16_t* H; const PG8_LAS float* rs;
    __device__ __forceinline__ void operator()(const f32x4 (&acc)[2][2][4][2], const Unit& u, int wr, int wc, int fr, int fq) const {
        const int lrow0 = wr * 64 + fr; const int col0 = u.pn * HALF + wc * 32 + 8 * fq;
#pragma unroll
        for (int ai = 0; ai < 2; ++ai)
#pragma unroll
            for (int m = 0; m < 4; ++m) { const int lrow = lrow0 + ai * HALF + m * 16; const float s = rs[u.ord * BM + lrow];
                float h[8];
#pragma unroll
                for (int n = 0; n < 2; ++n)
#pragma unroll
                    for (int e = 0; e < 4; ++e) { const float g = acc[ai][0][m][n][e] * s, uu = acc[ai][1][m][n][e] * s; h[n * 4 + e] = g * sigmoidf_(g) * uu; }
                u32x4 w; w.x = cvt_pk_bf16(h[0], h[1]); w.y = cvt_pk_bf16(h[2], h[3]); w.z = cvt_pk_bf16(h[4], h[5]); w.w = cvt_pk_bf16(h[6], h[7]);
                *(PG8_GAS u32x4*)((PG8_GAS char*)H + (size_t)u.pm * 262144 + (size_t)((u.pn * 2 + (wc >> 1)) * 32768 + ai * 16384 + lds_byte(wr * 64 + m * 16 + fr, (wc & 1) * 32 + 8 * fq))) = w; }
    }
};
struct EpiMoe2 {
    static constexpr bool PERM = true, AFTER_DRAIN = false;
    bf16_t* O; const PG8_LAS float* ws;
    __device__ __forceinline__ void operator()(const f32x4 (&acc)[2][2][4][2], const Unit& u, int wr, int wc, int fr, int fq) const {
        const int lrow0 = wr * 64 + fr; const int col0 = u.pn * BM + wc * 32 + 8 * fq;
#pragma unroll
        for (int ai = 0; ai < 2; ++ai)
#pragma unroll
            for (int m = 0; m < 4; ++m) { const int lrow = lrow0 + ai * HALF + m * 16; const float s = ws[u.ord * BM + lrow]; bf16_t* rowp = O + (size_t)(u.pm * BM + lrow) * 1024 + col0;
#pragma unroll
                for (int bj = 0; bj < 2; ++bj) { const f32x4 v0 = acc[ai][bj][m][0] * s, v1 = acc[ai][bj][m][1] * s;
                    u32x4 w; w.x = cvt_pk_bf16(v0[0], v0[1]); w.y = cvt_pk_bf16(v0[2], v0[3]); w.z = cvt_pk_bf16(v1[0], v1[1]); w.w = cvt_pk_bf16(v1[2], v1[3]);
                    *(PG8_GAS u32x4*)(rowp + bj * HALF) = w; } }
    }
};
template <class Epi, class Sched, bool ALIGN_EPI = false, bool SP2 = false, bool GATHER = false, bool AIMG = false>
__device__ __forceinline__ void gemm_phase(PG8_LAS unsigned char* lds, const Gemm g, const Sched& S, const Epi& E, const int tid_in) {
    int tid_o = tid_in; asm volatile("" : "+v"(tid_o));
    const int tid = tid_o, wid = __builtin_amdgcn_readfirstlane(tid >> 6), lane = tid & 63, wr = wid >> 2, wc = wid & 3, fr = lane & 15, fq = lane >> 4;
    const int K = g.K, nt = K / BK;
    static_assert(!GATHER || SP2, "GATHER is wired into the SP2 loop only");
    unsigned voffA[2], voffB[2]; int gR[2], gC[2];
#pragma unroll
    for (int i = 0; i < 2; ++i) { int R, C; stage_rc(tid * 16 + i * 8192, R, C); gR[i] = R; gC[i] = C; const int Rb = Epi::PERM ? ((R & ~31) + perm32(R & 31)) : R;
        voffA[i] = AIMG ? (unsigned)(tid * 16 + i * 8192) : (unsigned)(R * g.lda + C) * 2u; voffB[i] = (unsigned)(Rb * g.ldb + C) * 2u; }
    static_assert(!(AIMG && GATHER), "AIMG and GATHER are exclusive");
    const size_t kstep = (size_t)(BK * 2), kstepA = AIMG ? (size_t)32768 : kstep;
    const size_t hstepA = AIMG ? (size_t)16384 : (GATHER ? 0 : (size_t)HALF * g.lda * 2), hstepB = (size_t)HALF * g.ldb * 2;
    const size_t tstepA = AIMG ? (size_t)(K / BK) * 32768 : (GATHER ? 0 : 2 * hstepA), tstepB = 2 * hstepB;
    const unsigned ldsw = (unsigned)wid * 1024u;
    const int aoff = lds_byte(wr * 64 + fr, fq * 8), boff = lds_byte(wc * 32 + fr, fq * 8);
#define PG8_SA(b, h) (((b) * 2 + (h)) * HTB)
#define PG8_SB(b, h) ((4 + (b) * 2 + (h)) * HTB)
#define PG8_STAGE(bufoff, gbase, voff) do { _Pragma("unroll") for (int _i = 0; _i < 2; ++_i) \
        __builtin_amdgcn_global_load_lds((const unsigned*)((const char*)(gbase) + (voff)[_i]), (PG8_LAS unsigned*)(lds + (bufoff) + ldsw + _i * 8192), 16, 0, 0); } while (0)
#define PG8_LDA(dst, b, h) do { _Pragma("unroll") for (int m = 0; m < 4; ++m) _Pragma("unroll") for (int k = 0; k < 2; ++k) dst[m][k] = *(const PG8_LAS bf16x8*)(lds + PG8_SA(b, h) + aoff + m * 2048 + k * 1024); } while (0)
#define PG8_LDB(dst, b, h) do { _Pragma("unroll") for (int n = 0; n < 2; ++n) _Pragma("unroll") for (int k = 0; k < 2; ++k) dst[n][k] = *(const PG8_LAS bf16x8*)(lds + PG8_SB(b, h) + boff + n * 2048 + k * 1024); } while (0)
#define PG8_MMA(ai, bj, At, Bt) do { __builtin_amdgcn_s_setprio(1); _Pragma("unroll") for (int m = 0; m < 4; ++m) _Pragma("unroll") for (int n = 0; n < 2; ++n) _Pragma("unroll") for (int k = 0; k < 2; ++k) \
        acc[ai][bj][m][n] = __builtin_amdgcn_mfma_f32_16x16x32_bf16(Bt[n][k], At[m][k], acc[ai][bj][m][n], 0, 0, 0); __builtin_amdgcn_s_setprio(0); } while (0)
#define PG8_WAIT_V(n) asm volatile("s_waitcnt vmcnt(" #n ")" ::: "memory")
#define PG8_WAIT_L(n) asm volatile("s_waitcnt lgkmcnt(" #n ")" ::: "memory")
#define PG8_BAR __builtin_amdgcn_s_barrier()
#define PG8_SCHED __builtin_amdgcn_sched_barrier(0)
    Unit cur, nxt; int ui = 0;
    if (!S.next(0, cur)) return;
    f32x4 acc[2][2][4][2];
#pragma unroll
    for (int a = 0; a < 2; ++a)
#pragma unroll
        for (int b = 0; b < 2; ++b)
#pragma unroll
            for (int m = 0; m < 4; ++m)
#pragma unroll
                for (int n = 0; n < 2; ++n) acc[a][b][m][n] = (f32x4){0.f, 0.f, 0.f, 0.f};
    bf16x8 At[4][2], B0[2][2], B1[2][2];
    const char* cA = (const char*)g.A + (size_t)cur.pm * tstepA + cur.aoff; const char* cB = (const char*)g.Bt + (size_t)cur.pn * tstepB + cur.boff;
    unsigned cv0[2], cv1[2], nv0[2], nv1[2];
#define PG8_SETOFF(d0, d1, u) do { _Pragma("unroll") for (int i_ = 0; i_ < 2; ++i_) { if constexpr (GATHER) { d0[i_] = (unsigned)S.row(u, gR[i_]) * (unsigned)(g.lda * 2) + (unsigned)gC[i_] * 2u; d1[i_] = (unsigned)S.row(u, HALF + gR[i_]) * (unsigned)(g.lda * 2) + (unsigned)gC[i_] * 2u; } else { d0[i_] = voffA[i_]; d1[i_] = voffA[i_]; } } } while (0)
    PG8_SETOFF(cv0, cv1, cur); PG8_SETOFF(nv0, nv1, cur);
    S.a_ready(cur);
    if constexpr (SP2) {
        PG8_STAGE(PG8_SB(0, 0), cB, voffB); PG8_STAGE(PG8_SB(0, 1), cB + hstepB, voffB); PG8_STAGE(PG8_SA(0, 0), cA, cv0); PG8_STAGE(PG8_SA(0, 1), cA + hstepA, cv1);
        if (wr == 1) PG8_BAR;
        PG8_WAIT_V(2); PG8_BAR;
        PG8_STAGE(PG8_SB(1, 0), cB + kstep, voffB); PG8_STAGE(PG8_SA(1, 0), cA + kstepA, cv0); PG8_STAGE(PG8_SB(1, 1), cB + hstepB + kstep, voffB);
        PG8_WAIT_V(6); PG8_BAR;
    } else {
        PG8_STAGE(PG8_SB(0, 0), cB, voffB); PG8_STAGE(PG8_SA(0, 0), cA, voffA); PG8_STAGE(PG8_SB(0, 1), cB + hstepB, voffB); PG8_STAGE(PG8_SA(0, 1), cA + hstepA, voffA);
        if (wr == 1) PG8_BAR;
        PG8_WAIT_V(4); PG8_BAR;
        PG8_STAGE(PG8_SB(1, 0), cB + kstep, voffB); PG8_STAGE(PG8_SA(1, 0), cA + kstepA, voffA); PG8_STAGE(PG8_SB(1, 1), cB + hstepB + kstep, voffB);
        PG8_WAIT_V(6); PG8_BAR;
    }
    for (;;) {
        const bool has_next = S.next(ui + 1, nxt);
        if constexpr (GATHER) { if (has_next) PG8_SETOFF(nv0, nv1, nxt); else { _Pragma("unroll") for (int i = 0; i < 2; ++i) { nv0[i] = cv0[i]; nv1[i] = cv1[i]; } } }
        const char* nA = has_next ? (const char*)g.A + (size_t)nxt.pm * tstepA + nxt.aoff : cA; const char* nB = has_next ? (const char*)g.Bt + (size_t)nxt.pn * tstepB + nxt.boff : cB;
        for (int t = 0; t < nt; t += 2) {
            const bool last = (t == nt - 2);
            unsigned s0[2], s1[2];
#pragma unroll
            for (int i = 0; i < 2; ++i) { s0[i] = last ? nv0[i] : cv0[i]; s1[i] = last ? nv1[i] : cv1[i]; }
            const char* a1 = cA + (size_t)(t + 1) * kstepA;
            const char* a2 = last ? nA : cA + (size_t)(t + 2) * kstepA; const char* b2 = last ? nB : cB + (size_t)(t + 2) * kstep;
            const char* a3 = a2 + kstepA; const char* b3 = b2 + kstep;
            if (last && has_next) S.a_ready(nxt);
            if constexpr (SP2) {
            PG8_LDB(B0, 0, 0); PG8_LDB(B1, 0, 1); PG8_SCHED; PG8_LDA(At, 0, 0); PG8_STAGE(PG8_SA(1, 1), a1 + hstepA, cv1);
            PG8_WAIT_V(8); PG8_WAIT_L(0); PG8_BAR; PG8_MMA(0, 0, At, B0); PG8_MMA(0, 1, At, B1); PG8_BAR; PG8_SCHED;
            PG8_LDA(At, 0, 1); PG8_STAGE(PG8_SB(0, 0), b2, voffB); PG8_STAGE(PG8_SB(0, 1), b2 + hstepB, voffB); PG8_STAGE(PG8_SA(0, 0), a2, s0);
            PG8_WAIT_V(8); PG8_WAIT_L(0); PG8_BAR; PG8_MMA(1, 0, At, B0); PG8_MMA(1, 1, At, B1); PG8_BAR; PG8_SCHED;
            PG8_LDB(B0, 1, 0); PG8_LDB(B1, 1, 1); PG8_SCHED; PG8_LDA(At, 1, 0); PG8_STAGE(PG8_SA(0, 1), a2 + hstepA, s1);
            PG8_WAIT_V(8); PG8_WAIT_L(0); PG8_BAR; PG8_MMA(0, 0, At, B0); PG8_MMA(0, 1, At, B1); PG8_BAR; PG8_SCHED;
            PG8_LDA(At, 1, 1); PG8_STAGE(PG8_SB(1, 0), b3, voffB); PG8_STAGE(PG8_SB(1, 1), b3 + hstepB, voffB); PG8_STAGE(PG8_SA(1, 0), a3, s0);
            PG8_WAIT_V(8); PG8_WAIT_L(0); PG8_BAR; PG8_MMA(1, 0, At, B0); PG8_MMA(1, 1, At, B1); PG8_BAR; PG8_SCHED;
            } else {
            PG8_LDB(B0, 0, 0); PG8_SCHED; PG8_LDA(At, 0, 0); PG8_STAGE(PG8_SA(1, 1), a1 + hstepA, voffA);
            PG8_WAIT_L(8); PG8_BAR; PG8_WAIT_L(0); PG8_MMA(0, 0, At, B0); PG8_BAR; PG8_SCHED;
            PG8_LDB(B1, 0, 1); PG8_STAGE(PG8_SB(0, 0), b2, voffB);
            PG8_BAR; PG8_WAIT_L(0); PG8_MMA(0, 1, At, B1); PG8_BAR;
            PG8_LDA(At, 0, 1); PG8_STAGE(PG8_SA(0, 0), a2, voffA);
            PG8_BAR; PG8_WAIT_L(0); PG8_MMA(1, 0, At, B0); PG8_BAR; PG8_SCHED;
            PG8_STAGE(PG8_SB(0, 1), b2 + hstepB, voffB);
            PG8_WAIT_V(6); PG8_BAR; PG8_MMA(1, 1, At, B1); PG8_BAR;
            PG8_LDB(B0, 1, 0); PG8_SCHED; PG8_LDA(At, 1, 0); PG8_STAGE(PG8_SA(0, 1), a2 + hstepA, voffA);
            PG8_WAIT_L(8); PG8_BAR; PG8_WAIT_L(0); PG8_MMA(0, 0, At, B0); PG8_BAR; PG8_SCHED;
            PG8_LDB(B1, 1, 1); PG8_STAGE(PG8_SB(1, 0), b3, voffB);
            PG8_BAR; PG8_WAIT_L(0); PG8_MMA(0, 1, At, B1); PG8_BAR;
            PG8_LDA(At, 1, 1); PG8_STAGE(PG8_SA(1, 0), a3, voffA);
            PG8_BAR; PG8_WAIT_L(0); PG8_MMA(1, 0, At, B0); PG8_BAR; PG8_SCHED;
            PG8_STAGE(PG8_SB(1, 1), b3 + hstepB, voffB);
            PG8_WAIT_V(6); PG8_BAR; PG8_MMA(1, 1, At, B1); PG8_BAR;
            }
        }
        if constexpr (ALIGN_EPI) { if (wr == 0) PG8_BAR; }
        if constexpr (!Epi::AFTER_DRAIN) { E(acc, cur, wr, wc, fr, fq); S.done(cur); }
        if (!has_next) break;
#pragma unroll
        for (int a = 0; a < 2; ++a)
#pragma unroll
            for (int b = 0; b < 2; ++b)
#pragma unroll
                for (int m = 0; m < 4; ++m)
#pragma unroll
                    for (int n = 0; n < 2; ++n) acc[a][b][m][n] = (f32x4){0.f, 0.f, 0.f, 0.f};
        cur = nxt; cA = nA; cB = nB; ++ui;
#pragma unroll
        for (int i = 0; i < 2; ++i) { cv0[i] = nv0[i]; cv1[i] = nv1[i]; }
        if constexpr (ALIGN_EPI) { if (wr == 1) PG8_BAR; }
    }
    PG8_WAIT_V(0);
    if constexpr (!ALIGN_EPI) { if (wr == 0) PG8_BAR; }
    PG8_BAR;
    if constexpr (Epi::AFTER_DRAIN) { E.fused(acc, cur, wr, wc, fr, fq, lds, wid, lane); S.done(cur); }
#undef PG8_SA
#undef PG8_SB
#undef PG8_STAGE
#undef PG8_SETOFF
#undef PG8_LDA
#undef PG8_LDB
#undef PG8_MMA
#undef PG8_WAIT_V
#undef PG8_WAIT_L
#undef PG8_BAR
#undef PG8_SCHED
}
}
#include <hip/hip_bf16.h>
#include <cmath>
namespace attn_body {
using bf16=__hip_bfloat16;
using bf16x8=__attribute__((ext_vector_type(8)))short;
using s16x4=__attribute__((ext_vector_type(4)))short;
using f32x16=__attribute__((ext_vector_type(16)))float;
using u32x4=__attribute__((ext_vector_type(4)))unsigned;
constexpr int SEQ=8192,D=64,DM=2816;
constexpr int NW=8,QBLK=32,QB=QBLK*NW,KVBLK=64,NQB=SEQ/QB;
constexpr int ATTN_PITCH=DM, ATTN_UNIT_ROWS=QB;
__device__ __forceinline__ int crow(int r,int hi){return (r&3)+8*(r>>2)+4*hi;}
#define SBAR() __builtin_amdgcn_sched_barrier(0)
__device__ __forceinline__ void cmask(f32x16&p0,f32x16&p1,int jb,int qrel,int hi){
  const float NEG=-INFINITY; int kb=64*jb+4*hi;
  #pragma unroll
  for(int r=0;r<16;++r){int kv=kb+(r&3)+8*(r>>2); if(kv>qrel)p0[r]=NEG; if(kv+32>qrel)p1[r]=NEG;}
}

constexpr int NSLOT=3, SLOTB=8192;
constexpr int LDS_K=0, LDS_V=NSLOT*SLOTB;
constexpr int LDS_BYTES=LDS_V+NSLOT*16384+NW*64*4+NW*4096;
constexpr float C2=0.125f*1.4426950408889634f;
__device__ __forceinline__ void glds16(const void*gsrc,unsigned lds_dst){unsigned keep;
  asm volatile("s_mov_b32 %0, m0\n\ts_mov_b32 m0, %2\n\ts_nop 0\n\tglobal_load_lds_dwordx4 %1, off\n\ts_mov_b32 m0, %0":"=&s"(keep):"v"(gsrc),"s"(lds_dst):"memory");}
__device__ __forceinline__ void glds16s(unsigned voff,const void*sbase,unsigned lds_dst){unsigned keep;
  asm volatile("s_mov_b32 %0, m0\n\ts_mov_b32 m0, %3\n\ts_nop 0\n\tglobal_load_lds_dwordx4 %1, %2\n\ts_mov_b32 m0, %0":"=&s"(keep):"v"(voff),"s"(sbase),"s"(lds_dst):"memory");}
__device__ __forceinline__ float max3f(float a,float b,float c){float r;asm("v_max3_f32 %0, %1, %2, %3":"=v"(r):"v"(a),"v"(b),"v"(c));return r;}
__device__ __forceinline__ float max2f(float a,float b){float r;asm("v_max_f32_e32 %0, %1, %2":"=v"(r):"v"(a),"v"(b));return r;}
__device__ __forceinline__ float fadd_s(float a,float b){float r;asm("v_add_f32_e32 %0, %1, %2":"=v"(r):"v"(a),"v"(b));return r;}
__device__ __forceinline__ float fsub_s(float a,float b){float r;asm("v_sub_f32_e32 %0, %1, %2":"=v"(r):"v"(a),"v"(b));return r;}
typedef float f32x2_t __attribute__((ext_vector_type(2))); typedef __bf16 bf16x2_t __attribute__((ext_vector_type(2)));
__device__ __forceinline__ unsigned cvtpk_s(float lo,float hi){f32x2_t v={lo,hi};bf16x2_t b=__builtin_convertvector(v,bf16x2_t);return __builtin_bit_cast(unsigned,b);}
#define WAIT_BAR(N) asm volatile("s_waitcnt vmcnt(" #N ") lgkmcnt(0)\n\ts_barrier":::"memory")

typedef __attribute__((address_space(3))) const char* lds_cptr;
__device__ __forceinline__ void qkt(f32x16&p0,f32x16&p1,lds_cptr Kslot,const bf16x8*qr,const f32x16&negm,int r32,int hi){
  const lds_cptr kb=Kslot+hi*1024+r32*16;
  #pragma unroll
  for(int d0=0;d0<4;++d0){
    const bf16x8 b0=*(const __attribute__((address_space(3))) bf16x8*)(kb+d0*2048);
    const bf16x8 b1=*(const __attribute__((address_space(3))) bf16x8*)(kb+d0*2048+512);
    if(d0==0){p0=__builtin_amdgcn_mfma_f32_32x32x16_bf16(b0,qr[0],negm,0,0,0);p1=__builtin_amdgcn_mfma_f32_32x32x16_bf16(b1,qr[0],negm,0,0,0);}
    else{p0=__builtin_amdgcn_mfma_f32_32x32x16_bf16(b0,qr[d0],p0,0,0,0);p1=__builtin_amdgcn_mfma_f32_32x32x16_bf16(b1,qr[d0],p1,0,0,0);}}
}
typedef short v4i16_t __attribute__((ext_vector_type(4)));
__device__ __forceinline__ void kload8(bf16x8*kf,lds_cptr kp){
  kf[0]=*(const __attribute__((address_space(3))) bf16x8*)(kp);      kf[1]=*(const __attribute__((address_space(3))) bf16x8*)(kp+512);
  kf[2]=*(const __attribute__((address_space(3))) bf16x8*)(kp+2048); kf[3]=*(const __attribute__((address_space(3))) bf16x8*)(kp+2560);
  kf[4]=*(const __attribute__((address_space(3))) bf16x8*)(kp+4096); kf[5]=*(const __attribute__((address_space(3))) bf16x8*)(kp+4608);
  kf[6]=*(const __attribute__((address_space(3))) bf16x8*)(kp+6144); kf[7]=*(const __attribute__((address_space(3))) bf16x8*)(kp+6656);
}
__device__ __forceinline__ void kload2(bf16x8*kf,lds_cptr kp,int j){ kf[2*j]=*(const __attribute__((address_space(3))) bf16x8*)(kp+j*2048); kf[2*j+1]=*(const __attribute__((address_space(3))) bf16x8*)(kp+j*2048+512); }
__device__ __forceinline__ s16x4 vtr(lds_cptr p){ return __builtin_bit_cast(s16x4,__builtin_amdgcn_ds_read_tr16_b64_v4i16((__attribute__((address_space(3))) v4i16_t*)p)); }
__device__ __forceinline__ float rowmax(const f32x16&p0,const f32x16&p1){
  float a=max3f(p0[0],p0[1],p1[0]),b=max3f(p0[2],p0[3],p1[1]);a=max3f(a,p1[2],p1[3]);
  #pragma unroll
  for(int r=4;r<16;r+=4){a=max3f(a,p0[r],p0[r+1]);b=max3f(b,p0[r+2],p0[r+3]);a=max3f(a,p1[r],p1[r+1]);b=max3f(b,p1[r+2],p1[r+3]);}
  const float m=max2f(a,b);
  auto rr=__builtin_amdgcn_permlane32_swap(__float_as_uint(m),__float_as_uint(m),false,false);
  return max2f(__uint_as_float(rr[0]),__uint_as_float(rr[1]));
}
template<int NDB> __device__ __forceinline__ void pv(f32x16*o,int vb,bf16x8 pa0,bf16x8 pa1,bf16x8 pa2,bf16x8 pa3){
  #pragma unroll
  for(int d0=0;d0<NDB;++d0){s16x4 lo[4],hi[4];
    #pragma unroll
    for(int ks=0;ks<4;++ks){
      asm volatile("ds_read_b64_tr_b16 %0,%1 offset:%c2":"=&v"(lo[ks]):"v"(vb),"i"(d0*4096+ks*1024):"memory");
      asm volatile("ds_read_b64_tr_b16 %0,%1 offset:%c2":"=&v"(hi[ks]):"v"(vb),"i"(d0*4096+ks*1024+512):"memory");}
    asm volatile("s_waitcnt lgkmcnt(0)":::"memory");SBAR();
    #define PK(k) (bf16x8){lo[k][0],lo[k][1],lo[k][2],lo[k][3],hi[k][0],hi[k][1],hi[k][2],hi[k][3]}
    o[d0]=__builtin_amdgcn_mfma_f32_32x32x16_bf16(pa0,PK(0),o[d0],0,0,0);
    o[d0]=__builtin_amdgcn_mfma_f32_32x32x16_bf16(pa1,PK(1),o[d0],0,0,0);
    o[d0]=__builtin_amdgcn_mfma_f32_32x32x16_bf16(pa2,PK(2),o[d0],0,0,0);
    o[d0]=__builtin_amdgcn_mfma_f32_32x32x16_bf16(pa3,PK(3),o[d0],0,0,0);
    #undef PK
  }
}

#ifndef ATTN_STORE16
#define ATTN_STORE16(p,v) (*(__attribute__((address_space(1))) u32x4*)(p)=(v))
#endif
template<int THRL,int NDB,bool FIXREF=false> __device__ __forceinline__ void attn_unit(int qb,const bf16*Qb,const bf16*__restrict__ Kb,const bf16*__restrict__ Vb,bf16*Ob,int opitch,char*shm,const int tid_in,const float negref=0.f){
  int tid_o=tid_in; asm volatile("":"+v"(tid_o));
  const int tid=tid_o,lane=tid&63,r32=lane&31,hi=lane>>5; const int wid=__builtin_amdgcn_readfirstlane(tid>>6);
  constexpr int VSLOTB=NDB*4096, LDS_WS=LDS_V+NSLOT*VSLOTB, LDS_OST=LDS_WS+NW*64*4;
  const int q0=qb*QB;
  const bf16*Qw=Qb+(long)(q0+wid*QBLK)*DM;
  const bf16*Kh=Kb,*Vh=Vb;
  const unsigned lds0=(unsigned)(uintptr_t)shm;
  __attribute__((address_space(3))) float*wsf=(__attribute__((address_space(3))) float*)((lds_cptr)shm+LDS_WS)+wid*64;
  const unsigned ksrc=(unsigned)((lane*DM+wid*8)*2);
  const unsigned vsrc=(unsigned)(((16*(wid&3)+(lane>>2))*DM+(wid>>2)*32+(lane&3)*8)*2);
  const unsigned kdst=lds0+LDS_K+wid*1024, vdst=lds0+LDS_V+wid*1024;
  #define DMA_K(t,slot) glds16s(ksrc,(const char*)Kh+(long)(t)*(KVBLK*DM*2),(unsigned)__builtin_amdgcn_readfirstlane(kdst+(slot)))
  #define DMA_V(t,slot) do{ glds16s(vsrc,(const char*)Vh+(long)(t)*(KVBLK*DM*2),(unsigned)__builtin_amdgcn_readfirstlane(vdst+(slot)*(VSLOTB/SLOTB))); if(NDB==4) glds16s(vsrc,(const char*)Vh+(long)(t)*(KVBLK*DM*2)+128,(unsigned)__builtin_amdgcn_readfirstlane(vdst+(slot)*(VSLOTB/SLOTB)+8192)); }while(0)
  const int vb0=(int)(lds0+LDS_V)+((lane>>4)&1)*32+(lane&3)*8+(4*hi+((lane&15)>>2))*64;
  const lds_cptr Kbase=(lds_cptr)shm+LDS_K; bf16x8 kf[8];
  const lds_cptr shm3=(lds_cptr)shm; const lds_cptr kp0=shm3+LDS_K+hi*1024+r32*16; const lds_cptr vp0=shm3+LDS_V+((lane>>4)&1)*32+(lane&3)*8+(4*hi+((lane&15)>>2))*64;
  constexpr int NT=SEQ/KVBLK;
  DMA_K(0,0);DMA_V(0,0);DMA_K(1,SLOTB);
  bf16x8 qr[4];
  #pragma unroll
  for(int d0=0;d0<4;++d0)qr[d0]=*(const __attribute__((address_space(1))) bf16x8*)(&Qw[(long)r32*DM+d0*16+hi*8]);
  float mhat=0.f,l_reg=0.f;f32x16 o[NDB];_Pragma("unroll") for(int d_=0;d_<NDB;++d_)o[d_]=f32x16{};f32x16 negm=f32x16{}; if(FIXREF){_Pragma("unroll") for(int r=0;r<16;++r)negm[r]=negref;} asm volatile("":"+v"(negm));
  #define CMASK(P0,P1,t) do{}while(0)
  bool resc=false;
  #define START(P0,P1) do{ resc=false; if(!FIXREF){ const float rm=rowmax(P0,P1); \
    { const float dl=rm; mhat=fadd_s(mhat,dl); \
      _Pragma("unroll") for(int r=0;r<16;++r){P0[r]=fsub_s(P0[r],dl);P1[r]=fsub_s(P1[r],dl);} \
      _Pragma("unroll") for(int r=0;r<16;++r)negm[r]=-mhat; asm volatile("":"+v"(negm)); } } \
    _Pragma("unroll") for(int r=0;r<16;++r)P0[r]=__builtin_amdgcn_exp2f(P0[r]); }while(0)
  #define RESC() do{ if(!FIXREF&&resc){ asm volatile("s_waitcnt lgkmcnt(0)":::"memory"); \
      _Pragma("unroll") for(int d_=0;d_<NDB;++d_) _Pragma("unroll") for(int r=0;r<16;++r)o[d_][r]*=wsf[crow(r,hi)]; } }while(0)
  f32x16 pA0,pA1,pB0,pB1;
  #define WAIT_KV() do{ if(NDB==4){WAIT_BAR(3);}else{WAIT_BAR(2);} }while(0)
  #define WAIT_V() do{ if(NDB==4){WAIT_BAR(2);}else{WAIT_BAR(1);} }while(0)
  int sl_prev=0,sl_cur=0,sl_next=SLOTB;
  #define ROT() do{sl_prev=sl_cur;sl_cur=sl_next;sl_next=(sl_next==(NSLOT-1)*SLOTB)?0:sl_next+SLOTB;}while(0)
  DMA_K(2,2*SLOTB);
  WAIT_BAR(3);
  qkt(pA0,pA1,Kbase,qr,negm,r32,hi);asm volatile("s_nop 15\n\ts_nop 7":"+v"(pA0),"+v"(pA1));CMASK(pA0,pA1,0);
  START(pA0,pA1);
  _Pragma("unroll") for(int r=0;r<16;++r)pA1[r]=__builtin_amdgcn_exp2f(pA1[r]);
  WAIT_BAR(0);
  DMA_K(3,0);DMA_V(1,SLOTB);
  ROT();
  kload8(kf,kp0+sl_cur);
  WAIT_KV();
  s16x4 vlo[8],vhi[8]; u32x4 pw0,pw1,pw2,pw3;
  #define PKW(P,B) cvtpk_s(P[B],P[B+1])
  #define PAF(k) __builtin_bit_cast(bf16x8,pw##k)
  #define VFR(i) (bf16x8){vlo[i][0],vlo[i][1],vlo[i][2],vlo[i][3],vhi[i][0],vhi[i][1],vhi[i][2],vhi[i][3]}
  #define PIN(x) asm volatile("":"+v"(x))
  #define MX3(a,b,c) __builtin_fmaxf(__builtin_fmaxf((a),(b)),(c))
  #define GAPA(MF,A0,A1,A2,A3,W0,W1,PW) do{ MF; sacc+=A0; sacc+=A1; sacc+=A2; sacc+=A3; PIN(sacc); W0; W1; PIN(PW); SBAR(); }while(0)
  #define EX(v) __builtin_amdgcn_exp2f(v)
  #define GAPB(MF,X,B) do{ MF; X[B]=EX(X[B]); X[B+1]=EX(X[B+1]); X[B+2]=EX(X[B+2]); X[B+3]=EX(X[B+3]); PIN(X); SBAR(); }while(0)
  #define GAPB2(MF,X,B) do{ MF; X[B]=EX(X[B]); X[B+1]=EX(X[B+1]); PIN(X); SBAR(); }while(0)
  #define VRDX(s,ks,db) do{ vlo[s]=vtr(vp_+((db)*4096+(ks)*1024)); vhi[s]=vtr(vp_+((db)*4096+(ks)*1024+512)); }while(0)
  #define VRDA(i) do{ if(NDB==2){VRD(i);} else if(((i)&3)<2){ VRDX(2*((i)&3)+((i)>>2),(i)&3,(i)>>2); } }while(0)
  #define VRD(i) do{ vlo[i]=vtr(vp_+(((i)>>2)*4096+((i)&3)*1024)); vhi[i]=vtr(vp_+(((i)>>2)*4096+((i)&3)*1024+512)); }while(0)
  #define KRD(G,j) do{ if(G){ kload2(kf,kp0+sl_next,j); SBAR(); } }while(0)
  #define STEP(C0,C1,P0,P1,t,GK,GV,GL) do{ SBAR(); \
    const lds_cptr vp_=vp0+sl_prev*(VSLOTB/SLOTB); \
    VRDA(0); SBAR(); float sacc=(P0[0]+P0[1]); \
    GAPA(C0=__builtin_amdgcn_mfma_f32_32x32x16_bf16(kf[0],qr[0],negm,0,0,0), P0[2],P0[3],P0[4],P0[5],     pw0[0]=PKW(P0,0), pw0[1]=PKW(P0,2), pw0); \
    VRDA(4); SBAR(); GAPA(C1=__builtin_amdgcn_mfma_f32_32x32x16_bf16(kf[1],qr[0],negm,0,0,0), P0[6],P0[7],P0[8],P0[9],     pw0[2]=PKW(P0,4), pw0[3]=PKW(P0,6), pw0); \
    VRDA(1); SBAR(); GAPA(C0=__builtin_amdgcn_mfma_f32_32x32x16_bf16(kf[2],qr[1],C0,0,0,0),   P0[10],P0[11],P0[12],P0[13], pw1[0]=PKW(P0,8), pw1[1]=PKW(P0,10), pw1); \
    VRDA(5); SBAR(); GAPA(C1=__builtin_amdgcn_mfma_f32_32x32x16_bf16(kf[3],qr[1],C1,0,0,0),   P0[14],P0[15],P1[0],P1[1],   pw1[2]=PKW(P0,12),pw1[3]=PKW(P0,14), pw1); \
    VRDA(2); SBAR(); GAPA(C0=__builtin_amdgcn_mfma_f32_32x32x16_bf16(kf[4],qr[2],C0,0,0,0),   P1[2],P1[3],P1[4],P1[5],     pw2[0]=PKW(P1,0), pw2[1]=PKW(P1,2), pw2); \
    VRDA(6); SBAR(); GAPA(C1=__builtin_amdgcn_mfma_f32_32x32x16_bf16(kf[5],qr[2],C1,0,0,0),   P1[6],P1[7],P1[8],P1[9],     pw2[2]=PKW(P1,4), pw2[3]=PKW(P1,6), pw2); \
    VRDA(3); SBAR(); GAPA(C0=__builtin_amdgcn_mfma_f32_32x32x16_bf16(kf[6],qr[3],C0,0,0,0),   P1[10],P1[11],P1[12],P1[13], pw3[0]=PKW(P1,8), pw3[1]=PKW(P1,10), pw3); \
    VRDA(7); SBAR(); GAPA(C1=__builtin_amdgcn_mfma_f32_32x32x16_bf16(kf[7],qr[3],C1,0,0,0),   P1[14],P1[15],0.f,0.f,       pw3[2]=PKW(P1,12),pw3[3]=PKW(P1,14), pw3); \
    l_reg+=sacc; \
    if(GK){DMA_K((t)+3,sl_cur);} if(GV){DMA_V((t)+1,sl_next);} \
    CMASK(C0,C1,t); \
    if(!FIXREF){ float a=MX3(C0[0],C0[1],C1[0]),b=MX3(C0[2],C0[3],C1[1]); a=MX3(a,C1[2],C1[3]); \
      _Pragma("unroll") for(int r=4;r<16;r+=4){a=MX3(a,C0[r],C0[r+1]);b=MX3(b,C0[r+2],C0[r+3]);a=MX3(a,C1[r],C1[r+1]);b=MX3(b,C1[r+2],C1[r+3]);} \
      float rm=__builtin_fmaxf(a,b); { auto rr=__builtin_amdgcn_permlane32_swap(__float_as_uint(rm),__float_as_uint(rm),false,false); rm=__builtin_fmaxf(__uint_as_float(rr[0]),__uint_as_float(rr[1])); } \
      resc=false; \
      if(__builtin_expect(__any(rm>(float)THRL),0)){ const float dl=__builtin_fmaxf(rm,0.f); mhat+=dl; \
        _Pragma("unroll") for(int r=0;r<16;++r){C0[r]-=dl;C1[r]-=dl;} \
        _Pragma("unroll") for(int r=0;r<16;++r)negm[r]=-mhat; asm volatile("":"+v"(negm)); \
        const float f=__builtin_amdgcn_exp2f(-dl); l_reg*=f; if(hi==0)wsf[r32]=f; resc=true; } } \
    SBAR(); \
    if(NDB==2){ \
    GAPB(o[0]=__builtin_amdgcn_mfma_f32_32x32x16_bf16(PAF(0),VFR(0),o[0],0,0,0), C0,0); \
    GAPB(o[1]=__builtin_amdgcn_mfma_f32_32x32x16_bf16(PAF(0),VFR(4),o[1],0,0,0), C0,4); \
    KRD(GL,0); GAPB(o[0]=__builtin_amdgcn_mfma_f32_32x32x16_bf16(PAF(1),VFR(1),o[0],0,0,0), C0,8); \
    KRD(GL,1); GAPB(o[1]=__builtin_amdgcn_mfma_f32_32x32x16_bf16(PAF(1),VFR(5),o[1],0,0,0), C0,12); \
    KRD(GL,2); GAPB(o[0]=__builtin_amdgcn_mfma_f32_32x32x16_bf16(PAF(2),VFR(2),o[0],0,0,0), C1,0); \
    KRD(GL,3); GAPB(o[1]=__builtin_amdgcn_mfma_f32_32x32x16_bf16(PAF(2),VFR(6),o[1],0,0,0), C1,4); \
    GAPB(o[0]=__builtin_amdgcn_mfma_f32_32x32x16_bf16(PAF(3),VFR(3),o[0],0,0,0), C1,8); \
    GAPB(o[1]=__builtin_amdgcn_mfma_f32_32x32x16_bf16(PAF(3),VFR(7),o[1],0,0,0), C1,12); \
    } else { \
    GAPB2(o[0]=__builtin_amdgcn_mfma_f32_32x32x16_bf16(PAF(0),VFR(0),o[0],0,0,0), C0,0); VRDX(0,2,0); SBAR(); \
    GAPB2(o[1]=__builtin_amdgcn_mfma_f32_32x32x16_bf16(PAF(0),VFR(1),o[1],0,0,0), C0,2); VRDX(1,2,1); SBAR(); \
    GAPB2(o[0]=__builtin_amdgcn_mfma_f32_32x32x16_bf16(PAF(1),VFR(2),o[0],0,0,0), C0,4); VRDX(2,3,0); SBAR(); \
    GAPB2(o[1]=__builtin_amdgcn_mfma_f32_32x32x16_bf16(PAF(1),VFR(3),o[1],0,0,0), C0,6); VRDX(3,3,1); SBAR(); \
    GAPB2(o[0]=__builtin_amdgcn_mfma_f32_32x32x16_bf16(PAF(2),VFR(0),o[0],0,0,0), C0,8); VRDX(0,0,2); SBAR(); \
    GAPB2(o[1]=__builtin_amdgcn_mfma_f32_32x32x16_bf16(PAF(2),VFR(1),o[1],0,0,0), C0,10); VRDX(1,0,3); SBAR(); \
    GAPB2(o[0]=__builtin_amdgcn_mfma_f32_32x32x16_bf16(PAF(3),VFR(2),o[0],0,0,0), C0,12); VRDX(2,1,2); SBAR(); \
    GAPB2(o[1]=__builtin_amdgcn_mfma_f32_32x32x16_bf16(PAF(3),VFR(3),o[1],0,0,0), C0,14); VRDX(3,1,3); SBAR(); \
    GAPB2(o[2]=__builtin_amdgcn_mfma_f32_32x32x16_bf16(PAF(0),VFR(0),o[2],0,0,0), C1,0); VRDX(0,2,2); SBAR(); \
    GAPB2(o[3]=__builtin_amdgcn_mfma_f32_32x32x16_bf16(PAF(0),VFR(1),o[3],0,0,0), C1,2); VRDX(1,2,3); SBAR(); \
    GAPB2(o[2]=__builtin_amdgcn_mfma_f32_32x32x16_bf16(PAF(1),VFR(2),o[2],0,0,0), C1,4); VRDX(2,3,2); SBAR(); \
    GAPB2(o[3]=__builtin_amdgcn_mfma_f32_32x32x16_bf16(PAF(1),VFR(3),o[3],0,0,0), C1,6); VRDX(3,3,3); SBAR(); \
    KRD(GL,0); GAPB2(o[2]=__builtin_amdgcn_mfma_f32_32x32x16_bf16(PAF(2),VFR(0),o[2],0,0,0), C1,8); \
    KRD(GL,1); GAPB2(o[3]=__builtin_amdgcn_mfma_f32_32x32x16_bf16(PAF(2),VFR(1),o[3],0,0,0), C1,10); \
    KRD(GL,2); GAPB2(o[2]=__builtin_amdgcn_mfma_f32_32x32x16_bf16(PAF(3),VFR(2),o[2],0,0,0), C1,12); \
    KRD(GL,3); GAPB2(o[3]=__builtin_amdgcn_mfma_f32_32x32x16_bf16(PAF(3),VFR(3),o[3],0,0,0), C1,14); \
    } \
    }while(0)
  int t=1;
  #undef CMASK
  #define CMASK(P0,P1,t) do{}while(0)
  for(;t+5<NT;t+=2){
    STEP(pB0,pB1,pA0,pA1,t,true,true,true);     WAIT_KV(); RESC(); ROT();
    STEP(pA0,pA1,pB0,pB1,t+1,true,true,true);   WAIT_KV(); RESC(); ROT();
  }
  #undef CMASK
  #define CMASK(P0,P1,t) do{}while(0)
  #define ENDW(tt) do{ if((tt)+3<NT){WAIT_KV();} else if((tt)+2<NT){WAIT_V();} else {WAIT_BAR(0);} }while(0)
  for(;t+1<NT;t+=2){
    STEP(pB0,pB1,pA0,pA1,t,(t+3<NT),(t+1<NT),(t+1<NT));       ENDW(t);   RESC(); ROT();
    STEP(pA0,pA1,pB0,pB1,t+1,(t+4<NT),(t+2<NT),(t+2<NT));     ENDW(t+1); RESC(); ROT();
  }
  STEP(pB0,pB1,pA0,pA1,NT-1,false,false,false); RESC();
  { float sacc=pB0[0]+pB0[1]; _Pragma("unroll") for(int r=2;r<16;++r)sacc+=pB0[r]; _Pragma("unroll") for(int r=0;r<16;++r)sacc+=pB1[r]; l_reg+=sacc;
    pw0=(u32x4){PKW(pB0,0),PKW(pB0,2),PKW(pB0,4),PKW(pB0,6)};pw1=(u32x4){PKW(pB0,8),PKW(pB0,10),PKW(pB0,12),PKW(pB0,14)};pw2=(u32x4){PKW(pB1,0),PKW(pB1,2),PKW(pB1,4),PKW(pB1,6)};pw3=(u32x4){PKW(pB1,8),PKW(pB1,10),PKW(pB1,12),PKW(pB1,14)};
    SBAR(); pv<NDB>(o,vb0+sl_cur*(VSLOTB/SLOTB),PAF(0),PAF(1),PAF(2),PAF(3)); }
  #undef PKW
  #undef PAF
  #undef VFR
  #undef PIN
  #undef MX3
  #undef GAPA
  #undef GAPB
  #undef EX
  #undef VRD
  #undef VRDX
  #undef VRDA
  #undef GAPB2
  #undef KRD
  #undef STEP
  #undef ENDW
  {auto rr=__builtin_amdgcn_permlane32_swap(__float_as_uint(l_reg),__float_as_uint(l_reg),false,false);l_reg=__uint_as_float(rr[0])+__uint_as_float(rr[1]);}
  if(hi==0)wsf[32+r32]=l_reg;asm volatile("s_waitcnt lgkmcnt(0)":::"memory");
  float rli[16];
  #pragma unroll
  for(int r=0;r<16;++r)rli[r]=__builtin_amdgcn_rcpf(wsf[32+crow(r,hi)]);
  bf16*Ow=Ob+(long)(q0+wid*QBLK)*opitch;
  _Pragma("unroll") for(int hf=0;hf<NDB/2;++hf){ __attribute__((address_space(3))) unsigned short*stg=(__attribute__((address_space(3))) unsigned short*)((lds_cptr)shm+LDS_OST)+wid*2048;
    #pragma unroll
    for(int r=0;r<16;++r){const int orow=crow(r,hi);
      #pragma unroll
      for(int d0=0;d0<2;++d0)stg[orow*64+d0*32+r32]=(unsigned short)(cvtpk_s(o[2*hf+d0][r]*rli[r],0.f)&0xffffu);}
    asm volatile("s_waitcnt lgkmcnt(0)":::"memory");
    #pragma unroll
    for(int i=0;i<4;++i){const int row=i*8+(lane>>3),ch=lane&7; const u32x4 v=*(const __attribute__((address_space(3))) u32x4*)(stg+row*64+ch*8); ATTN_STORE16(Ow+(long)row*opitch+hf*64+ch*8,v);}
    asm volatile("s_waitcnt lgkmcnt(0)":::"memory"); }
  asm volatile("s_waitcnt lgkmcnt(0)\n\ts_barrier":::"memory");
  #undef DMA_K
  #undef DMA_V
  #undef CMASK
  #undef START
  #undef RESC
  #undef ROT
  #undef WAIT_KV
  #undef WAIT_V
}
constexpr int ATTN_LDS_BYTES=LDS_BYTES;
#undef SBAR
#undef WAIT_BAR
}

#ifndef MK_SPLIT
#define MK_SPLIT 0
#endif
constexpr int NWAVES = 8;
constexpr int DM = 1024, NBATCH = 4, SEQ = 8192, TOK = NBATCH * SEQ, NLAYER = 2, INC = 7440;
constexpr float EPS = 1e-6f;
constexpr float QSCALE = 0.125f * 1.4426950408889634f;
constexpr int NPH = 26;
constexpr size_t MiB = 1u << 20;
constexpr size_t WS_CTL = 0, CTL_ZERO_BYTES = 1 * MiB;
constexpr size_t WS_COS1 = 1 * MiB, WS_SIN1 = 2 * MiB;
constexpr size_t WS_AX = 3 * MiB;
constexpr size_t WS_WBA = 3 * MiB + 64 * 1024;
constexpr size_t WS_WRT = 3 * MiB + 256 * 1024;
constexpr size_t WS_RSTD1 = 4 * MiB, WS_RSTD2 = 4 * MiB + 128 * 1024, WS_RSTDF = 4 * MiB + 256 * 1024;
constexpr size_t WS_BA = 4 * MiB + 512 * 1024;
constexpr size_t WS_TOKL = 7 * MiB;
constexpr size_t WS_WL = 11 * MiB;
constexpr size_t WS_TSLOT = 15 * MiB;
constexpr size_t WS_WROW = 15 * MiB + 256 * 1024;
constexpr size_t WS_RROW = 15 * MiB + 576 * 1024;
constexpr size_t WS_WIN = 16 * MiB;
constexpr size_t WS_WG = 33 * MiB;
constexpr size_t WS_WBR = 45 * MiB;
constexpr size_t WS_WO3 = 51 * MiB;
constexpr size_t WS_XB = 55 * MiB;
constexpr size_t WS_MM = 520 * MiB, WS_INTRA = 552 * MiB;
constexpr size_t WS_PP = 119 * MiB;
constexpr size_t WS_RAW = 295 * MiB;
constexpr size_t WS_OF = 295 * MiB, WS_OB = 327 * MiB;
constexpr size_t WS_KN = 391 * MiB, WS_KT = 423 * MiB, WS_QN = 455 * MiB, WS_VC = 487 * MiB;
constexpr size_t WS_GC = 519 * MiB;
constexpr size_t WS_OD = 391 * MiB;
constexpr size_t WS_YBR = 295 * MiB;
constexpr size_t WS_MGT = 183 * MiB;
constexpr size_t WS_MG = 119 * MiB;
constexpr size_t WS_W13T = 487 * MiB, WS_W2T = 551 * MiB;
constexpr size_t WS_XG = 215 * MiB;
constexpr size_t WS_HH = 359 * MiB;
constexpr size_t WS_END = 584 * MiB;
constexpr int PPW = 2816, PC_Z = 0, PC_DQ = 512, PC_DK = 1024, PC_DV = 1536, PC_CQ = 2048, PC_CK = 2560, PC_CV = 2688;
constexpr int CW_BAR = 4096, CW_CNT = 8192, CW_NRM = 8448;
constexpr int RING_BYTES = 131072, LDSCTL_OFF = 145408, LDS_TBASE = LDSCTL_OFF + 256, LDS_TILEE = LDSCTL_OFF + 512;
constexpr int LDS_ROWTAB = LDSCTL_OFF + 2048, LDS_RSTAB = LDS_ROWTAB + 5120, LDS_WTAB = LDS_RSTAB + 5120, LDS_BYTES = LDS_WTAB + 5120;
static_assert(LDS_BYTES <= 163840, "LDS");

#define GAS __attribute__((address_space(1)))
#define LAS __attribute__((address_space(3)))
typedef unsigned short bf16;
typedef unsigned v4u __attribute__((ext_vector_type(4)));
typedef unsigned v2u __attribute__((ext_vector_type(2)));
typedef float f32x4 __attribute__((ext_vector_type(4)));
typedef short bf16x8 __attribute__((ext_vector_type(8)));
typedef GAS unsigned gu32;
#define RLX_AGENT __ATOMIC_RELAXED, __HIP_MEMORY_SCOPE_AGENT
#define LDS_WAIT() asm volatile("s_waitcnt lgkmcnt(0)" ::: "memory")
#define LBAR() do { asm volatile("s_waitcnt lgkmcnt(0)" ::: "memory"); __builtin_amdgcn_s_barrier(); asm volatile("" ::: "memory"); } while (0)
__device__ __forceinline__ unsigned pk2(float lo, float hi) { return pg8::cvt_pk_bf16(lo, hi); }
__device__ __forceinline__ float bflo(unsigned w) { return __uint_as_float(w << 16); }
__device__ __forceinline__ float bfhi(unsigned w) { return __uint_as_float(w & 0xffff0000u); }
__device__ __forceinline__ float bf2f(bf16 v) { return __uint_as_float((unsigned)v << 16); }
__device__ __forceinline__ float lshfl(float v, int src) { return __int_as_float(__builtin_amdgcn_ds_bpermute(src << 2, __float_as_int(v))); }
__device__ __forceinline__ int lshfl(int v, int src) { return __builtin_amdgcn_ds_bpermute(src << 2, v); }
#define SHFL_XOR(v, m) lshfl((v), lane ^ (m))
#define SHFL_UP(v, o) lshfl((v), (lane - (o)) & 63)
#define SHFL(v, s) lshfl((v), (s))
__device__ __forceinline__ float wave_sum(float v, int) {
    v += __int_as_float(__builtin_amdgcn_update_dpp(0, __float_as_int(v), 0xB1, 0xf, 0xf, false));
    v += __int_as_float(__builtin_amdgcn_update_dpp(0, __float_as_int(v), 0x4E, 0xf, 0xf, false));
    v += __int_as_float(__builtin_amdgcn_update_dpp(0, __float_as_int(v), 0x141, 0xf, 0xf, false));
    v += __int_as_float(__builtin_amdgcn_update_dpp(0, __float_as_int(v), 0x140, 0xf, 0xf, false));
    v += __int_as_float(__builtin_amdgcn_update_dpp(0, __float_as_int(v), 0x142, 0xa, 0xf, false));
    v += __int_as_float(__builtin_amdgcn_update_dpp(0, __float_as_int(v), 0x143, 0xc, 0xf, false));
    return __int_as_float(__builtin_amdgcn_readlane(__float_as_int(v), 63));
}
__device__ __forceinline__ float row16_sum(float v) {
    v += __int_as_float(__builtin_amdgcn_update_dpp(0, __float_as_int(v), 0xB1, 0xf, 0xf, false));
    v += __int_as_float(__builtin_amdgcn_update_dpp(0, __float_as_int(v), 0x4E, 0xf, 0xf, false));
    v += __int_as_float(__builtin_amdgcn_update_dpp(0, __float_as_int(v), 0x141, 0xf, 0xf, false));
    v += __int_as_float(__builtin_amdgcn_update_dpp(0, __float_as_int(v), 0x140, 0xf, 0xf, false));
    return v;
}
__device__ __forceinline__ float sigm(float x) { return __builtin_amdgcn_rcpf(1.0f + __expf(-x)); }
__device__ __forceinline__ f32x4 mfma16(bf16x8 a, bf16x8 b, f32x4 c) { return __builtin_amdgcn_mfma_f32_16x16x32_bf16(a, b, c, 0, 0, 0); }
#define XB_TMO      128
#define XB_XCNT(j)  (256  + 64 * (j))
#define XB_XSUB(j)  (1280 + 64 * (j))
#define XB_XGEN(j)  (2304 + 64 * (j))
#define XB_TOP      3328
#define XB_TOPGEN   3392
#define XCD_BAR_WORDS 3456
#define XB_SPIN_CAP (1u << 18)

__device__ __forceinline__ unsigned xb_ld(unsigned* p)              { return __hip_atomic_load(p, __ATOMIC_RELAXED, __HIP_MEMORY_SCOPE_AGENT); }
__device__ __forceinline__ unsigned xb_add(unsigned* p, unsigned v) { asm volatile("" : "+v"(v));
    return __hip_atomic_fetch_add(p, v, __ATOMIC_RELAXED, __HIP_MEMORY_SCOPE_AGENT); }
__device__ __forceinline__ unsigned xb_xcc_id() { return (unsigned)__builtin_amdgcn_s_getreg((3 << 11) | 20) & 0xFu; }
#define XB_SPIN(cond, bar) do { unsigned _sp = 0; while (cond) { __builtin_amdgcn_s_sleep(1); \
    if ((++_sp & 255u) == 0u) { if (xb_ld(&(bar)[XB_TMO])) break; if (_sp > XB_SPIN_CAP) { atomicAdd(&(bar)[XB_TMO], 1u); break; } } } } while (0)

struct XcdBarrier {
    unsigned* bar; unsigned x;
    volatile LAS unsigned* st;
};

__device__ __forceinline__ XcdBarrier xcd_barrier_post(unsigned* bar, volatile LAS unsigned* st) {
    XcdBarrier b; b.bar = bar; b.x = xb_xcc_id(); b.st = st;
    if (threadIdx.x == 0) (void)xb_add(&bar[XB_XCNT(b.x)], 1u);
    return b;
}
__device__ __forceinline__ void xcd_barrier_complete(unsigned* bar, unsigned x, unsigned& nloc, unsigned& nx) {
    const unsigned G = gridDim.x * gridDim.y * gridDim.z;
    unsigned sum, cnt, mine, sp = 0u;
    for (;;) {
        sum = 0u; cnt = 0u; mine = 0u;
#pragma unroll
        for (unsigned j = 0; j < 16; ++j) { const unsigned c = xb_ld(&bar[XB_XCNT(j)]); sum += c; cnt += (c > 0u) ? 1u : 0u; mine = (j == x) ? c : mine; }
        if (sum == G) break;
        __builtin_amdgcn_s_sleep(1);
        if ((++sp & 255u) == 0u) { if (xb_ld(&bar[XB_TMO])) break; if (sp > XB_SPIN_CAP) { atomicAdd(&bar[XB_TMO], 1u); break; } }
    }
    nloc = mine > 0u ? mine : 1u; nx = cnt > 0u ? cnt : 1u;
}

__device__ __forceinline__ void xcd_barrier(const XcdBarrier& b) {
    asm volatile("s_waitcnt vmcnt(0)" ::: "memory");
    __syncthreads();
    if (threadIdx.x == 0) {
        unsigned* bar = b.bar;
        __builtin_amdgcn_s_waitcnt(0);
        unsigned nloc = b.st[0], nx = b.st[1];
        if (nloc == 0u) { xcd_barrier_complete(bar, b.x, nloc, nx); b.st[0] = nloc; b.st[1] = nx; }
        const unsigned old = xb_add(&bar[XB_XSUB(b.x)], 1u);
        const unsigned gen = old / nloc;
        if (old + 1u == (gen + 1u) * nloc) {
            __builtin_amdgcn_fence(__ATOMIC_RELEASE, "agent");
            asm volatile("s_waitcnt vmcnt(0)" ::: "memory");
            const unsigned og = xb_add(&bar[XB_TOP], 1u);
            const unsigned tg = og / nx;
            if (og + 1u == (tg + 1u) * nx) xb_add(&bar[XB_TOPGEN], 1u);
            else XB_SPIN(xb_ld(&bar[XB_TOPGEN]) == tg, bar);
            __builtin_amdgcn_fence(__ATOMIC_ACQUIRE, "agent");
            xb_add(&bar[XB_XGEN(b.x)], 1u);
            asm volatile("s_waitcnt vmcnt(0)" ::: "memory");
        } else {
            XB_SPIN(xb_ld(&bar[XB_XGEN(b.x)]) == gen, bar);
            __builtin_amdgcn_fence(__ATOMIC_ACQUIRE, "agent");
            asm volatile("s_waitcnt vmcnt(0)" ::: "memory");
        }
    }
    __syncthreads();
}

struct Args { const float* in[24]; float* out; unsigned char* ws; int ph_lo, ph_hi; };
struct Frame {
    LAS unsigned char* lds; unsigned char* ldsg;
    volatile LAS unsigned* MISC;
    gu32* ctl;
    int tid, lane, wave, vcu, G;
    const __attribute__((address_space(4))) Args* A; float* out; unsigned char* ws;
};
#define INP(k) (F.A->in[k])
#define WSP(T, off) ((T*)(F.ws + (off)))
#define WSG(T, off) ((GAS T*)(F.ws + (off)))

__device__ __forceinline__ void tr_item(const float* W, int ldw, int srccol0, int k0, bf16* WT, int ldt, int dstrow0, int dstk0, const float* ksc, LAS float* scr, int lane) {
    f32x4 v[8];
#pragma unroll
    for (int i = 0; i < 8; ++i) v[i] = __builtin_nontemporal_load((const f32x4*)(W + (size_t)(k0 + 8 * i + (lane >> 3)) * ldw + srccol0 + 4 * (lane & 7)));
#pragma unroll
    for (int i = 0; i < 8; ++i) { const int kk = 8 * i + (lane >> 3); const float sc = ksc ? ksc[k0 + kk] : 1.0f; LAS float* d = scr + kk * 33 + 4 * (lane & 7);
        d[0] = v[i][0] * sc; d[1] = v[i][1] * sc; d[2] = v[i][2] * sc; d[3] = v[i][3] * sc; }
    LDS_WAIT(); asm volatile("" ::: "memory");
    const int c = lane & 7;
#pragma unroll
    for (int j = 0; j < 4; ++j) { const int n = (lane >> 3) + 8 * j; const LAS float* s = scr + (8 * c) * 33 + n;
        v4u o; o.x = pk2(s[0 * 33], s[1 * 33]); o.y = pk2(s[2 * 33], s[3 * 33]); o.z = pk2(s[4 * 33], s[5 * 33]); o.w = pk2(s[6 * 33], s[7 * 33]);
        *(GAS v4u*)(WT + (size_t)(dstrow0 + n) * ldt + dstk0 + 8 * c) = o; }
    LDS_WAIT(); asm volatile("" ::: "memory");
}
__device__ __forceinline__ void sincos_d(double x, double& s, double& c) {
    const double q = rint(x * 0.6366197723675814); double r = fma(-q, 1.5707963267948966, x); r = fma(-q, 6.123233995736766e-17, r);
    const double r2 = r * r;
    double sp = -7.647163731819816e-13; sp = fma(sp, r2, 1.6059043836821613e-10); sp = fma(sp, r2, -2.505210838544172e-08); sp = fma(sp, r2, 2.7557319223985893e-06); sp = fma(sp, r2, -1.984126984126984e-04); sp = fma(sp, r2, 8.333333333333333e-03); sp = fma(sp, r2, -1.6666666666666666e-01);
    const double sr = fma(sp * r2, r, r);
    double cp = 4.779477332387385e-14; cp = fma(cp, r2, -1.1470745597729725e-11); cp = fma(cp, r2, 2.08767569878681e-09); cp = fma(cp, r2, -2.755731922398589e-07); cp = fma(cp, r2, 2.48015873015873e-05); cp = fma(cp, r2, -1.388888888888889e-03); cp = fma(cp, r2, 4.1666666666666664e-02); cp = fma(cp, r2, -0.5);
    const double cr = fma(cp, r2, 1.0);
    const int qi = ((int)q) & 3;
    s = (qi == 0) ? sr : (qi == 1) ? cr : (qi == 2) ? -sr : -cr;
    c = (qi == 0) ? cr : (qi == 1) ? -sr : (qi == 2) ? -cr : sr;
}
__device__ __forceinline__ void p0_prologue(Frame& F) {
    LAS float* scr = (LAS float*)(F.lds + F.wave * 16384);
    const int gw = F.vcu * NWAVES + F.wave, NGW = F.G * NWAVES;
    constexpr int I_A = 136 * 16, I_B = 96 * 16, I_C = 3 * 256, I_D = 512, I_L = I_A + I_B + I_C + I_D;
    for (int it0 = gw; it0 < NLAYER * I_L; it0 += NGW) {
        const int l = it0 / I_L; int r = it0 % I_L;
        const float* anw = INP(1) + l * DM;
        if (r < I_A) { const int db = r / 16, kb = r % 16, d0 = 32 * db; const int pt_ = (d0 >> 8) - 6, rho = d0 & 255;
            const int lc = ((pt_ >= 2 && pt_ <= 5) || pt_ >= 8) ? (d0 & ~255) + ((rho >> 5) & 3) * 64 + (rho >> 7) * 32 : d0;
            tr_item(INP(2) + (size_t)l * DM * INC, INC, lc < 2048 ? lc : lc + 16, 64 * kb, WSP(bf16, WS_WIN) + (size_t)l * 4352 * 1024, 1024, d0, 64 * kb, anw, scr, F.lane); continue; } r -= I_A;
        if (r < I_B) { const int db = r / 16, kb = r % 16, d0 = 32 * db; tr_item(INP(2) + (size_t)l * DM * INC, INC, 4368 + d0, 64 * kb, WSP(bf16, WS_WG) + (size_t)l * 3072 * 1024, 1024, d0, 64 * kb, anw, scr, F.lane); continue; } r -= I_B;
        if (r < I_C) { const int i = r / 256, rr = r % 256, db = rr / 8, kb = rr % 8; tr_item((i == 0 ? INP(11) : (i == 1 ? INP(12) : INP(13))) + (size_t)l * 512 * 1024, 1024, 32 * db, 64 * kb, WSP(bf16, WS_WBR) + (size_t)l * 3072 * 512, 512, i * 1024 + 32 * db, 64 * kb, nullptr, scr, F.lane); continue; } r -= I_C;
        { const int db = r / 16, kb = r % 16; tr_item(INP(14) + (size_t)l * 1024 * 1024, 1024, 32 * db, 64 * kb, WSP(bf16, WS_WO3) + (size_t)l * 1024 * 1024, 1024, 32 * db, 64 * kb, nullptr, scr, F.lane); }
    }
    const int gt = (F.vcu * NWAVES + F.wave) * 64 + F.lane, NGT = F.G * NWAVES * 64;
    float* wba = WSP(float, WS_WBA); float* wrt = WSP(float, WS_WRT);
    for (int i = gt; i < NLAYER * 16 * 1024; i += NGT) { const int l = i / (16 * 1024), j = (i / 1024) % 16, k = i % 1024; wba[i] = INP(1)[l * DM + k] * INP(2)[((size_t)l * DM + k) * INC + 2048 + j]; }
    for (int i = gt; i < NLAYER * 48 * 1024; i += NGT) { const int l = i / (48 * 1024), j = (i / 1024) % 48, k = i % 1024; const float nw = INP(15)[l * DM + k];
        float v = 0.f; if (j < 4) v = nw * INP(16)[((size_t)l * DM + k) * 4 + j]; else if (j < 36) v = nw * INP(18)[((size_t)l * DM + k) * 32 + (j - 4)]; wrt[i] = v; }
    float* c1 = WSP(float, WS_COS1); float* s1 = WSP(float, WS_SIN1);
    for (int i = gt; i < SEQ * 32; i += NGT) { const int s = i >> 5, f = i & 31; const double inv = exp(-((double)f / 32.0) * 9.210340371976184); double sn, cs; sincos_d((double)s * inv, sn, cs); c1[i] = (float)cs; s1[i] = (float)sn; }
    float* ax = WSP(float, WS_AX);
    for (int i = gt; i < 192 * 16; i += NGT) { const int p = i >> 4, f = i & 15; const double inv = exp(-((double)f / 16.0) * 9.210340371976184); const int pos = p < 128 ? p : p - 128; double sn, cs; sincos_d((double)pos * inv, sn, cs);
        if (p < 128) { ax[p * 16 + f] = (float)cs; ax[2048 + p * 16 + f] = (float)sn; } else { ax[4096 + (p - 128) * 16 + f] = (float)cs; ax[5120 + (p - 128) * 16 + f] = (float)sn; } }
}
struct TrDesc { const float* src; bf16* dst; int ldw, ldt, k0; bool scale; };
__device__ __forceinline__ TrDesc expert_item(Frame& F, int l, int it) {
    const int e = it / 768, r = it % 768, kind = r / 256, rr = r % 256; TrDesc d;
    if (kind < 2) { const int cb = rr / 16, kb = rr % 16, c0 = 32 * cb;
        d.src = (kind == 0 ? INP(20) : INP(21)) + ((size_t)l * 32 + e) * 1024 * 512 + (size_t)(64 * kb) * 512 + c0; d.ldw = 512;
        d.dst = WSP(bf16, WS_W13T) + (size_t)e * 1024 * 1024 + (size_t)((c0 / 128) * 256 + (c0 % 128) + kind * 128) * 1024 + 64 * kb; d.ldt = 1024; d.k0 = 64 * kb; d.scale = true; }
    else { const int cb = rr / 8, kb = rr % 8;
        d.src = INP(22) + ((size_t)l * 32 + e) * 512 * 1024 + (size_t)(64 * kb) * 1024 + 32 * cb; d.ldw = 1024;
        d.dst = WSP(bf16, WS_W2T) + (size_t)e * 1024 * 512 + (size_t)(32 * cb) * 512 + 64 * kb; d.ldt = 512; d.k0 = 64 * kb; d.scale = false; }
    return d;
}
template <class V> __device__ __forceinline__ void st16s_hidden(unsigned voff, const void* sbase, const V v) { asm volatile("global_store_dwordx4 %0, %1, %2\n\ts_nop 1" :: "v"(voff), "v"(v), "s"(sbase) : "memory"); }
template <class T, class V> __device__ __forceinline__ void st16_hidden(GAS T* p, const V v) { asm volatile("global_store_dwordx4 %0, %1, off\n\ts_nop 1" :: "v"(p), "v"(v) : "memory"); }
__device__ __forceinline__ void expert_convert(Frame& F, int l) {
    int lane; asm volatile("v_mbcnt_lo_u32_b32 %0, -1, 0\n\tv_mbcnt_hi_u32_b32 %0, -1, %0" : "=v"(lane));
    const int gw = F.vcu * NWAVES + F.wave, NGW = F.G * NWAVES, NIT = 32 * 768;
    LAS float* scr = (LAS float*)(F.lds + F.wave * 16896); LAS float* fnl = scr + 64 * 33;
    { const GAS float* fnw = (const GAS float*)INP(15) + l * DM;
#pragma unroll
      for (int i = 0; i < 4; ++i) *(LAS f32x4*)(fnl + 4 * (i * 64 + lane)) = *(const GAS f32x4*)(fnw + 4 * (i * 64 + lane)); }
    LDS_WAIT(); asm volatile("" ::: "memory");
    constexpr int EC_D = 4;
    int its[EC_D]; f32x4 v[EC_D][8];
#define EC_ISSUE(s, IT) do { its[s] = (IT); const bool ok_ = its[s] < NIT; TrDesc di_ = expert_item(F, l, ok_ ? its[s] : gw); if (!ok_) { di_.src = INP(15); di_.ldw = 0; } \
        const unsigned vo_ = (unsigned)(((lane >> 3) * di_.ldw + 4 * (lane & 7)) * 4);     \
        _Pragma("unroll") for (int i = 0; i < 8; ++i) v[s][i] = __builtin_nontemporal_load((const GAS f32x4*)((const GAS char*)(di_.src + (size_t)(8 * i) * di_.ldw) + vo_)); } while (0)
#pragma unroll
    for (int s = 0; s < EC_D; ++s) EC_ISSUE(s, gw + s * NGW);
    for (int it = gw; it < NIT; it += EC_D * NGW) {
#pragma unroll
        for (int s = 0; s < EC_D; ++s) {
            if (its[s] < NIT) { const TrDesc dd = expert_item(F, l, its[s]); const unsigned vd = (unsigned)(((lane >> 3) * dd.ldt + 8 * (lane & 7)) * 2);
#pragma unroll
                for (int i = 0; i < 8; ++i) { const int kk = 8 * i + (lane >> 3); const float sc = dd.scale ? fnl[dd.k0 + kk] : 1.0f; LAS float* q = scr + kk * 33 + 4 * (lane & 7);
                    q[0] = v[s][i][0] * sc; q[1] = v[s][i][1] * sc; q[2] = v[s][i][2] * sc; q[3] = v[s][i][3] * sc; }
                LDS_WAIT(); asm volatile("" ::: "memory");
                const int c = lane & 7;
#pragma unroll
                for (int j = 0; j < 4; ++j) { const int n = (lane >> 3) + 8 * j; const LAS float* sp = scr + (8 * c) * 33 + n;
                    v4u o; o.x = pk2(sp[0 * 33], sp[1 * 33]); o.y = pk2(sp[2 * 33], sp[3 * 33]); o.z = pk2(sp[4 * 33], sp[5 * 33]); o.w = pk2(sp[6 * 33], sp[7 * 33]);
                    st16s_hidden(vd, dd.dst + (size_t)(8 * j) * dd.ldt, o); }
                LDS_WAIT(); asm volatile("" ::: "memory");
            }
            EC_ISSUE(s, it + (s + EC_D) * NGW);
        }
    }
#undef EC_ISSUE
    asm volatile("s_waitcnt vmcnt(0)" ::: "memory");
}

template <int MODE> __device__ __forceinline__ void norm_pass(Frame& F, int l) {
    const int lane = F.lane, r16 = lane & 15, q4 = lane >> 4;
    const int gw = F.vcu * NWAVES + F.wave, NGW = F.G * NWAVES;
    constexpr int NCT = (MODE == 1) ? 3 : (MODE == 3 ? 0 : 1);
    const GAS float* Wt = (MODE == 1) ? WSG(float, WS_WRT) + (size_t)l * 48 * 1024 : WSG(float, WS_WBA) + (size_t)l * 16 * 1024;
    GAS float* rstd_out = WSG(float, MODE == 1 ? WS_RSTD2 : (MODE == 3 ? WS_RSTDF : WS_RSTD1));
    GAS bf16* XB = WSG(bf16, WS_XB);
    const GAS bf16* YB = WSG(bf16, WS_XG);
    int tb = 0;
    if (MODE >= 2) {
        const int lp = (MODE == 2) ? l - 1 : NLAYER - 1;
        const int cnt = lane < 32 ? (int)F.ctl[CW_CNT + 64 * lp + lane] : 0; const int nt = (cnt + 255) >> 8; int inc = nt;
#pragma unroll
        for (int o = 1; o < 32; o <<= 1) { const int t = SHFL_UP(inc, o); if (lane >= o) inc += t; }
        tb = inc - nt;
    }
    LAS float* scr = (LAS float*)(F.lds + F.wave * 16384 + 12288);
    for (int tile = gw; tile < TOK / 16; tile += NGW) {
        const int row = tile * 16 + r16;
        const GAS float* src = (const GAS float*)INP(0) + (size_t)row * DM + 16 * q4;
        GAS float* dst = (GAS float*)F.out + (size_t)row * DM + 16 * q4;
        const GAS bf16* xb = XB + (size_t)row * DM + 16 * q4;
        size_t y1 = 0, y2 = 0;
        if (MODE >= 2) { const GAS int* ts = WSG(int, WS_TSLOT) + row * 2; const int s1 = ts[0], s2 = ts[1];
            const int b1 = SHFL(tb, s1 >> 15), b2 = SHFL(tb, s2 >> 15);
            y1 = ((size_t)b1 * 256 + (s1 & 32767)) * DM + 16 * q4; y2 = ((size_t)b2 * 256 + (s2 & 32767)) * DM + 16 * q4; }
        f32x4 acc[NCT > 0 ? NCT : 1];
#pragma unroll
        for (int c = 0; c < (NCT > 0 ? NCT : 1); ++c) acc[c] = (f32x4){0.f, 0.f, 0.f, 0.f};
        float ss = 0.f;
        f32x4 vv[2][2][4]; v4u xa[2][2][2]; v4u ya[2][2][4];
#define NP_LOAD(B, KB) do { _Pragma("unroll") for (int gq = 0; gq < 2; ++gq) { const int kb_ = (KB) + 64 * gq; \
            if (MODE == 0) { _Pragma("unroll") for (int i = 0; i < 4; ++i) vv[B][gq][i] = __builtin_nontemporal_load((const GAS f32x4*)(src + kb_ + 4 * i)); } \
            else { xa[B][gq][0] = *(const GAS v4u*)(xb + kb_); xa[B][gq][1] = *(const GAS v4u*)(xb + kb_ + 8); } \
            if (MODE >= 2) { ya[B][gq][0] = __builtin_nontemporal_load((const GAS v4u*)(YB + y1 + kb_)); ya[B][gq][1] = __builtin_nontemporal_load((const GAS v4u*)(YB + y1 + kb_ + 8)); \
                             ya[B][gq][2] = __builtin_nontemporal_load((const GAS v4u*)(YB + y2 + kb_)); ya[B][gq][3] = __builtin_nontemporal_load((const GAS v4u*)(YB + y2 + kb_ + 8)); } } } while (0)
#define NP_TRIP(B, KB0, PF) do { const int kb0 = (KB0); \
            f32x4 wv[2][NCT > 0 ? NCT : 1][4]; \
            _Pragma("unroll") for (int gq = 0; gq < 2; ++gq) _Pragma("unroll") for (int c = 0; c < NCT; ++c) _Pragma("unroll") for (int i = 0; i < 4; ++i) \
                wv[gq][c][i] = *(const GAS f32x4*)(Wt + (size_t)(c * 16 + r16) * DM + kb0 + 64 * gq + 16 * q4 + 4 * i); \
            __builtin_amdgcn_sched_barrier(0); \
            if (PF) NP_LOAD((B) ^ 1, kb0 + 128); \
            __builtin_amdgcn_sched_barrier(0);     \
            _Pragma("unroll") for (int gq = 0; gq < 2; ++gq) { const int kb = kb0 + 64 * gq; \
                f32x4 v[4]; \
                if (MODE == 0) { _Pragma("unroll") for (int i = 0; i < 4; ++i) v[i] = vv[B][gq][i]; } \
                else { const v4u x0 = xa[B][gq][0], x1 = xa[B][gq][1]; \
                    v[0] = (f32x4){bflo(x0.x), bfhi(x0.x), bflo(x0.y), bfhi(x0.y)}; v[1] = (f32x4){bflo(x0.z), bfhi(x0.z), bflo(x0.w), bfhi(x0.w)}; \
                    v[2] = (f32x4){bflo(x1.x), bfhi(x1.x), bflo(x1.y), bfhi(x1.y)}; v[3] = (f32x4){bflo(x1.z), bfhi(x1.z), bflo(x1.w), bfhi(x1.w)}; } \
                if (MODE >= 2) { \
                    const v4u a0 = ya[B][gq][0], a1 = ya[B][gq][1], b0 = ya[B][gq][2], b1 = ya[B][gq][3]; \
                    v[0] += (f32x4){bflo(a0.x) + bflo(b0.x), bfhi(a0.x) + bfhi(b0.x), bflo(a0.y) + bflo(b0.y), bfhi(a0.y) + bfhi(b0.y)}; \
                    v[1] += (f32x4){bflo(a0.z) + bflo(b0.z), bfhi(a0.z) + bfhi(b0.z), bflo(a0.w) + bflo(b0.w), bfhi(a0.w) + bfhi(b0.w)}; \
                    v[2] += (f32x4){bflo(a1.x) + bflo(b1.x), bfhi(a1.x) + bfhi(b1.x), bflo(a1.y) + bflo(b1.y), bfhi(a1.y) + bfhi(b1.y)}; \
                    v[3] += (f32x4){bflo(a1.z) + bflo(b1.z), bfhi(a1.z) + bfhi(b1.z), bflo(a1.w) + bflo(b1.w), bfhi(a1.w) + bfhi(b1.w)}; \
                } \
                _Pragma("unroll") for (int i = 0; i < 4; ++i) ss += (v[i][0] * v[i][0] + v[i][1] * v[i][1]) + (v[i][2] * v[i][2] + v[i][3] * v[i][3]); \
                if (MODE == 0 || MODE == 2) { \
                    v4u o0, o1; o0.x = pk2(v[0][0], v[0][1]); o0.y = pk2(v[0][2], v[0][3]); o0.z = pk2(v[1][0], v[1][1]); o0.w = pk2(v[1][2], v[1][3]); \
                    o1.x = pk2(v[2][0], v[2][1]); o1.y = pk2(v[2][2], v[2][3]); o1.z = pk2(v[3][0], v[3][1]); o1.w = pk2(v[3][2], v[3][3]); \
                    GAS bf16* xo = XB + (size_t)row * DM + 16 * q4 + kb; st16_hidden(xo, o0); st16_hidden(xo + 8, o1); \
                } \
                _Pragma("unroll") for (int c = 0; c < NCT; ++c) _Pragma("unroll") for (int i = 0; i < 4; ++i) _Pragma("unroll") for (int e = 0; e < 4; ++e) \
                    acc[c] = __builtin_amdgcn_mfma_f32_16x16x4f32(v[i][e], wv[gq][c][i][e], acc[c], 0, 0, 0); \
            } } while (0)
        NP_LOAD(0, 0);
#pragma unroll 1
        for (int kbq = 0; kbq < DM - 256; kbq += 256) { NP_TRIP(0, kbq, true); NP_TRIP(1, kbq + 128, true); }
        NP_TRIP(0, DM - 256, true); NP_TRIP(1, DM - 128, false);
#undef NP_LOAD
#undef NP_TRIP
        ss += SHFL_XOR(ss, 16); ss += SHFL_XOR(ss, 32);
        const float rstd = 1.0f / sqrtf(ss * (1.0f / DM) + EPS);
        if (q4 == 0) rstd_out[row] = rstd;
        if (MODE == 3) {
            const GAS float* fw = (const GAS float*)INP(23) + 16 * q4;
#pragma unroll 2
            for (int kb = 0; kb < DM; kb += 64) {
                const v4u x0 = *(const GAS v4u*)(xb + kb), x1 = *(const GAS v4u*)(xb + kb + 8);
                const v4u a0 = *(const GAS v4u*)(YB + y1 + kb), a1 = *(const GAS v4u*)(YB + y1 + kb + 8), b0 = *(const GAS v4u*)(YB + y2 + kb), b1 = *(const GAS v4u*)(YB + y2 + kb + 8);
                f32x4 wv[4];
#pragma unroll
                for (int i = 0; i < 4; ++i) wv[i] = *(const GAS f32x4*)(fw + kb + 4 * i);
                f32x4 v[4];
                v[0] = (f32x4){bflo(x0.x), bfhi(x0.x), bflo(x0.y), bfhi(x0.y)}; v[1] = (f32x4){bflo(x0.z), bfhi(x0.z), bflo(x0.w), bfhi(x0.w)};
                v[2] = (f32x4){bflo(x1.x), bfhi(x1.x), bflo(x1.y), bfhi(x1.y)}; v[3] = (f32x4){bflo(x1.z), bfhi(x1.z), bflo(x1.w), bfhi(x1.w)};
                v[0] += (f32x4){bflo(a0.x) + bflo(b0.x), bfhi(a0.x) + bfhi(b0.x), bflo(a0.y) + bflo(b0.y), bfhi(a0.y) + bfhi(b0.y)};
                v[1] += (f32x4){bflo(a0.z) + bflo(b0.z), bfhi(a0.z) + bfhi(b0.z), bflo(a0.w) + bflo(b0.w), bfhi(a0.w) + bfhi(b0.w)};
                v[2] += (f32x4){bflo(a1.x) + bflo(b1.x), bfhi(a1.x) + bfhi(b1.x), bflo(a1.y) + bflo(b1.y), bfhi(a1.y) + bfhi(b1.y)};
                v[3] += (f32x4){bflo(a1.z) + bflo(b1.z), bfhi(a1.z) + bfhi(b1.z), bflo(a1.w) + bflo(b1.w), bfhi(a1.w) + bfhi(b1.w)};
#pragma unroll
                for (int i = 0; i < 4; ++i) st16_hidden(dst + kb + 4 * i, v[i] * rstd * wv[i]);
            }
        }
        float rr[4];
#pragma unroll
        for (int g = 0; g < 4; ++g) rr[g] = SHFL(rstd, q4 * 4 + g);
        if (MODE == 0 || MODE == 2) { GAS float* ba = WSG(float, WS_BA);
#pragma unroll
            for (int g = 0; g < 4; ++g) ba[(size_t)(tile * 16 + q4 * 4 + g) * 16 + r16] = acc[0][g] * rr[g]; }
        if (MODE == 1) {
#pragma unroll
            for (int c = 0; c < NCT; ++c) { const int col = c * 16 + r16; float bias = 0.f; if (col < 4) bias = ((const GAS float*)INP(17))[l * 4 + col]; else if (col < 36) bias = ((const GAS float*)INP(19))[l * 32 + col - 4];
#pragma unroll
                for (int g = 0; g < 4; ++g) scr[(q4 * 4 + g) * 48 + col] = acc[c][g] * rr[g] + bias; }
            LDS_WAIT(); asm volatile("" ::: "memory");
            if (lane < 16) {
                const LAS float* lg = scr + lane * 48; const int t = tile * 16 + lane;
                int gi = 0; float gm = lg[0];
#pragma unroll
                for (int j = 1; j < 4; ++j) if (lg[j] > gm) { gm = lg[j]; gi = j; }
                float gs = 0.f;
#pragma unroll
                for (int j = 0; j < 4; ++j) gs += __expf(lg[j] - gm);
                const float gp = 1.0f / gs;
                const LAS float* el = lg + 4 + gi * 8;
                int i1 = 0; float m1 = el[0];
#pragma unroll
                for (int j = 1; j < 8; ++j) if (el[j] > m1) { m1 = el[j]; i1 = j; }
                int i2 = -1; float m2 = -3.0e38f;
#pragma unroll
                for (int j = 0; j < 8; ++j) if (j != i1 && el[j] > m2) { m2 = el[j]; i2 = j; }
                const float p2 = __expf(m2 - m1), w1 = gp / (1.0f + p2), w2 = gp * p2 / (1.0f + p2);
                const int E1 = gi * 8 + i1, E2 = gi * 8 + i2;
                GAS unsigned* cnt = (GAS unsigned*)(F.ctl + CW_CNT + 64 * l);
                const int p1 = (int)__hip_atomic_fetch_add(cnt + E1, 1u, __ATOMIC_RELAXED, __HIP_MEMORY_SCOPE_AGENT), pp2 = (int)__hip_atomic_fetch_add(cnt + E2, 1u, __ATOMIC_RELAXED, __HIP_MEMORY_SCOPE_AGENT);
                GAS int* tokl = WSG(int, WS_TOKL); GAS float* wl = WSG(float, WS_WL); GAS int* ts = WSG(int, WS_TSLOT);
                tokl[E1 * 32768 + p1] = t; wl[E1 * 32768 + p1] = w1; ts[t * 2] = (E1 << 15) | p1;
                tokl[E2 * 32768 + pp2] = t; wl[E2 * 32768 + pp2] = w2; ts[t * 2 + 1] = (E2 << 15) | pp2;
            }
            LDS_WAIT(); asm volatile("" ::: "memory");
        }
    }
}

__device__ __forceinline__ void unpack8(const v4u w, float (&x)[8]) { x[0] = bflo(w.x); x[1] = bfhi(w.x); x[2] = bflo(w.y); x[3] = bfhi(w.y); x[4] = bflo(w.z); x[5] = bfhi(w.z); x[6] = bflo(w.w); x[7] = bfhi(w.w); }
__device__ __forceinline__ v4u pack8(const float (&x)[8]) { v4u w; w.x = pk2(x[0], x[1]); w.y = pk2(x[2], x[3]); w.z = pk2(x[4], x[5]); w.w = pk2(x[6], x[7]); return w; }
__device__ __forceinline__ void rope_pass(Frame& F, int l) {
    const int lane = F.lane, jl = lane & 7;
    const int gw = F.vcu * NWAVES + F.wave, NGW = F.G * NWAVES;
    const float* c1 = WSP(float, WS_COS1); const float* s1 = WSP(float, WS_SIN1); const float* ax = WSP(float, WS_AX);
    bf16* PP = WSP(bf16, WS_PP);
    float qnw[8], knw[8];
#pragma unroll
    for (int e = 0; e < 8; ++e) { qnw[e] = INP(9)[l * 64 + 8 * jl + e]; knw[e] = INP(10)[l * 64 + 8 * jl + e]; }
    for (int t = gw; t < TOK; t += NGW) {
        const int s = t & (SEQ - 1); bf16* prow = PP + (size_t)t * PPW;
        float cs[8], sn[8];
        { const f32x4 ca = *(const f32x4*)(c1 + s * 32 + 8 * (jl & 3)), cb = *(const f32x4*)(c1 + s * 32 + 8 * (jl & 3) + 4), sa = *(const f32x4*)(s1 + s * 32 + 8 * (jl & 3)), sb = *(const f32x4*)(s1 + s * 32 + 8 * (jl & 3) + 4);
#pragma unroll
          for (int e = 0; e < 4; ++e) { cs[e] = ca[e]; cs[4 + e] = cb[e]; sn[e] = sa[e]; sn[4 + e] = sb[e]; } }
#pragma unroll
        for (int which = 0; which < 2; ++which) {
            bf16* p = prow + (which == 0 ? PC_DQ : PC_DK) + 8 * lane; float x[8], o[8]; unpack8(*(const v4u*)p, x);
#pragma unroll
            for (int e = 0; e < 8; ++e) { const float pv = SHFL_XOR(x[e], 4); o[e] = (jl < 4) ? x[e] * cs[e] - pv * sn[e] : x[e] * cs[e] + pv * sn[e]; if (which == 0) o[e] *= QSCALE; }
            *(v4u*)p = pack8(o);
        }
        float ac[8], as[8];
        { const float* tbc = (jl < 4) ? ax + (s >> 6) * 16 : ax + 4096 + (s & 63) * 16; const float* tbs = (jl < 4) ? ax + 2048 + (s >> 6) * 16 : ax + 5120 + (s & 63) * 16;
          const f32x4 ca = *(const f32x4*)(tbc + 8 * (jl & 1)), cb = *(const f32x4*)(tbc + 8 * (jl & 1) + 4), sa = *(const f32x4*)(tbs + 8 * (jl & 1)), sb = *(const f32x4*)(tbs + 8 * (jl & 1) + 4);
#pragma unroll
          for (int e = 0; e < 4; ++e) { ac[e] = ca[e]; ac[4 + e] = cb[e]; as[e] = sa[e]; as[4 + e] = sb[e]; } }
#pragma unroll
        for (int which = 0; which < 2; ++which) {
            bf16* p = prow + (which == 0 ? PC_CQ + 8 * lane : PC_CK + 8 * (lane & 15)); float x[8], o[8]; unpack8(*(const v4u*)p, x);
            float ssq = 0.f;
#pragma unroll
            for (int e = 0; e < 8; ++e) ssq += x[e] * x[e];
            ssq += SHFL_XOR(ssq, 1); ssq += SHFL_XOR(ssq, 2); ssq += SHFL_XOR(ssq, 4);
            const float rn = 1.0f / sqrtf(ssq * (1.0f / 64.0f) + EPS);
#pragma unroll
            for (int e = 0; e < 8; ++e) x[e] = x[e] * rn * (which == 0 ? qnw[e] : knw[e]);
#pragma unroll
            for (int e = 0; e < 8; ++e) { const float pv = SHFL_XOR(x[e], 2); o[e] = ((jl & 3) < 2) ? x[e] * ac[e] - pv * as[e] : x[e] * ac[e] + pv * as[e]; if (which == 0) o[e] *= QSCALE; }
            if (which == 0 || lane < 16) *(v4u*)p = pack8(o);
        }
    }
}

__host__ __device__ __forceinline__ constexpr int frag_off(int row, int col, int C) { return (((row >> 4) * (C / 32) + (col >> 5)) * 64 + ((col >> 3) & 3) * 16 + (row & 15)) * 8 + (col & 7); }
constexpr int CK_KS = 0, CK_QS = 17408, CK_L0 = 34816, CK_L1 = 52224, CK_BET = 69632, CK_GCS = 70144, CK_BYTES = 70656;
constexpr int SOLVE_PF = 8;
constexpr int solve_ns() { int s = 0; for (int i = 0; i < 63; ++i) s += 16 - (i + 1) / 4; return s; }
constexpr int SOLVE_NS = solve_ns();
constexpr int solve_si(int s) { int i = 0; for (; i < 63; ++i) { const int n = 16 - (i + 1) / 4; if (s < n) break; s -= n; } return i; }
constexpr int solve_sq(int s) { int i = 0; for (; i < 63; ++i) { const int n = 16 - (i + 1) / 4; if (s < n) break; s -= n; } return (i + 1) / 4 + s; }
template <int S> __device__ __forceinline__ void solve_slot(float (&m)[64], f32x4 (&ring)[SOLVE_PF], const LAS float* Lm) {
    constexpr int i = solve_si(S), lq = solve_sq(S);
    const f32x4 Lv = ring[S % SOLVE_PF];
    if constexpr (S + SOLVE_PF < SOLVE_NS) { constexpr int i2 = solve_si(S + SOLVE_PF), q2 = solve_sq(S + SOLVE_PF); ring[S % SOLVE_PF] = *(const LAS f32x4*)(Lm + i2 * 68 + 4 * q2); }
#pragma unroll
    for (int e = 0; e < 4; ++e) if (4 * lq + e > i) m[4 * lq + e] -= Lv[e] * m[i];
    __builtin_amdgcn_sched_barrier(0);
}
template <int... Is> __device__ __forceinline__ void solve_run(float (&m)[64], f32x4 (&ring)[SOLVE_PF], const LAS float* Lm, std::integer_sequence<int, Is...>) { (solve_slot<Is>(m, ring, Lm), ...); }
__device__ __forceinline__ void chunk_solve(Frame& F, LAS unsigned char* ldsc, int d, int cid, int j) {
    const LAS float* Lm = (const LAS float*)(ldsc + (d == 0 ? CK_L0 : CK_L1));
    const LAS float* bet = (const LAS float*)(ldsc + CK_BET);
    const float bj = bet[d * 64 + (d == 0 ? j : 63 - j)];
    float m[64];
#pragma unroll
    for (int i = 0; i < 64; ++i) m[i] = 0.f;
    { int jj = j; asm volatile("" : "+v"(jj));
#pragma unroll
      for (int i = 0; i < 64; ++i) m[i] = (i == jj) ? bj : 0.f; }
    f32x4 ring[SOLVE_PF];
#pragma unroll
    for (int k = 0; k < SOLVE_PF; ++k) ring[k] = *(const LAS f32x4*)(Lm + solve_si(k) * 68 + 4 * solve_sq(k));
    solve_run(m, ring, Lm, std::make_integer_sequence<int, SOLVE_NS>{});
    LAS unsigned short* Mi = (LAS unsigned short*)(ldsc + (d == 0 ? CK_L0 : CK_L1));
    if (d == 0) {
        LAS unsigned short* mp = Mi + j;
#pragma unroll
        for (int i = 0; i < 64; ++i) mp[i * 72] = (unsigned short)(pk2(m[i], 0.f) & 0xffffu);
    } else {
        LAS unsigned short* mp = Mi + (63 - j);
#pragma unroll
        for (int i = 0; i < 64; ++i) mp[(63 - i) * 72] = (unsigned short)(pk2(m[i], 0.f) & 0xffffu);
    }
    LDS_WAIT(); asm volatile("" ::: "memory");
    GAS bf16* mt = WSG(bf16, WS_MM) + ((size_t)d * 2048 + cid) * 4096;
#pragma unroll
    for (int t = 0; t < 8; ++t) { const int row = (t >> 1) * 16 + (j & 15), col0 = (t & 1) * 32 + (j >> 4) * 8;
        const v4u v = *(const LAS v4u*)(Mi + row * 72 + col0); *(GAS v4u*)(mt + (t * 64 + j) * 8) = v; }
}
template <int PV> __device__ __forceinline__ void chunk_phase(Frame& F, int l) {
    const int w = F.wave, hb = w >> 2, ww = w & 3;
    const GAS float* convw = (const GAS float*)(INP(3) + l * 5 * 1536); const GAS float* alog = (const GAS float*)(INP(4) + l * 8); const GAS float* dtb = (const GAS float*)(INP(5) + l * 8);
    const GAS bf16* RAW = WSG(bf16, WS_RAW); const GAS float* BA = WSG(float, WS_BA);
    LAS unsigned char* lds = F.lds + hb * CK_BYTES;
    LAS float* bet = (LAS float*)(lds + CK_BET); LAS float* gcs = (LAS float*)(lds + CK_GCS);
    for (int pu = blockIdx.x; pu < 1024; pu += F.G) {
        const int cid = 2 * pu + hb;
        const int c = cid & 127, bh = cid >> 7, h = bh & 3, b = bh >> 2;
        const int t0 = b * SEQ + c * 64;
        int lane = F.lane; asm volatile("" : "+v"(lane));
        const int r16 = lane & 15, q4 = lane >> 4;
        { const int rb0 = 16 * ww;
          unsigned rw[3][20]; float cw0[3][5], cw1[3][5];
#pragma unroll
          for (int p = 0; p < 3; ++p) { const int col = p * 512 + h * 128 + 2 * lane;
#pragma unroll
            for (int tp = 0; tp < 5; ++tp) { cw0[p][tp] = convw[tp * 1536 + col]; cw1[p][tp] = convw[tp * 1536 + col + 1]; }
#pragma unroll
            for (int jr = 0; jr < 20; ++jr) { const int s = c * 64 + rb0 + jr - 2; unsigned u = 0u; if (s >= 0 && s < SEQ) u = *(const GAS unsigned*)(RAW + (size_t)(b * SEQ + s) * 1536 + col); rw[p][jr] = u; } }
#pragma unroll
          for (int p = 0; p < 3; ++p) {
            GAS bf16* gdst = WSG(bf16, WS_VC) + (size_t)cid * 8192 + ((rb0 >> 2) * 128 + 2 * lane) * 4;
            unsigned vq[4];
#pragma unroll
            for (int jr = 0; jr < 16; ++jr) {
                float a0 = 0.f, a1 = 0.f;
#pragma unroll
                for (int tp = 0; tp < 5; ++tp) { a0 += cw0[p][tp] * bflo(rw[p][jr + tp]); a1 += cw1[p][tp] * bfhi(rw[p][jr + tp]); }
                a0 = a0 * sigm(a0); a1 = a1 * sigm(a1);
                if (p < 2) { const float ssq = wave_sum(a0 * a0 + a1 * a1, lane); float rn = __builtin_amdgcn_rsqf(ssq + EPS); if (p == 0) rn *= 0.08838834764831845f; a0 *= rn; a1 *= rn; }
                const unsigned pk = pk2(a0, a1); const int row = rb0 + jr;
                if (p == 2) { vq[jr & 3] = pk;
                    if ((jr & 3) == 3) { v4u o; o.x = (vq[0] & 0xffffu) | (vq[1] << 16); o.y = (vq[2] & 0xffffu) | (vq[3] << 16); o.z = (vq[0] >> 16) | (vq[1] & 0xffff0000u); o.w = (vq[2] >> 16) | (vq[3] & 0xffff0000u);
                        *(GAS v4u*)(gdst + (jr >> 2) * 512) = o; } }
                if (p == 0) *(LAS unsigned*)(lds + CK_QS + row * 272 + 4 * lane) = pk;
                if (p == 1) *(LAS unsigned*)(lds + CK_KS + row * 272 + 4 * lane) = pk;
            }
          } }
        if (ww < 2) { const int d = ww, tn = d == 0 ? lane : 63 - lane; const size_t tok = (size_t)(t0 + tn);
            const float braw = BA[tok * 16 + d * 4 + h], araw = BA[tok * 16 + 8 + d * 4 + h];
            const float x = araw + dtb[d * 4 + h]; const float sp = fmaxf(x, 0.f) + log1pf(__expf(-fabsf(x)));
            float gc = -__expf(alog[d * 4 + h]) * sp;
#pragma unroll
            for (int o = 1; o < 64; o <<= 1) { const float tv = SHFL_UP(gc, o); if (lane >= o) gc += tv; }
            bet[d * 64 + tn] = sigm(braw); gcs[d * 64 + tn] = gc;
            WSG(float, WS_GC)[((size_t)d * 2048 + cid) * 64 + tn] = gc; }
        LBAR();
        { GAS bf16* KNt = WSG(bf16, WS_KN) + (size_t)cid * 8192; GAS bf16* QNt = WSG(bf16, WS_QN) + (size_t)cid * 8192;
#pragma unroll
          for (int it = 0; it < 4; ++it) { const int lo = (it * 16 + r16) * 272 + (ww * 32 + q4 * 8) * 2, P = (it * 4 + ww) * 64 + lane;
              const v4u kq = *(const LAS v4u*)(lds + CK_KS + lo), qq = *(const LAS v4u*)(lds + CK_QS + lo);
              *(GAS v4u*)(KNt + P * 8) = kq; *(GAS v4u*)(QNt + P * 8) = qq; } }
        { const int ti = ww;
          GAS bf16* I0 = WSG(bf16, WS_INTRA) + ((size_t)0 * 2048 + cid) * 4096; GAS bf16* I1 = WSG(bf16, WS_INTRA) + ((size_t)1 * 2048 + cid) * 4096;
          LAS float* L0 = (LAS float*)(lds + CK_L0); LAS float* L1 = (LAS float*)(lds + CK_L1);
          const int iq = ti * 16 + r16; const float gq0 = gcs[iq], gq1 = gcs[64 + iq];
#pragma unroll 1
          for (int tj = 0; tj < 4; ++tj) {
            f32x4 aK = (f32x4){0.f, 0.f, 0.f, 0.f}, aQ = (f32x4){0.f, 0.f, 0.f, 0.f};
#pragma unroll
            for (int kk = 0; kk < 4; ++kk) { const bf16x8 fk = *(const LAS bf16x8*)(lds + CK_KS + (ti * 16 + r16) * 272 + kk * 64 + q4 * 16), fq = *(const LAS bf16x8*)(lds + CK_QS + (ti * 16 + r16) * 272 + kk * 64 + q4 * 16),
                                                            fb = *(const LAS bf16x8*)(lds + CK_KS + (tj * 16 + r16) * 272 + kk * 64 + q4 * 16);
                aK = mfma16(fk, fb, aK); aQ = mfma16(fb, fq, aQ); }
            const int jn = tj * 16 + r16; const float g0j = gcs[jn], g1j = gcs[64 + jn];
#pragma unroll
            for (int r = 0; r < 4; ++r) { const int in = ti * 16 + q4 * 4 + r;
                const float e0 = __expf(fminf(gcs[in] - g0j, 0.f)), e1 = __expf(fminf(gcs[64 + in] - g1j, 0.f));
                L0[jn * 68 + in] = (in > jn) ? bet[in] * aK[r] * e0 : 0.f;
                L1[(63 - jn) * 68 + (63 - in)] = (in < jn) ? bet[64 + in] * aK[r] * e1 : 0.f; }
            float v0[4], v1[4];
#pragma unroll
            for (int r = 0; r < 4; ++r) { const int jq = tj * 16 + q4 * 4 + r;
                const float e0 = __expf(fminf(gq0 - gcs[jq], 0.f)), e1 = __expf(fminf(gq1 - gcs[64 + jq], 0.f));
                v0[r] = (iq >= jq) ? aQ[r] * e0 : 0.f; v1[r] = (iq <= jq) ? aQ[r] * e1 : 0.f; }
            const int ib = frag_off(iq, tj * 16 + q4 * 4, 64);
            v2u o0, o1; o0.x = pk2(v0[0], v0[1]); o0.y = pk2(v0[2], v0[3]); o1.x = pk2(v1[0], v1[1]); o1.y = pk2(v1[2], v1[3]);
            *(GAS v2u*)(I0 + ib) = o0; *(GAS v2u*)(I1 + ib) = o1;
          } }
        LBAR();
        const int role = (ww + 2 * hb) & 3;
        if (role < 2) { if (!(PV & 1)) chunk_solve(F, lds, role, cid, lane); }
        LBAR();
    }
}

typedef short s16x4 __attribute__((ext_vector_type(4)));
__device__ __forceinline__ s16x4 sc_tr(const LAS unsigned char* p) { return __builtin_bit_cast(s16x4, __builtin_amdgcn_ds_read_tr16_b64_v4i16((LAS s16x4*)p)); }
#ifndef SC_NST
#define SC_NST 6
#endif
#ifndef SCAN_CS
#define SCAN_CS 1
#endif
static_assert(SCAN_CS == 1, "the token-quad v layout is wired for 16-column slices");
constexpr int SC_CS = SCAN_CS, SC_NITEM = 32 * (8 / SC_CS), SC_STRIDE = 256 / SC_NITEM, SC_ST = 0, SC_RT = SC_CS * 4352, SC_VT = SC_RT + SC_CS * 2304, SC_VTS = SC_VT + SC_CS * 2304, SC_LDS = SC_VTS + SC_CS * 2304, SC_KI = SC_LDS, SC_KIP = 288;
template <int VAR> __device__ __forceinline__ void scan_phase(Frame& F) {
    const int lane = F.lane, w = F.wave, wl = w & 3, r16 = lane & 15, q4 = lane >> 4;
    LAS unsigned char* lds = F.lds;
    const GAS bf16* KN = WSG(bf16, WS_KN); const GAS bf16* KT = WSG(bf16, WS_KT); const GAS bf16* QN = WSG(bf16, WS_QN); const GAS bf16* VC = WSG(bf16, WS_VC);
    const GAS bf16* MMp = WSG(bf16, WS_MM); const GAS bf16* INp = WSG(bf16, WS_INTRA); const GAS float* GC = WSG(float, WS_GC);
    if ((F.vcu % SC_STRIDE) != 0) return;
    for (int item = F.vcu / SC_STRIDE; item < SC_NITEM; item += F.G / SC_STRIDE) {
        const int chain = item / (8 / SC_CS), d = chain >> 4, b = (chain >> 2) & 3, h = chain & 3, dv0 = (item % (8 / SC_CS)) * (16 * SC_CS);
        for (int i = F.tid; i < SC_LDS / 4; i += NWAVES * 64) ((LAS unsigned*)lds)[i] = 0u;
        f32x4 Sacc[SC_CS];
#pragma unroll
        for (int cs = 0; cs < SC_CS; ++cs) Sacc[cs] = (f32x4){0.f, 0.f, 0.f, 0.f};
        GAS bf16* Og = WSG(bf16, d == 0 ? WS_OF : WS_OB);
        __syncthreads();
        constexpr int NST = SC_NST;
        bf16x8 sA4[NST][4], sA2[NST][2]; f32x4 sgc[NST]; float sgl[NST]; v2u svq[NST];
#define SC_LOAD(st, n) do { const int c_ = d == 0 ? (n) : 127 - (n); const size_t cid_ = (size_t)(b * 4 + h) * 128 + c_; const size_t dc_ = (size_t)d * 2048 + cid_; \
        const GAS bf16* a4_ = (w < 4 ? KN : QN) + cid_ * 8192 + (wl * 4 * 64 + lane) * 8; \
        const GAS bf16* a2_ = (w < 4 ? MMp : INp) + dc_ * 4096 + (wl * 2 * 64 + lane) * 8; \
        _Pragma("unroll") for (int kk = 0; kk < 4; ++kk) sA4[st][kk] = *(const GAS bf16x8*)(a4_ + kk * 512); \
        _Pragma("unroll") for (int kk = 0; kk < 2; ++kk) sA2[st][kk] = *(const GAS bf16x8*)(a2_ + kk * 512); \
        sgc[st] = *(const GAS f32x4*)(GC + dc_ * 64 + 16 * wl + q4 * 4); sgl[st] = GC[dc_ * 64 + (d == 0 ? 63 : 0)]; \
        svq[st] = *(const GAS v2u*)(VC + cid_ * 8192 + ((4 * wl + q4) * 128 + dv0 + r16) * 4); } while (0)
#pragma unroll
        for (int st0 = 0; st0 < NST - 1; ++st0) SC_LOAD(st0, st0);
        for (int n0 = 0; n0 < 128; n0 += NST) {
#pragma unroll
          for (int j = 0; j < NST; ++j) {
            const int n = n0 + j; if (n >= 128) break;
            {
            const f32x4 gcv = sgc[j]; const float gl = sgl[j];
            const int c = d == 0 ? n : 127 - n; const int t0 = b * SEQ + c * 64;
            if (w < 4) {
#pragma unroll
                for (int kk = 0; kk < 4; ++kk) *(LAS bf16x8*)(lds + SC_KI + (16 * wl + r16) * SC_KIP + (kk * 32 + 8 * q4) * 2) = sA4[j][kk]; }
            f32x4 ks[SC_CS];
#pragma unroll
            for (int cs = 0; cs < SC_CS; ++cs) { bf16x8 Bs[4];
#pragma unroll
              for (int kk = 0; kk < 4; ++kk) Bs[kk] = *(const LAS bf16x8*)(lds + SC_ST + cs * 4352 + r16 * 272 + kk * 64 + q4 * 16);
              f32x4 a = (f32x4){0.f, 0.f, 0.f, 0.f};
#pragma unroll
              for (int kk = 0; kk < 4; ++kk) a = mfma16(sA4[j][kk], Bs[kk], a);
              ks[cs] = a; }
            __builtin_amdgcn_sched_barrier(0);
            if (!(VAR & 4)) { const int np = n + NST - 1 < 128 ? n + NST - 1 : 127; SC_LOAD((j + NST - 1) % NST, np); }
            __builtin_amdgcn_sched_barrier(0);
            float eg[4];
#pragma unroll
            for (int r = 0; r < 4; ++r) eg[r] = __expf(gcv[r]);
            if (w < 4) {
#pragma unroll
                for (int cs = 0; cs < SC_CS; ++cs) { float rv[4];
#pragma unroll
                    for (int r = 0; r < 4; ++r) { const unsigned u = (r < 2) ? svq[j].x : svq[j].y; const float vv = (r & 1) ? __uint_as_float(u & 0xffff0000u) : __uint_as_float(u << 16); rv[r] = vv - eg[r] * ks[cs][r]; }
                    v2u o; o.x = pk2(rv[0], rv[1]); o.y = pk2(rv[2], rv[3]); *(LAS v2u*)(lds + SC_RT + cs * 2304 + r16 * 144 + (16 * wl + q4 * 4) * 2) = o; } }
            if (!(VAR & 2)) LBAR();
            if (w < 4) { float es[4];
#pragma unroll
                for (int r = 0; r < 4; ++r) es[r] = __expf(gl - gcv[r]);
#pragma unroll
                for (int cs = 0; cs < SC_CS; ++cs) { f32x4 vn = (f32x4){0.f, 0.f, 0.f, 0.f};
                    const bf16x8 Br0 = *(const LAS bf16x8*)(lds + SC_RT + cs * 2304 + r16 * 144 + q4 * 16), Br1 = *(const LAS bf16x8*)(lds + SC_RT + cs * 2304 + r16 * 144 + 64 + q4 * 16);
                    vn = mfma16(sA2[j][0], Br0, vn); vn = mfma16(sA2[j][1], Br1, vn);
                    v2u o; o.x = pk2(vn[0], vn[1]); o.y = pk2(vn[2], vn[3]); *(LAS v2u*)(lds + SC_VT + cs * 2304 + r16 * 144 + (16 * wl + q4 * 4) * 2) = o;
                    o.x = pk2(vn[0] * es[0], vn[1] * es[1]); o.y = pk2(vn[2] * es[2], vn[3] * es[3]); *(LAS v2u*)(lds + SC_VTS + cs * 2304 + r16 * 144 + (16 * wl + q4 * 4) * 2) = o; } }
            if (!(VAR & 2)) LBAR();
            if (w >= 4) { f32x4 o[SC_CS];
#pragma unroll
                for (int cs = 0; cs < SC_CS; ++cs) { f32x4 a;
#pragma unroll
                    for (int r = 0; r < 4; ++r) a[r] = eg[r] * ks[cs][r];
                    const bf16x8 Bv0 = *(const LAS bf16x8*)(lds + SC_VT + cs * 2304 + r16 * 144 + q4 * 16), Bv1 = *(const LAS bf16x8*)(lds + SC_VT + cs * 2304 + r16 * 144 + 64 + q4 * 16);
                    a = mfma16(sA2[j][0], Bv0, a); a = mfma16(sA2[j][1], Bv1, a); o[cs] = a; }
                if (!(VAR & 1)) {
#pragma unroll
                    for (int r = 0; r < 4; ++r) { GAS bf16* op = Og + (size_t)(t0 + 16 * wl + q4 * 4 + r) * 512 + h * 128 + dv0 + SC_CS * r16;
                        if (SC_CS == 4) { v2u ov; ov.x = pk2(o[0][r], o[1][r]); ov.y = pk2(o[SC_CS - 2][r], o[SC_CS - 1][r]); asm volatile("global_store_dwordx2 %0, %1, off" :: "v"(op), "v"(ov) : "memory"); }
                        else if (SC_CS == 2) { const unsigned ov = pk2(o[0][r], o[SC_CS - 1][r]); asm volatile("global_store_dword %0, %1, off" :: "v"(op), "v"(ov) : "memory"); }
                        else { const unsigned ov = pk2(o[0][r], 0.f); asm volatile("global_store_short %0, %1, off" :: "v"(op), "v"(ov) : "memory"); } } } }
            { const float egl = __expf(gl);
              const LAS unsigned char* kip = lds + SC_KI + (8 * q4 + (r16 >> 2)) * SC_KIP + (16 * w + 4 * (r16 & 3)) * 2;
              const s16x4 ka0 = sc_tr(kip), ka1 = sc_tr(kip + 4 * SC_KIP), kb0 = sc_tr(kip + 32 * SC_KIP), kb1 = sc_tr(kip + 36 * SC_KIP);
              const bf16x8 kt0 = (bf16x8){ka0[0], ka0[1], ka0[2], ka0[3], ka1[0], ka1[1], ka1[2], ka1[3]}, kt1 = (bf16x8){kb0[0], kb0[1], kb0[2], kb0[3], kb1[0], kb1[1], kb1[2], kb1[3]};
#pragma unroll
              for (int cs = 0; cs < SC_CS; ++cs) { f32x4 sn = Sacc[cs] * egl;
                const bf16x8 Bvs0 = *(const LAS bf16x8*)(lds + SC_VTS + cs * 2304 + r16 * 144 + q4 * 16), Bvs1 = *(const LAS bf16x8*)(lds + SC_VTS + cs * 2304 + r16 * 144 + 64 + q4 * 16);
                sn = mfma16(kt0, Bvs0, sn); sn = mfma16(kt1, Bvs1, sn);
                Sacc[cs] = sn; v2u o; o.x = pk2(sn[0], sn[1]); o.y = pk2(sn[2], sn[3]); *(LAS v2u*)(lds + SC_ST + cs * 4352 + r16 * 272 + (16 * w + q4 * 4) * 2) = o; } }
            if (!(VAR & 2)) LBAR();
            }
          }
        }
#undef SC_LOAD
        __syncthreads();
    }
}

__device__ __forceinline__ int utid(const Frame& F) { int ln; asm volatile("v_mbcnt_lo_u32_b32 %0, -1, 0\n\tv_mbcnt_hi_u32_b32 %0, -1, %0" : "=v"(ln)); return F.wave * 64 + ln; }
__device__ __forceinline__ void attn_phase_all(Frame& F, int l, int ulo, int uhi, bool conv) {
    typedef attn_body::bf16 abf;
    abf* PP = (abf*)WSP(bf16, WS_PP); abf* OD = (abf*)WSP(bf16, WS_OD);
    const int slot = (F.vcu + (F.vcu >> 3)) & 7; int cnt = 0; bool pend = conv;
    for (int i = 0;; ++i) {
        const int L = ulo + i * F.G + F.vcu; if (L >= uhi || L >= 1024) break;
        if (pend && cnt == slot) { expert_convert(F, l); __syncthreads(); pend = false; } ++cnt;
        const int hd = L >> 5, qb = L & 31, b = hd >> 3, h = (hd >> 1) & 3, m = hd & 1; abf* base = PP + (size_t)b * SEQ * PPW;
        const float q2 = __uint_as_float(F.ctl[CW_NRM + 64 * l + b * 8 + (hd & 7)]), k2 = __uint_as_float(F.ctl[CW_NRM + 64 * l + 32 + b * 8 + (hd & 7)]);
        const float dbound = 1.01f * sqrtf(q2 * k2) + 0.25f;
        if (dbound <= 40.0f) attn_body::attn_unit<8, 4, true>(qb, base + PC_DQ + (h * 2 + m) * 64, base + PC_DK + (h * 2 + m) * 64, base + PC_DV + h * 128, OD + (size_t)b * SEQ * 1024 + m * 512 + h * 128, 1024, (char*)F.ldsg, utid(F), -dbound);
        else attn_body::attn_unit<8, 4, false>(qb, base + PC_DQ + (h * 2 + m) * 64, base + PC_DK + (h * 2 + m) * 64, base + PC_DV + h * 128, OD + (size_t)b * SEQ * 1024 + m * 512 + h * 128, 1024, (char*)F.ldsg, utid(F));
    }
    float sbound;
    { int lane; asm volatile("v_mbcnt_lo_u32_b32 %0, -1, 0\n\tv_mbcnt_hi_u32_b32 %0, -1, %0" : "=v"(lane)); const float wq = fabsf(((const GAS float*)INP(9))[l * 64 + lane]), wk = fabsf(((const GAS float*)INP(10))[l * 64 + lane]); float mq = wq, mk = wk;
#pragma unroll
      for (int o = 1; o < 64; o <<= 1) { mq = fmaxf(mq, SHFL_XOR(mq, o)); mk = fmaxf(mk, SHFL_XOR(mk, o)); }
      sbound = 1.02f * attn_body::C2 * 64.0f * mq * mk + 0.25f; }
    const bool fixref = sbound <= 40.0f;
    for (int i = 0;; ++i) {
        const int L = (ulo > 1024 ? ulo : 1024) + i * F.G + F.vcu; if (L >= uhi) break;
        if (pend && cnt == slot) { expert_convert(F, l); __syncthreads(); pend = false; } ++cnt;
        const int g = (L - 1024) >> 5, qb = L & 31, b = g >> 3, h = g & 7, kv = h >> 2; abf* base = PP + (size_t)b * SEQ * PPW;
        if (fixref) attn_body::attn_unit<8, 2, true>(qb, base + PC_CQ + h * 64, base + PC_CK + kv * 64, base + PC_CV + kv * 64, base + PC_CQ + h * 64, PPW, (char*)F.ldsg, utid(F), -sbound);
        else attn_body::attn_unit<8, 2, false>(qb, base + PC_CQ + h * 64, base + PC_CK + kv * 64, base + PC_CV + kv * 64, base + PC_CQ + h * 64, PPW, (char*)F.ldsg, utid(F));
    }
    if (pend) { expert_convert(F, l); __syncthreads(); }
}

__device__ __forceinline__ void post_phase(Frame& F, int l) {
    const int lane = F.lane; const int gw = F.vcu * NWAVES + F.wave, NGW = F.G * NWAVES;
    const float linit = (l == 0) ? 0.2f : 0.35550906759096926f;
    float lam;
    { const GAS float* lv = (const GAS float*)INP(7) + l * 256; const float sa = wave_sum(lv[lane] * lv[64 + lane], lane), sb = wave_sum(lv[128 + lane] * lv[192 + lane], lane); lam = expf(sa) - expf(sb) + linit; }
    float gnw[8], dnw[8];
#pragma unroll
    for (int e = 0; e < 8; ++e) { gnw[e] = ((const GAS float*)INP(6))[l * 128 + ((8 * lane) & 127) + e]; dnw[e] = ((const GAS float*)INP(8))[l * 128 + ((8 * lane) & 127) + e] * (1.0f - linit); }
    GAS bf16* PP = WSG(bf16, WS_PP); const GAS bf16* OF = WSG(bf16, WS_OF); const GAS bf16* OB = WSG(bf16, WS_OB); const GAS bf16* OD = WSG(bf16, WS_OD);
    for (int t0 = gw; t0 < TOK; t0 += 4 * NGW) {
        v4u la[4], lb[4], lz[4], lc[4], ld[4];
#pragma unroll
        for (int q = 0; q < 4; ++q) { const int t = t0 + q * NGW < TOK ? t0 + q * NGW : t0;
            la[q] = __builtin_nontemporal_load((const GAS v4u*)(OF + (size_t)t * 512 + 8 * lane)); lb[q] = __builtin_nontemporal_load((const GAS v4u*)(OB + (size_t)t * 512 + 8 * lane)); lz[q] = __builtin_nontemporal_load((const GAS v4u*)(PP + (size_t)t * PPW + PC_Z + 8 * lane));
            lc[q] = __builtin_nontemporal_load((const GAS v4u*)(OD + (size_t)t * 1024 + 8 * lane)); ld[q] = __builtin_nontemporal_load((const GAS v4u*)(OD + (size_t)t * 1024 + 512 + 8 * lane)); }
#pragma unroll
        for (int q = 0; q < 4; ++q) { const int t = t0 + q * NGW; if (t >= TOK) break;
        GAS bf16* prow = PP + (size_t)t * PPW;
        { float a[8], bb[8], z[8], o[8]; unpack8(la[q], a); unpack8(lb[q], bb); unpack8(lz[q], z);
          float ssq = 0.f;
#pragma unroll
          for (int e = 0; e < 8; ++e) { o[e] = a[e] + bb[e]; ssq += o[e] * o[e]; }
          ssq = row16_sum(ssq);
          const float rn = __builtin_amdgcn_rsqf(ssq * (1.0f / 128.0f) + EPS);
#pragma unroll
          for (int e = 0; e < 8; ++e) o[e] = o[e] * rn * gnw[e] * (z[e] * sigm(z[e]));
          *(GAS v4u*)(prow + PC_Z + 8 * lane) = pack8(o); }
        { float a[8], bb[8], o[8]; unpack8(lc[q], a); unpack8(ld[q], bb);
          float ssq = 0.f;
#pragma unroll
          for (int e = 0; e < 8; ++e) { o[e] = a[e] - lam * bb[e]; ssq += o[e] * o[e]; }
          ssq = row16_sum(ssq);
          const float rn = __builtin_amdgcn_rsqf(ssq * (1.0f / 128.0f) + EPS);
#pragma unroll
          for (int e = 0; e < 8; ++e) o[e] = o[e] * rn * dnw[e];
          *(GAS v4u*)(prow + PC_DQ + 8 * lane) = pack8(o); }
        }
    }
}

__device__ __forceinline__ int moe_tables(Frame& F, int l) {
    LAS int* tbase = (LAS int*)(F.lds + LDS_TBASE); LAS int* tilee = (LAS int*)(F.lds + LDS_TILEE);
    if (F.wave == 0) { const int lane = F.lane; const int cnt = lane < 32 ? (int)F.ctl[CW_CNT + 64 * l + lane] : 0; const int nt = (cnt + 255) >> 8; int inc = nt;
#pragma unroll
        for (int o = 1; o < 32; o <<= 1) { const int t = SHFL_UP(inc, o); if (lane >= o) inc += t; }
        const int tb = inc - nt;
        if (lane < 32) { tbase[lane] = tb; for (int k = 0; k < nt; ++k) if (tb + k < 320) tilee[tb + k] = lane; }
        if (lane == 31) tbase[32] = inc; }
    __syncthreads();
    int ntile = tbase[32]; if (ntile > 288) ntile = 288;
    return ntile;
}
struct MoeOrder {
    const LAS int* tilee; const LAS int* rowtab; int nunit, G, c; long estride;
    __device__ __forceinline__ bool next(int i, pg8::Unit& u) const { const long L = (long)i * G + c; if (L >= nunit) return false; u.pm = (int)(L >> 2); u.pn = (int)(L & 3); u.aoff = 0; u.boff = (long)tilee[u.pm] * estride; u.ord = i; return true; }
    __device__ __forceinline__ void a_ready(const pg8::Unit&) const {}
    __device__ __forceinline__ void done(const pg8::Unit&) const {}
    __device__ __forceinline__ int row(const pg8::Unit& u, int r) const { return rowtab[u.ord * 256 + r]; }
};
__device__ __forceinline__ void moe_build(Frame& F, int l, int nunit) {
    const LAS int* tbase = (const LAS int*)(F.lds + LDS_TBASE); const LAS int* tilee = (const LAS int*)(F.lds + LDS_TILEE);
    LAS int* rowtab = (LAS int*)(F.lds + LDS_ROWTAB); LAS float* rstab = (LAS float*)(F.lds + LDS_RSTAB); LAS float* wtab = (LAS float*)(F.lds + LDS_WTAB);
    const GAS int* tokl = WSG(int, WS_TOKL); const GAS float* wl = WSG(float, WS_WL); const GAS float* rstd2 = WSG(float, WS_RSTD2);
    for (int k = F.tid; k < 5 * 256; k += NWAVES * 64) { const int i = k >> 8, r = k & 255; const long L = (long)i * F.G + F.vcu;
        int tok = 0; float rs = 0.f, w = 0.f;
        if (L < nunit) { const int pm = (int)(L >> 2), e = tilee[pm], idx = (pm - tbase[e]) * 256 + r; const int cnt = (int)F.ctl[CW_CNT + 64 * l + e];
            if (idx < cnt) { tok = tokl[e * 32768 + idx]; rs = rstd2[tok]; w = wl[e * 32768 + idx]; } }
        rowtab[k] = tok; rstab[k] = rs; wtab[k] = w; }
    __syncthreads();
}
struct BrOrder {
    pg8::StaticOrder s;
    __device__ __forceinline__ bool next(int i, pg8::Unit& u) const { if (!s.next(i, u)) return false; const int br = u.pn >> 2; u.aoff = (br == 0 ? PC_Z : (br == 1 ? PC_DQ : PC_CQ)) * 2; return true; }
    __device__ __forceinline__ void a_ready(const pg8::Unit&) const {}
    __device__ __forceinline__ void done(const pg8::Unit&) const {}
};
struct GateOrder {
    pg8::StaticOrder s;
    __device__ __forceinline__ bool next(int i, pg8::Unit& u) const { if (!s.next(i / 3, u)) return false; u.pn += 4 * (i % 3); return true; }
    __device__ __forceinline__ void a_ready(const pg8::Unit&) const {}
    __device__ __forceinline__ void done(const pg8::Unit&) const {}
};
__device__ __forceinline__ void final_phase(Frame& F) {
    const int lane = F.lane; const int gw = F.vcu * NWAVES + F.wave, NGW = F.G * NWAVES;
    const float* rs = WSP(float, WS_RSTDF); const float* fw = INP(23);
    f32x4 wv[4];
#pragma unroll
    for (int j = 0; j < 4; ++j) wv[j] = *(const f32x4*)(fw + 256 * j + 4 * lane);
    for (int t = gw; t < TOK; t += NGW) { const float r = rs[t]; f32x4* o = (f32x4*)(F.out + (size_t)t * DM) + lane;
#pragma unroll
        for (int j = 0; j < 4; ++j) o[64 * j] = o[64 * j] * r * wv[j]; }
}

__global__ void __launch_bounds__(NWAVES * 64, 2) mk_fwd(Args args) {
    extern __shared__ __attribute__((aligned(16))) unsigned char lds[];
    Frame F;
    F.lds = (LAS unsigned char*)lds; F.ldsg = lds;
    F.MISC = (volatile LAS unsigned*)(F.lds + LDSCTL_OFF);
    F.tid = threadIdx.x; F.lane = F.tid & 63; F.wave = __builtin_amdgcn_readfirstlane(F.tid >> 6); const int wave0 = F.wave;
    F.G = gridDim.x; { const int bx = blockIdx.x; F.vcu = (F.G % 8 == 0) ? (bx % 8) * (F.G / 8) + bx / 8 : bx; }
    F.ws = args.ws; F.ctl = (gu32*)(args.ws + WS_CTL); F.out = args.out;
    F.A = (const __attribute__((address_space(4))) Args*)&args;
    for (int u = F.tid; u < (LDS_BYTES - LDSCTL_OFF) / 4; u += NWAVES * 64) ((LAS unsigned*)(F.lds + LDSCTL_OFF))[u] = 0u;
    __syncthreads();
    XcdBarrier bar; bar.bar = (unsigned*)(F.ctl + CW_BAR); bar.x = 0; bar.st = nullptr;
    if (!MK_SPLIT) bar = xcd_barrier_post((unsigned*)(F.ctl + CW_BAR), F.MISC + 8);
    const int lo = args.ph_lo, hi = args.ph_hi;
#ifndef PH_EN
#define PH_EN 0x3fffu
#endif
#define EN(j) ((PH_EN >> (j)) & 1u)
#ifndef REP_MASK
#define REP_MASK 0u
#endif
#define REPN(j) (1 + (int)((REP_MASK >> (j)) & 1u))
#define IN(k) (lo <= (k) && (k) < hi)
#define SEAM(k) do { if (IN((k) + 1)) xcd_barrier(bar); } while (0)
#define FRESH() do { int l_; asm volatile("v_mbcnt_lo_u32_b32 %0, -1, 0\n\tv_mbcnt_hi_u32_b32 %0, -1, %0" : "=v"(l_)); int wv_ = wave0; asm volatile("" : "+s"(wv_)); F.lane = l_; F.wave = wv_; F.tid = wv_ * 64 + l_;     \
    unsigned char* w_ = args.ws; float* o_ = args.out; unsigned char* lg_ = lds; asm volatile("" : "+s"(w_), "+s"(o_), "+s"(lg_)); F.ldsg = lg_; F.lds = (LAS unsigned char*)lg_; F.MISC = (volatile LAS unsigned*)(F.lds + LDSCTL_OFF); F.ws = w_; F.out = o_; F.ctl = (gu32*)(w_ + WS_CTL); } while (0)

    if (IN(0)) { FRESH(); for (int rep = 0; rep < REPN(13); ++rep) { p0_prologue(F); if (rep + 1 < REPN(13)) xcd_barrier(bar); } SEAM(0); }
    for (int l = 0; l < NLAYER; ++l) {
        const int pb = 1 + 12 * l;
        const float* rstd1 = WSP(float, WS_RSTD1);
        if (IN(pb + 0) && EN(0)) { FRESH(); if (l == 0) { for (int rep = 0; rep < REPN(0); ++rep) { norm_pass<0>(F, l); if (rep + 1 < REPN(0)) xcd_barrier(bar); } } else norm_pass<2>(F, l); SEAM(pb + 0); }
        if (IN(pb + 1) && EN(1)) { FRESH();
            pg8::Gemm g{WSP(bf16, WS_XB), WSP(bf16, WS_WIN) + (size_t)l * 4352 * 1024, TOK, 4352, 1024, 1024, 1024}; pg8::StaticOrder S; S.init(TOK, 4352, F.G, (int)blockIdx.x);
            pg8::EpiInproj E{WSP(bf16, WS_RAW), WSP(bf16, WS_PP), rstd1, WSP(float, WS_COS1), WSP(float, WS_SIN1), WSP(float, WS_AX), INP(9) + l * 64, INP(10) + l * 64, QSCALE, (unsigned*)(F.ctl + CW_NRM + 64 * l)};
            for (int rep = 0; rep < REPN(1); ++rep) { pg8::gemm_phase<pg8::EpiInproj, pg8::StaticOrder, true, true>(F.lds, g, S, E, F.tid); if (rep + 1 < REPN(1)) xcd_barrier(bar); }
            SEAM(pb + 1); }
        if (IN(pb + 2) && EN(2)) { FRESH();
#ifndef X_NOCHUNK
            FRESH();
            chunk_phase<0>(F, l);
#ifdef CHUNK_VAR
            xcd_barrier(bar); FRESH(); chunk_phase<CHUNK_VAR>(F, l);
#endif
#endif
            SEAM(pb + 2); }
        if (IN(pb + 3) && EN(3)) { FRESH(); scan_phase<0>(F);
#ifdef SCAN_VAR
            xcd_barrier(bar); scan_phase<SCAN_VAR>(F);
#endif
            SEAM(pb + 3); }
        if (IN(pb + 4) && EN(4)) { FRESH(); for (int rep = 0; rep < REPN(4); ++rep) { attn_phase_all(F, l, 0, rep == 0 ? 2048 : 1024, rep == 0); if (rep + 1 < REPN(4)) xcd_barrier(bar); } SEAM(pb + 4); }
        if (IN(pb + 5) && EN(5)) { FRESH(); post_phase(F, l); SEAM(pb + 5); }
        if (IN(pb + 6) && EN(6)) { FRESH();
            pg8::Gemm g{WSP(bf16, WS_PP), WSP(bf16, WS_WBR) + (size_t)l * 3072 * 512, TOK, 3072, 512, PPW, 512}; BrOrder S; S.s.init(TOK, 3072, F.G, (int)blockIdx.x);
            pg8::EpiBrTM E{WSP(bf16, WS_YBR)};
            for (int rep = 0; rep < REPN(6); ++rep) { pg8::gemm_phase<pg8::EpiBrTM, BrOrder, true, true>(F.lds, g, S, E, F.tid); if (rep + 1 < REPN(6)) xcd_barrier(bar); }
            SEAM(pb + 6); }
        if (IN(pb + 7) && EN(7)) { FRESH();
            pg8::Gemm g{WSP(bf16, WS_XB), WSP(bf16, WS_WG) + (size_t)l * 3072 * 1024, TOK, 3072, 1024, 1024, 1024}; GateOrder S; S.s.init(TOK, 1024, F.G, (int)blockIdx.x);
            pg8::EpiGate E{WSP(bf16, WS_YBR), WSP(bf16, WS_MG), rstd1, WSP(bf16, WS_MGT)};
            for (int rep = 0; rep < REPN(7); ++rep) { pg8::gemm_phase<pg8::EpiGate, GateOrder, true, true>(F.lds, g, S, E, F.tid); if (rep + 1 < REPN(7)) xcd_barrier(bar); }
            SEAM(pb + 7); }
        if (IN(pb + 8) && EN(8)) { FRESH();
            pg8::Gemm g{WSP(bf16, WS_MG), WSP(bf16, WS_WO3) + (size_t)l * 1024 * 1024, TOK, 1024, 1024, 1024, 1024}; pg8::StaticOrder S; S.init(TOK, 1024, F.G, (int)blockIdx.x);
            pg8::EpiResidB E{WSP(bf16, WS_XB), DM};
            pg8::gemm_phase<pg8::EpiResidB, pg8::StaticOrder, true, true, false, true>(F.lds, g, S, E, F.tid);
            SEAM(pb + 8); }
        if (IN(pb + 9) && EN(9)) { FRESH(); norm_pass<1>(F, l); SEAM(pb + 9); }
        if (IN(pb + 10) && EN(10)) { FRESH();
            const int ntile = moe_tables(F, l); moe_build(F, l, ntile * 4);
            pg8::Gemm g{WSP(bf16, WS_XB), WSP(bf16, WS_W13T), ntile * 256, 1024, 1024, 1024, 1024}; MoeOrder S{(const LAS int*)(F.lds + LDS_TILEE), (const LAS int*)(F.lds + LDS_ROWTAB), ntile * 4, F.G, F.vcu, (long)1024 * 1024 * 2};
            pg8::EpiMoe1 E{WSP(bf16, WS_HH), (const LAS float*)(F.lds + LDS_RSTAB)};
            for (int rep = 0; rep < REPN(11); ++rep) { pg8::gemm_phase<pg8::EpiMoe1, MoeOrder, true, true, true>(F.lds, g, S, E, F.tid); if (rep + 1 < REPN(11)) xcd_barrier(bar); }
            SEAM(pb + 10); }
        if (IN(pb + 11) && EN(11)) { FRESH();
            if (MK_SPLIT) { const int nt_ = moe_tables(F, l); moe_build(F, l, nt_ * 4); }
            int ntile = ((const LAS int*)(F.lds + LDS_TBASE))[32]; if (ntile > 288) ntile = 288;
            pg8::Gemm g{WSP(bf16, WS_HH), WSP(bf16, WS_W2T), ntile * 256, 1024, 512, 512, 512}; MoeOrder S{(const LAS int*)(F.lds + LDS_TILEE), (const LAS int*)(F.lds + LDS_ROWTAB), ntile * 4, F.G, F.vcu, (long)1024 * 512 * 2};
            pg8::EpiMoe2 E{WSP(bf16, WS_XG), (const LAS float*)(F.lds + LDS_WTAB)};
            for (int rep = 0; rep < REPN(12); ++rep) { pg8::gemm_phase<pg8::EpiMoe2, MoeOrder, true, true, false, true>(F.lds, g, S, E, F.tid); if (rep + 1 < REPN(12)) xcd_barrier(bar); }
            SEAM(pb + 11); }
    }
#ifdef EXTRA_BARS
    for (int eb = 0; eb < EXTRA_BARS; ++eb) xcd_barrier(bar);
#endif
    if (IN(25)) { FRESH(); norm_pass<3>(F, 0); }
#undef IN
#undef SEAM
}

#ifdef DBG_STOP
#ifndef DBG_KIND
#define DBG_KIND 0
#endif
#ifndef DBG_OFF
#define DBG_OFF 0
#endif
__global__ void dbg_dump(const unsigned char* ws, float* out, int n) {
    for (int i = blockIdx.x * blockDim.x + threadIdx.x; i < n; i += gridDim.x * blockDim.x) {
        if (DBG_KIND == 1) out[i] = bf2f(((const bf16*)(ws + (size_t)DBG_OFF * MiB))[i]);
        if (DBG_KIND == 2) out[i] = ((const float*)(ws + (size_t)DBG_OFF * MiB))[i];
        if (DBG_KIND == 3) out[i] = (float)((const int*)(ws + (size_t)DBG_OFF * MiB))[i];
        if (DBG_KIND == 4) { const float v = out[i] * 65536.0f; out[i] = v - floorf(v); }
        if (DBG_KIND == 5) out[i] = (float)(((const bf16*)(ws + (size_t)DBG_OFF * MiB))[i] & 0xffu);
        if (DBG_KIND == 6) { const float v = ((const float*)(ws + (size_t)DBG_OFF * MiB))[i] * 65536.0f; out[i] = v - floorf(v); }
    }
}
#endif
extern "C" void kernel_launch(void* const* d_in, const int* in_sizes, int n_in, void* d_out, int out_size, void* d_ws, size_t ws_size, hipStream_t stream) {
    static int grid = 0;
    if (grid == 0) {
        if (n_in != 24 || out_size != TOK * DM || ws_size < WS_END) { fprintf(stderr, "kernel_launch: unexpected sizes (n_in %d out %d ws %zu)\n", n_in, out_size, ws_size); grid = -1; return; }
        int dev = 0, cus = 0, per_cu = 0;
        if (hipGetDevice(&dev) != hipSuccess || hipDeviceGetAttribute(&cus, hipDeviceAttributeMultiprocessorCount, dev) != hipSuccess) { grid = -1; return; }
        if (hipFuncSetAttribute((const void*)mk_fwd, hipFuncAttributeMaxDynamicSharedMemorySize, LDS_BYTES) != hipSuccess) { fprintf(stderr, "kernel_launch: hipFuncSetAttribute failed\n"); grid = -1; return; }
        if (hipOccupancyMaxActiveBlocksPerMultiprocessor(&per_cu, (const void*)mk_fwd, NWAVES * 64, LDS_BYTES) != hipSuccess || per_cu < 1) { fprintf(stderr, "kernel_launch: occupancy query says %d\n", per_cu); }
        (void)hipGetLastError();
        grid = cus;
    }
    if (grid < 0) return;
    if (hipMemsetAsync((char*)d_ws + WS_CTL, 0, CTL_ZERO_BYTES, stream) != hipSuccess) return;
    Args a{};
    for (int i = 0; i < 24; ++i) a.in[i] = (const float*)d_in[i];
    a.out = (float*)d_out; a.ws = (unsigned char*)d_ws;
#if MK_SPLIT
#ifdef DBG_STOP
    for (int p = 0; p <= DBG_STOP; ++p) { a.ph_lo = p; a.ph_hi = p + 1; hipLaunchKernelGGL(mk_fwd, dim3(grid), dim3(NWAVES * 64), LDS_BYTES, stream, a); }
    if (DBG_KIND != 0) hipLaunchKernelGGL(dbg_dump, dim3(2048), dim3(256), 0, stream, (const unsigned char*)d_ws, (float*)d_out, DBG_N);
#else
    for (int p = 0; p < NPH; ++p) { a.ph_lo = p; a.ph_hi = p + 1; hipLaunchKernelGGL(mk_fwd, dim3(grid), dim3(NWAVES * 64), LDS_BYTES, stream, a); }
#endif
#else
    a.ph_lo = 0; a.ph_hi = NPH;
    hipLaunchKernelGGL(mk_fwd, dim3(grid), dim3(NWAVES * 64), LDS_BYTES, stream, a);
#endif
}
```
